# Optimizing an MI355X kernel written in HIP

```python
import math
import jax
import jax.numpy as jnp
from jax import lax
import numpy as np

D_MODEL = 1024
BATCH = 16
SEQ = 2048
DEPTH = 2

CHUNK = 64
Q_BLOCK = 128
N_BRANCH = 3
BRANCH_W = D_MODEL
EPS = 1e-6

FOX_HD = 64
FOX_HEADS = BRANCH_W // FOX_HD

SSM_HD = 64
SSM_HEADS = BRANCH_W // SSM_HD
SSM_W = SSM_HEADS * SSM_HD
SSM_GROUPS = 4
SSM_STATE = 128
SSM_CONV_K = 4
SSM_CONV_DIM = SSM_W + 2 * SSM_GROUPS * SSM_STATE

DIFF_HD = 64
DIFF_HEADS = BRANCH_W // (2 * DIFF_HD)
DIFF_QK_W = DIFF_HEADS * 2 * DIFF_HD
DIFF_V_W = DIFF_HEADS * 2 * DIFF_HD
ROPE_THETA = 500000.0
ROT_DIM = DIFF_HD // 4

SPLIT_SIZES = (
    BRANCH_W, BRANCH_W, BRANCH_W, FOX_HEADS, BRANCH_W,
    SSM_W, SSM_CONV_DIM, SSM_HEADS,
    DIFF_QK_W, DIFF_QK_W, DIFF_V_W, DIFF_V_W,
    N_BRANCH * D_MODEL,
)
N_IN = sum(SPLIT_SIZES)

kernel_name = 'hybrid_fox_ssd_diffattn_streaming'


def rmsnorm(x, w):
    x32 = x.astype(jnp.float32)
    y = x32 * lax.rsqrt(jnp.mean(x32 * x32, axis=-1, keepdims=True) + EPS)
    return (y * w.astype(jnp.float32)).astype(x.dtype)


def partial_rope(x, cos, sin):
    half = ROT_DIM // 2
    x1 = x[..., :half]
    x2 = x[..., half:ROT_DIM]
    rest = x[..., ROT_DIM:]
    rot = jnp.concatenate([x1 * cos - x2 * sin, x2 * cos + x1 * sin], axis=-1)
    return jnp.concatenate([rot.astype(x.dtype), rest], axis=-1)


def causal_depthwise_conv(u, w, b):
    y = lax.conv_general_dilated(
        u, w[:, None, :].astype(u.dtype), window_strides=(1,),
        padding=[(SSM_CONV_K - 1, 0)], dimension_numbers=('NWC', 'WIO', 'NWC'),
        feature_group_count=u.shape[-1])
    return y + b


def forgetting_attention(q, k, v, log_f):
    L = q.shape[2]
    F = jnp.cumsum(log_f, axis=-1)
    scale = q.shape[-1] ** -0.5
    outs = []
    for i in range(L // Q_BLOCK):
        q0, q1 = i * Q_BLOCK, (i + 1) * Q_BLOCK
        s = jnp.einsum('bhqd,bhkd->bhqk', q[:, :, q0:q1], k[:, :, :q1]).astype(jnp.float32) * scale
        s = s + F[:, :, q0:q1, None] - F[:, :, None, :q1]
        tq = jnp.arange(q0, q1)[:, None]
        tk = jnp.arange(q1)[None, :]
        s = jnp.where(tk <= tq, s, -jnp.inf)
        p = jax.nn.softmax(s, axis=-1).astype(v.dtype)
        outs.append(jnp.einsum('bhqk,bhkd->bhqd', p, v[:, :, :q1]))
    return jnp.concatenate(outs, axis=2)


def differential_attention(q, k, v, lam):
    L = q.shape[3]
    scale = q.shape[-1] ** -0.5
    outs = []
    for i in range(L // Q_BLOCK):
        q0, q1 = i * Q_BLOCK, (i + 1) * Q_BLOCK
        s = jnp.einsum('bhcqd,bhckd->bhcqk', q[:, :, :, q0:q1], k[:, :, :, :q1]).astype(jnp.float32) * scale
        cq = (jnp.arange(q0, q1) // CHUNK)[:, None]
        ck = (jnp.arange(q1) // CHUNK)[None, :]
        s = jnp.where(ck <= cq, s, -jnp.inf)
        p = jax.nn.softmax(s, axis=-1)
        a = (p[:, :, 0] - lam * p[:, :, 1]).astype(v.dtype)
        outs.append(jnp.einsum('bhqk,bhkd->bhqd', a, v[:, :, :q1]))
    return jnp.concatenate(outs, axis=2)


def ssd_scan(x, dt, a, b, c):
    bsz, L, H, P = x.shape
    G, N = b.shape[-2], b.shape[-1]
    nc = L // CHUNK
    hg = H // G
    x = x.reshape(bsz, nc, CHUNK, G, hg, P)
    dt = dt.reshape(bsz, nc, CHUNK, G, hg)
    b = b.reshape(bsz, nc, CHUNK, G, N)
    c = c.reshape(bsz, nc, CHUNK, G, N)
    xdt = x * dt[..., None].astype(x.dtype)
    a_cs = jnp.cumsum(dt * a.reshape(G, hg), axis=2)
    seg = a_cs[:, :, :, None] - a_cs[:, :, None, :]
    tril = jnp.tril(jnp.ones((CHUNK, CHUNK), dtype=bool))[:, :, None, None]
    decay = jnp.exp(jnp.where(tril, seg, -jnp.inf))
    cb = jnp.einsum('bclgn,bcsgn->bclsg', c, b)
    y_diag = jnp.einsum('bclsg,bclsgh,bcsghp->bclghp', cb, decay, xdt)
    decay_states = jnp.exp(a_cs[:, :, -1:] - a_cs)
    states = jnp.einsum('bcsgn,bcsgh,bcsghp->bcghpn', b, decay_states, xdt)
    chunk_decay = jnp.exp(a_cs[:, :, -1])

    def step(h, inp):
        st, dec = inp
        h_new = h * dec[..., None, None] + st
        return h_new, h

    init = jnp.zeros((bsz, G, hg, P, N), dtype=states.dtype)
    _, prev = lax.scan(step, init, (states.swapaxes(0, 1), chunk_decay.swapaxes(0, 1)))
    prev = prev.swapaxes(0, 1)
    y_off = jnp.einsum('bclgn,bcghpn,bclgh->bclghp', c, prev, jnp.exp(a_cs))
    return (y_diag + y_off).reshape(bsz, L, H, P)


def hybrid_layer(x, layer, norm_w, w_in, b_forget, conv_w, conv_b, dt_bias, a_log,
                 d_skip, ssm_norm_w, diff_lambda, subln_w, w_branch, w_out, cos, sin):
    bsz, L, _ = x.shape
    h = rmsnorm(x, norm_w)
    proj = jnp.einsum('bld,de->ble', h, w_in)
    split_points = np.cumsum(SPLIT_SIZES)[:-1].tolist()
    (fq, fk, fv, ff, fg, sz, sxbc, sdt, dq, dk, dv, dg, mg) = jnp.split(proj, split_points, axis=-1)

    def heads(t, n, d):
        return t.reshape(bsz, L, n, d).transpose(0, 2, 1, 3)
    log_f = jax.nn.log_sigmoid((ff + b_forget).astype(jnp.float32)).transpose(0, 2, 1)
    o_a = forgetting_attention(heads(fq, FOX_HEADS, FOX_HD), heads(fk, FOX_HEADS, FOX_HD),
                               heads(fv, FOX_HEADS, FOX_HD), log_f)
    y_a = o_a.transpose(0, 2, 1, 3).reshape(bsz, L, BRANCH_W) * jax.nn.silu(fg)

    xbc = jax.nn.silu(causal_depthwise_conv(sxbc, conv_w, conv_b))
    gn = SSM_GROUPS * SSM_STATE
    xs, bs, cs = jnp.split(xbc, [SSM_W, SSM_W + gn], axis=-1)
    dt = jax.nn.softplus((sdt + dt_bias).astype(jnp.float32))
    a = -jnp.exp(a_log.astype(jnp.float32))
    xh = xs.reshape(bsz, L, SSM_HEADS, SSM_HD)
    y = ssd_scan(xh, dt, a, bs.reshape(bsz, L, SSM_GROUPS, SSM_STATE),
                 cs.reshape(bsz, L, SSM_GROUPS, SSM_STATE))
    y = (y + xh * d_skip[:, None]).reshape(bsz, L, SSM_W)
    yg = (y * jax.nn.silu(sz)).reshape(bsz, L, SSM_GROUPS, SSM_W // SSM_GROUPS)
    y_b = rmsnorm(yg, jnp.ones((SSM_W // SSM_GROUPS,), jnp.float32)).reshape(bsz, L, SSM_W) * ssm_norm_w

    q = partial_rope(dq.reshape(bsz, L, DIFF_HEADS, 2, DIFF_HD), cos, sin).transpose(0, 2, 3, 1, 4)
    k = partial_rope(dk.reshape(bsz, L, DIFF_HEADS, 2, DIFF_HD), cos, sin).transpose(0, 2, 3, 1, 4)
    v = heads(dv, DIFF_HEADS, 2 * DIFF_HD)
    lam_init = 0.8 - 0.6 * math.exp(-0.3 * layer)
    lp = diff_lambda.astype(jnp.float32)
    lam = jnp.exp(jnp.sum(lp[0] * lp[1])) - jnp.exp(jnp.sum(lp[2] * lp[3])) + lam_init
    o_c = differential_attention(q, k, v, lam)
    o_c = rmsnorm(o_c, subln_w) * (1.0 - lam_init)
    y_c = o_c.transpose(0, 2, 1, 3).reshape(bsz, L, DIFF_V_W) * jax.nn.silu(dg)

    gates = jax.nn.sigmoid(mg).reshape(bsz, L, N_BRANCH, D_MODEL)
    branches = jnp.stack([y_a, y_b, y_c], axis=2)
    proj_br = jnp.einsum('blnw,nwd->blnd', branches, w_branch)
    merged = jnp.sum(gates * proj_br, axis=2)
    return x + jnp.einsum('bld,de->ble', merged, w_out)


def setup_inputs(seed: int = 0) -> dict:
    key = jax.random.key(seed)
    ks = jax.random.split(key, 16)
    f32 = jnp.float32
    x = jax.random.normal(ks[0], (BATCH, SEQ, D_MODEL), f32)
    norm_w = 1.0 + 0.02 * jax.random.normal(ks[1], (DEPTH, D_MODEL), f32)
    w_in = jax.random.normal(ks[2], (DEPTH, D_MODEL, N_IN), f32) * D_MODEL ** -0.5
    b_forget = jax.random.uniform(ks[3], (DEPTH, FOX_HEADS), f32, minval=1.0, maxval=4.0)
    conv_w = jax.random.normal(ks[4], (DEPTH, SSM_CONV_K, SSM_CONV_DIM), f32) * SSM_CONV_K ** -0.5
    conv_b = 0.01 * jax.random.normal(ks[5], (DEPTH, SSM_CONV_DIM), f32)
    dt0 = jnp.exp(jax.random.uniform(ks[6], (DEPTH, SSM_HEADS), f32,
                                     minval=math.log(1e-3), maxval=math.log(1e-1)))
    dt_bias = dt0 + jnp.log(-jnp.expm1(-dt0))
    a_log = jnp.log(jax.random.uniform(ks[7], (DEPTH, SSM_HEADS), f32, minval=1.0, maxval=16.0))
    d_skip = 1.0 + 0.02 * jax.random.normal(ks[8], (DEPTH, SSM_HEADS), f32)
    ssm_norm_w = 1.0 + 0.02 * jax.random.normal(ks[9], (DEPTH, SSM_W), f32)
    diff_lambda = 0.1 * jax.random.normal(ks[10], (DEPTH, 4, DIFF_HD), f32)
    subln_w = 1.0 + 0.02 * jax.random.normal(ks[11], (DEPTH, 2 * DIFF_HD), f32)
    w_branch = jax.random.normal(ks[12], (DEPTH, N_BRANCH, BRANCH_W, D_MODEL), f32) * BRANCH_W ** -0.5
    w_out = jax.random.normal(ks[13], (DEPTH, D_MODEL, D_MODEL), f32) * D_MODEL ** -0.5
    final_norm_w = 1.0 + 0.02 * jax.random.normal(ks[14], (D_MODEL,), f32)
    return {'x': x, 'norm_w': norm_w, 'w_in': w_in, 'b_forget': b_forget, 'conv_w': conv_w,
            'conv_b': conv_b, 'dt_bias': dt_bias, 'a_log': a_log, 'd_skip': d_skip,
            'ssm_norm_w': ssm_norm_w, 'diff_lambda': diff_lambda, 'subln_w': subln_w,
            'w_branch': w_branch, 'w_out': w_out, 'final_norm_w': final_norm_w}


def reference(x, norm_w, w_in, b_forget, conv_w, conv_b, dt_bias, a_log, d_skip,
              ssm_norm_w, diff_lambda, subln_w, w_branch, w_out, final_norm_w):
    L = x.shape[1]
    pos = jnp.arange(L, dtype=jnp.float32)
    inv_freq = ROPE_THETA ** (-jnp.arange(0, ROT_DIM, 2, dtype=jnp.float32) / ROT_DIM)
    ang = pos[:, None] * inv_freq[None, :]
    cos = jnp.cos(ang)[:, None, None, :]
    sin = jnp.sin(ang)[:, None, None, :]
    for layer in range(DEPTH):
        x = hybrid_layer(x, layer, norm_w[layer], w_in[layer], b_forget[layer], conv_w[layer],
                         conv_b[layer], dt_bias[layer], a_log[layer], d_skip[layer],
                         ssm_norm_w[layer], diff_lambda[layer], subln_w[layer],
                         w_branch[layer], w_out[layer], cos, sin)
    return rmsnorm(x, final_norm_w)
```

```cpp
#include <hip/hip_runtime.h>
#include <hip/hip_cooperative_groups.h>
#include <cstdio>
#include <cstdint>
#include <cstddef>
#include <cmath>
namespace cg = cooperative_groups;
namespace pg8 {
#define PG8_LAS __attribute__((address_space(3)))
typedef unsigned short bf16_t;
typedef short bf16x8 __attribute__((ext_vector_type(8)));
typedef float f32x4 __attribute__((ext_vector_type(4)));
typedef unsigned u32x4 __attribute__((ext_vector_type(4)));
constexpr int BM = 256, BK = 64, HALF = 128, HTB = HALF * BK * 2  , STAGE_BYTES = 8 * HTB, NXCD = 8, WGM = 8;

__host__ __device__ __forceinline__ int lds_byte(int r, int c) { const int st = (r >> 4) * 2 + (c >> 5), rr = r & 15, cc = c & 31, ob = rr * 64 + cc * 2; return st * 1024 + (ob ^ (((ob >> 9) & 1) << 5)); }
__host__ __device__ __forceinline__ void stage_rc(int b, int& R, int& C) { const int st = b / 1024, sb = b % 1024, swz = sb ^ (((sb >> 9) & 1) << 5); R = (st >> 1) * 16 + swz / 64; C = (st & 1) * 32 + (swz % 64) / 2; }
__host__ __device__ __forceinline__ int perm32(int rho) { const int n = rho >> 4, i = rho & 15; return 8 * (i >> 2) + 4 * n + (i & 3); }

struct Unit { int pm, pn; };
struct Gemm { const bf16_t* A; const bf16_t* Bt; int M, N, K, lda; };

struct StaticOrder {
    int nM, nN, nwg, G, c;
    __host__ __device__ void init(int M, int N, int G_, int c_) { nM = M / BM; nN = N / BM; nwg = nM * nN; G = G_; c = c_; }
    __host__ __device__ bool next(int i, Unit& u) const {
        const long L = (long)i * G + c; if (L >= nwg) return false;
        int wgid = (int)L; { const int q = nwg / NXCD, r = nwg % NXCD, xcd = wgid % NXCD, off = wgid / NXCD; wgid = (xcd < r ? xcd * (q + 1) : r * (q + 1) + (xcd - r) * q) + off; }
        const int nig = WGM * nN, gid = wgid / nig, fm = gid * WGM, gsz = (nM - fm) < WGM ? (nM - fm) : WGM;
        u.pm = fm + ((wgid % nig) % gsz); u.pn = (wgid % nig) / gsz; return true;
    }
    __device__ __forceinline__ void a_ready(const Unit&) const {}
    __device__ __forceinline__ void done(const Unit&) const {}
};

__device__ __forceinline__ unsigned cvt_pk_bf16(float lo, float hi) { unsigned r; asm volatile("v_cvt_pk_bf16_f32 %0, %1, %2" : "=v"(r) : "v"(lo), "v"(hi)); return r; }

typedef unsigned u32x2 __attribute__((ext_vector_type(2)));
constexpr int LDP = 14336;
__device__ __forceinline__ float silu_f(float v) { return v * __builtin_amdgcn_rcpf(1.0f + __expf(-v)); }
__device__ __forceinline__ float sigm_f(float v) { return __builtin_amdgcn_rcpf(1.0f + __expf(-v)); }
__device__ __forceinline__ float bflo(unsigned w) { return __uint_as_float(w << 16); }
__device__ __forceinline__ float bfhi(unsigned w) { return __uint_as_float(w & 0xffff0000u); }

struct EpiProj {
    static constexpr bool PERM = true, AFTER_DRAIN = false;
    bf16_t* P; float* small; const float* sbias;
    __device__ __forceinline__ void operator()(const f32x4 (&acc)[2][2][4][2], const Unit& u, int wr, int wc, int fr, int fq) const {
        asm volatile("" : "+v"(fr));
        const int row0 = u.pm * BM + wr * 64 + fr;
        if (u.pn < 56) {
            const int pn = u.pn;
            const int mode = (pn < 12) ? 0 : (pn < 20) ? 1 : (pn < 40) ? 0 : (pn < 44) ? 1 : 2;
            const int col0 = pn * BM + wc * 32 + 8 * fq;
#pragma unroll
            for (int ai = 0; ai < 2; ++ai)
#pragma unroll
                for (int m = 0; m < 4; ++m) { bf16_t* rowp = P + (size_t)(row0 + ai * HALF + m * 16) * LDP + col0;
#pragma unroll
                    for (int bj = 0; bj < 2; ++bj) { f32x4 v0 = acc[ai][bj][m][0], v1 = acc[ai][bj][m][1];
                        if (mode == 1) {
#pragma unroll
                            for (int i = 0; i < 4; ++i) { v0[i] = silu_f(v0[i]); v1[i] = silu_f(v1[i]); } }
                        else if (mode == 2) {
#pragma unroll
                            for (int i = 0; i < 4; ++i) { v0[i] = sigm_f(v0[i]); v1[i] = sigm_f(v1[i]); } }
                        u32x4 w; w.x = cvt_pk_bf16(v0[0], v0[1]); w.y = cvt_pk_bf16(v0[2], v0[3]); w.z = cvt_pk_bf16(v1[0], v1[1]); w.w = cvt_pk_bf16(v1[2], v1[3]);
                        *(u32x4*)(rowp + bj * HALF) = w; } }
        } else if (wc == 0) {
            const float* sbp = sbias; asm volatile("" : "+s"(sbp));
            f32x4 bb[2]; bb[0] = *(const f32x4*)(sbp + 8 * fq); bb[1] = *(const f32x4*)(sbp + 8 * fq + 4);
#pragma unroll
            for (int ai = 0; ai < 2; ++ai)
#pragma unroll
                for (int m = 0; m < 4; ++m) { const int row = row0 + ai * HALF + m * 16;
#pragma unroll
                    for (int n = 0; n < 2; ++n) { f32x4 o;
#pragma unroll
                        for (int i = 0; i < 4; ++i) { const int c = 8 * fq + 4 * n + i; const float v = acc[ai][0][m][n][i];
                            const float xx = v + bb[n][i];
                            const float sp = __logf(1.0f + __expf(-fabsf(xx)));
                            o[i] = (c < 16) ? (fminf(xx, 0.f) - sp) : (fmaxf(xx, 0.f) + sp); }
                        *(f32x4*)(small + (size_t)row * 32 + 8 * fq + 4 * n) = o; } }
        }
    }
};
struct EpiGate {
    static constexpr bool PERM = false, AFTER_DRAIN = false;
    const bf16_t* gate; float* m32; bf16_t* m16; int nidx;
    __device__ __forceinline__ void operator()(const f32x4 (&acc)[2][2][4][2], const Unit& u, int wr, int wc, int fr, int fq) const {
        asm volatile("" : "+v"(fr));
        const int row0 = u.pm * BM + wr * 64 + fr, col0 = u.pn * BM + wc * 32 + 4 * fq;
#pragma unroll
        for (int ai = 0; ai < 2; ++ai)
#pragma unroll
            for (int m = 0; m < 4; ++m) { const int row = row0 + ai * HALF + m * 16;
#pragma unroll
                for (int bj = 0; bj < 2; ++bj)
#pragma unroll
                    for (int n = 0; n < 2; ++n) { const int col = col0 + bj * HALF + n * 16;
                        const u32x2 gw = *(const u32x2*)(gate + (size_t)row * LDP + col);
                        f32x4 v = acc[ai][bj][m][n];
                        v[0] *= bflo(gw.x); v[1] *= bfhi(gw.x); v[2] *= bflo(gw.y); v[3] *= bfhi(gw.y);
                        float* mp = m32 + (size_t)row * 1024 + col; bf16_t* hp = m16 + (size_t)row * 1024 + col;
                        if (nidx == 0) *(f32x4*)mp = v;
                        else { if (nidx == 1) { const u32x2 t2 = *(const u32x2*)hp; v += *(const f32x4*)mp; v[0] += bflo(t2.x); v[1] += bfhi(t2.x); v[2] += bflo(t2.y); v[3] += bfhi(t2.y); }
                            u32x2 w; w.x = cvt_pk_bf16(v[0], v[1]); w.y = cvt_pk_bf16(v[2], v[3]); *(u32x2*)hp = w; } } }
    }
};
struct EpiRes {
    static constexpr bool PERM = false, AFTER_DRAIN = false;
    const float* xin; float* out;
    __device__ __forceinline__ void operator()(const f32x4 (&acc)[2][2][4][2], const Unit& u, int wr, int wc, int fr, int fq) const {
        asm volatile("" : "+v"(fr));
        const int row0 = u.pm * BM + wr * 64 + fr, col0 = u.pn * BM + wc * 32 + 4 * fq;
#pragma unroll
        for (int ai = 0; ai < 2; ++ai)
#pragma unroll
            for (int m = 0; m < 4; ++m) { const size_t off = (size_t)(row0 + ai * HALF + m * 16) * 1024 + col0;
#pragma unroll
                for (int bj = 0; bj < 2; ++bj)
#pragma unroll
                    for (int n = 0; n < 2; ++n) { const f32x4 b = *(const f32x4*)(xin + off + bj * HALF + n * 16); *(f32x4*)(out + off + bj * HALF + n * 16) = b + acc[ai][bj][m][n]; } }
    }
};
template <class Epi, class Sched, bool ALIGN_EPI = false, bool SP2 = false>
__device__ __forceinline__ void gemm_phase(PG8_LAS unsigned char* lds, const Gemm g, const Sched& S, const Epi& E, int w0) {
    int lane_; asm volatile("v_mbcnt_lo_u32_b32 %0, -1, 0\n\tv_mbcnt_hi_u32_b32 %0, -1, %0" : "=v"(lane_)); int wid = w0; asm volatile("" : "+s"(wid)); const int tid = wid * 64 + lane_, lane = tid & 63, wr = wid >> 2, wc = wid & 3, fr = lane & 15, fq = lane >> 4;
    const int K = g.K, nt = K / BK;
    unsigned voffA[2], voffB[2];
#pragma unroll
    for (int i = 0; i < 2; ++i) { int R, C; stage_rc(tid * 16 + i * 8192, R, C); const int Rb = Epi::PERM ? ((R & ~31) + perm32(R & 31)) : R;
        voffA[i] = (unsigned)(R * g.lda + C) * 2u; voffB[i] = (unsigned)(Rb * K + C) * 2u; }
    const size_t kstep = (size_t)(BK * 2);
    const size_t hstepA = (size_t)HALF * g.lda * 2, hstepB = (size_t)HALF * K * 2;
    const size_t tstepA = 2 * hstepA, tstepB = 2 * hstepB;
    const unsigned ldsw = (unsigned)wid * 1024u;
    const int aoff = lds_byte(wr * 64 + fr, fq * 8), boff = lds_byte(wc * 32 + fr, fq * 8);
#define PG8_SA(b, h) (((b) * 2 + (h)) * HTB)
#define PG8_SB(b, h) ((4 + (b) * 2 + (h)) * HTB)
#define PG8_STAGE(bufoff, gbase, voff) do { _Pragma("unroll") for (int _i = 0; _i < 2; ++_i) \
        __builtin_amdgcn_global_load_lds((const unsigned*)((const char*)(gbase) + (voff)[_i]), (PG8_LAS unsigned*)(lds + (bufoff) + ldsw + _i * 8192), 16, 0, 0); } while (0)
#define PG8_LDA(dst, b, h) do { _Pragma("unroll") for (int m = 0; m < 4; ++m) _Pragma("unroll") for (int k = 0; k < 2; ++k) dst[m][k] = *(const PG8_LAS bf16x8*)(lds + PG8_SA(b, h) + aoff + m * 2048 + k * 1024); } while (0)
#define PG8_LDB(dst, b, h) do { _Pragma("unroll") for (int n = 0; n < 2; ++n) _Pragma("unroll") for (int k = 0; k < 2; ++k) dst[n][k] = *(const PG8_LAS bf16x8*)(lds + PG8_SB(b, h) + boff + n * 2048 + k * 1024); } while (0)
#define PG8_MMA(ai, bj, At, Bt) do { __builtin_amdgcn_s_setprio(1); _Pragma("unroll") for (int m = 0; m < 4; ++m) _Pragma("unroll") for (int n = 0; n < 2; ++n) _Pragma("unroll") for (int k = 0; k < 2; ++k) \
        acc[ai][bj][m][n] = __builtin_amdgcn_mfma_f32_16x16x32_bf16(Bt[n][k], At[m][k], acc[ai][bj][m][n], 0, 0, 0); __builtin_amdgcn_s_setprio(0); } while (0)
#define PG8_WAIT_V(n) asm volatile("s_waitcnt vmcnt(" #n ")" ::: "memory")
#define PG8_WAIT_L(n) asm volatile("s_waitcnt lgkmcnt(" #n ")" ::: "memory")
#define PG8_BAR __builtin_amdgcn_s_barrier()
#define PG8_SCHED __builtin_amdgcn_sched_barrier(0)
    Unit cur, nxt; int ui = 0;
    if (!S.next(0, cur)) return;
    f32x4 acc[2][2][4][2];
#pragma unroll
    for (int a = 0; a < 2; ++a)
#pragma unroll
        for (int b = 0; b < 2; ++b)
#pragma unroll
            for (int m = 0; m < 4; ++m)
#pragma unroll
                for (int n = 0; n < 2; ++n) acc[a][b][m][n] = (f32x4){0.f, 0.f, 0.f, 0.f};
    bf16x8 At[4][2], B0[2][2], B1[2][2];
    const char* cA = (const char*)g.A + (size_t)cur.pm * tstepA; const char* cB = (const char*)g.Bt + (size_t)cur.pn * tstepB;
    S.a_ready(cur);
    if constexpr (SP2) {
        PG8_STAGE(PG8_SB(0, 0), cB, voffB); PG8_STAGE(PG8_SB(0, 1), cB + hstepB, voffB); PG8_STAGE(PG8_SA(0, 0), cA, voffA); PG8_STAGE(PG8_SA(0, 1), cA + hstepA, voffA);
        if (wr == 1) PG8_BAR;
        PG8_WAIT_V(2); PG8_BAR;
        PG8_STAGE(PG8_SB(1, 0), cB + kstep, voffB); PG8_STAGE(PG8_SA(1, 0), cA + kstep, voffA); PG8_STAGE(PG8_SB(1, 1), cB + hstepB + kstep, voffB);
        PG8_WAIT_V(6); PG8_BAR;
    } else {
        PG8_STAGE(PG8_SB(0, 0), cB, voffB); PG8_STAGE(PG8_SA(0, 0), cA, voffA); PG8_STAGE(PG8_SB(0, 1), cB + hstepB, voffB); PG8_STAGE(PG8_SA(0, 1), cA + hstepA, voffA);
        if (wr == 1) PG8_BAR;
        PG8_WAIT_V(4); PG8_BAR;
        PG8_STAGE(PG8_SB(1, 0), cB + kstep, voffB); PG8_STAGE(PG8_SA(1, 0), cA + kstep, voffA); PG8_STAGE(PG8_SB(1, 1), cB + hstepB + kstep, voffB);
        PG8_WAIT_V(6); PG8_BAR;
    }
    for (;;) {
        const bool has_next = S.next(ui + 1, nxt);
        const char* nA = has_next ? (const char*)g.A + (size_t)nxt.pm * tstepA : cA; const char* nB = has_next ? (const char*)g.Bt + (size_t)nxt.pn * tstepB : cB;
        for (int t = 0; t < nt; t += 2) {
            const bool last = (t == nt - 2);
            const char* a1 = cA + (size_t)(t + 1) * kstep;
            const char* a2 = last ? nA : cA + (size_t)(t + 2) * kstep; const char* b2 = last ? nB : cB + (size_t)(t + 2) * kstep;
            const char* a3 = a2 + kstep; const char* b3 = b2 + kstep;
            if (last && has_next) S.a_ready(nxt);
            if constexpr (SP2) {
            PG8_LDB(B0, 0, 0); PG8_LDB(B1, 0, 1); PG8_SCHED; PG8_LDA(At, 0, 0); PG8_STAGE(PG8_SA(1, 1), a1 + hstepA, voffA);
            PG8_WAIT_V(8); PG8_WAIT_L(0); PG8_BAR; PG8_MMA(0, 0, At, B0); PG8_MMA(0, 1, At, B1); PG8_BAR; PG8_SCHED;
            PG8_LDA(At, 0, 1); PG8_STAGE(PG8_SB(0, 0), b2, voffB); PG8_STAGE(PG8_SB(0, 1), b2 + hstepB, voffB); PG8_STAGE(PG8_SA(0, 0), a2, voffA);
            PG8_WAIT_V(8); PG8_WAIT_L(0); PG8_BAR; PG8_MMA(1, 0, At, B0); PG8_MMA(1, 1, At, B1); PG8_BAR; PG8_SCHED;
            PG8_LDB(B0, 1, 0); PG8_LDB(B1, 1, 1); PG8_SCHED; PG8_LDA(At, 1, 0); PG8_STAGE(PG8_SA(0, 1), a2 + hstepA, voffA);
            PG8_WAIT_V(8); PG8_WAIT_L(0); PG8_BAR; PG8_MMA(0, 0, At, B0); PG8_MMA(0, 1, At, B1); PG8_BAR; PG8_SCHED;
            PG8_LDA(At, 1, 1); PG8_STAGE(PG8_SB(1, 0), b3, voffB); PG8_STAGE(PG8_SB(1, 1), b3 + hstepB, voffB); PG8_STAGE(PG8_SA(1, 0), a3, voffA);
            PG8_WAIT_V(8); PG8_WAIT_L(0); PG8_BAR; PG8_MMA(1, 0, At, B0); PG8_MMA(1, 1, At, B1); PG8_BAR; PG8_SCHED;
            } else {
            PG8_LDB(B0, 0, 0); PG8_SCHED; PG8_LDA(At, 0, 0); PG8_STAGE(PG8_SA(1, 1), a1 + hstepA, voffA);
            PG8_WAIT_L(8); PG8_BAR; PG8_WAIT_L(0); PG8_MMA(0, 0, At, B0); PG8_BAR; PG8_SCHED;
            PG8_LDB(B1, 0, 1); PG8_STAGE(PG8_SB(0, 0), b2, voffB);
            PG8_BAR; PG8_WAIT_L(0); PG8_MMA(0, 1, At, B1); PG8_BAR;
            PG8_LDA(At, 0, 1); PG8_STAGE(PG8_SA(0, 0), a2, voffA);
            PG8_BAR; PG8_WAIT_L(0); PG8_MMA(1, 0, At, B0); PG8_BAR; PG8_SCHED;
            PG8_STAGE(PG8_SB(0, 1), b2 + hstepB, voffB);
            PG8_WAIT_V(6); PG8_BAR; PG8_MMA(1, 1, At, B1); PG8_BAR;
            PG8_LDB(B0, 1, 0); PG8_SCHED; PG8_LDA(At, 1, 0); PG8_STAGE(PG8_SA(0, 1), a2 + hstepA, voffA);
            PG8_WAIT_L(8); PG8_BAR; PG8_WAIT_L(0); PG8_MMA(0, 0, At, B0); PG8_BAR; PG8_SCHED;
            PG8_LDB(B1, 1, 1); PG8_STAGE(PG8_SB(1, 0), b3, voffB);
            PG8_BAR; PG8_WAIT_L(0); PG8_MMA(0, 1, At, B1); PG8_BAR;
            PG8_LDA(At, 1, 1); PG8_STAGE(PG8_SA(1, 0), a3, voffA);
            PG8_BAR; PG8_WAIT_L(0); PG8_MMA(1, 0, At, B0); PG8_BAR; PG8_SCHED;
            PG8_STAGE(PG8_SB(1, 1), b3 + hstepB, voffB);
            PG8_WAIT_V(6); PG8_BAR; PG8_MMA(1, 1, At, B1); PG8_BAR;
            }
        }
        if constexpr (ALIGN_EPI) { if (wr == 0) PG8_BAR; }
        if constexpr (!Epi::AFTER_DRAIN) { E(acc, cur, wr, wc, fr, fq); S.done(cur); }
        if (!has_next) break;
#pragma unroll
        for (int a = 0; a < 2; ++a)
#pragma unroll
            for (int b = 0; b < 2; ++b)
#pragma unroll
                for (int m = 0; m < 4; ++m)
#pragma unroll
                    for (int n = 0; n < 2; ++n) acc[a][b][m][n] = (f32x4){0.f, 0.f, 0.f, 0.f};
        cur = nxt; cA = nA; cB = nB; ++ui;
        if constexpr (ALIGN_EPI) { if (wr == 1) PG8_BAR; }
    }
    PG8_WAIT_V(0);
    if constexpr (!ALIGN_EPI) { if (wr == 0) PG8_BAR; }
    PG8_BAR;
    if constexpr (Epi::AFTER_DRAIN) { E.fused(acc, cur, wr, wc, fr, fq, lds, wid, lane); S.done(cur); }
#undef PG8_SA
#undef PG8_SB
#undef PG8_STAGE
#undef PG8_LDA
#undef PG8_LDB
#undef PG8_MMA
#undef PG8_WAIT_V
#undef PG8_WAIT_L
#undef PG8_BAR
#undef PG8_SCHED
}
}

#define LAS __attribute__((address_space(3)))
typedef unsigned short bf16_t;
typedef short bf16x8 __attribute__((ext_vector_type(8)));
typedef short v4i16_t __attribute__((ext_vector_type(4)));
typedef float f32x4 __attribute__((ext_vector_type(4)));
typedef float f32x16 __attribute__((ext_vector_type(16)));
typedef unsigned u32x4 __attribute__((ext_vector_type(4)));
typedef unsigned u32x2 __attribute__((ext_vector_type(2)));
typedef float f32x2 __attribute__((ext_vector_type(2)));

constexpr int DM = 1024, SEQ = 2048, NBATCH = 16, MT = NBATCH * SEQ;
constexpr int GB = 4, TG = GB * SEQ, NGRP = NBATCH / GB;
constexpr int LDP = pg8::LDP, NP = 14592, NIN = 14368;
constexpr int C_FQ = 0, C_FK = 1024, C_FV = 2048, C_FG = 3072, C_SZ = 4096, C_XBC = 5120, C_DQ = 7168, C_DK = 8192, C_DV = 9216, C_DG = 10240, C_MG = 11264;
constexpr float EPS = 1e-6f, LOG2E = 1.4426950408889634f, C2 = 0.125f * 1.4426950408889634f;
constexpr int NTHR = 512, NWAVES = 8;
constexpr int LDS_BYTES = 147456, LDS_MISC = 131072 + 8192;

constexpr size_t WS_CTR = 0, WS_BAR = 32768, WS_ROPE = 65536, WS_LAM = WS_ROPE + 131072, WS_WIN = 1u << 20;
constexpr size_t WS_WBR = WS_WIN + (size_t)2 * NP * 1024 * 2;
constexpr size_t WS_WOUT = WS_WBR + (size_t)6 * 1024 * 1024 * 2;
constexpr size_t WS_H = WS_WOUT + (size_t)2 * 1024 * 1024 * 2;
constexpr size_t WS_PROJ = WS_H + (size_t)MT * 1024 * 2;
constexpr size_t WS_SMALL = WS_PROJ + (size_t)TG * LDP * 2;
constexpr size_t WS_F2 = WS_SMALL + (size_t)TG * 32 * 4;
constexpr size_t WS_CD = WS_F2 + (size_t)GB * 16 * SEQ * 4;
constexpr size_t WS_M32 = WS_CD + 65536;
constexpr size_t WS_M16 = WS_M32 + (size_t)TG * 1024 * 4;
constexpr size_t WS_ST = WS_M16 + (size_t)TG * 1024 * 2;
constexpr size_t WS_PREV = WS_ST + (size_t)GB * 32 * 16 * 8192 * 2;
constexpr size_t WS_END = WS_ST + (size_t)GB * 32 * 16 * 8192 * 4;

struct Args { const float* in[15]; float* out; unsigned char* ws; };

__device__ __forceinline__ unsigned f2bf(float f) { unsigned u = __builtin_bit_cast(unsigned, f); return (u + 0x7fffu + ((u >> 16) & 1u)) >> 16; }
__device__ __forceinline__ unsigned pk2(float lo, float hi) { return pg8::cvt_pk_bf16(lo, hi); }
typedef __bf16 bf16x2_t __attribute__((ext_vector_type(2)));
__device__ __forceinline__ unsigned pk2m(float lo, float hi) { const f32x2 v = {lo, hi}; return __builtin_bit_cast(unsigned, __builtin_convertvector(v, bf16x2_t)); }
__device__ __forceinline__ float bflo(unsigned w) { return __uint_as_float(w << 16); }
__device__ __forceinline__ float bfhi(unsigned w) { return __uint_as_float(w & 0xffff0000u); }
__device__ __forceinline__ float bf1(bf16_t b) { return __uint_as_float(((unsigned)b) << 16); }
__device__ __forceinline__ float lx_xor(float v, int mask, int lane) { return __int_as_float(__builtin_amdgcn_ds_bpermute((lane ^ mask) << 2, __float_as_int(v))); }
__device__ __forceinline__ float lx_up(float v, int d, int lane) { return __int_as_float(__builtin_amdgcn_ds_bpermute((lane - d) << 2, __float_as_int(v))); }
__device__ __forceinline__ float wave_sum(float v, int lane) {
#pragma unroll
    for (int o = 1; o < 64; o <<= 1) v += lx_xor(v, o, lane);
    return v;
}
__device__ __forceinline__ int crow(int r, int hi) { return (r & 3) + 8 * (r >> 2) + 4 * hi; }
#define LDS_WAIT() asm volatile("s_waitcnt lgkmcnt(0)" ::: "memory")
#define THREAD_IDS() int lane; asm volatile("v_mbcnt_lo_u32_b32 %0, -1, 0\n\tv_mbcnt_hi_u32_b32 %0, -1, %0" : "=v"(lane)); int wave = w0; asm volatile("" : "+s"(wave)); const int tid = wave * 64 + lane; (void)tid
#define MFMA32(a, b, c) __builtin_amdgcn_mfma_f32_32x32x16_bf16((a), (b), (c), 0, 0, 0)
#define MFMA16(a, b, c) __builtin_amdgcn_mfma_f32_16x16x32_bf16((a), (b), (c), 0, 0, 0)

__device__ __forceinline__ int lbx() { int b = (int)blockIdx.x; asm volatile("" : "+s"(b)); return b; }
__device__ __forceinline__ unsigned char* wsl(unsigned char* p) { asm volatile("" : "+s"(p)); return p; }
__device__ __forceinline__ int q_draw(unsigned* ctr, int w0) { int v = 0; if (w0 == 0) { int lane; asm volatile("v_mbcnt_lo_u32_b32 %0, -1, 0\n\tv_mbcnt_hi_u32_b32 %0, -1, %0" : "=v"(lane)); if (lane == 0) v = (int)atomicAdd(ctr, 1u); } return v; }
__device__ __forceinline__ int q_pub(int drawn, unsigned char* lds, int w0) {
    volatile int* slot = (volatile int*)(lds + LDS_MISC);
    __syncthreads();
    if (w0 == 0) { int lane; asm volatile("v_mbcnt_lo_u32_b32 %0, -1, 0\n\tv_mbcnt_hi_u32_b32 %0, -1, %0" : "=v"(lane)); if (lane == 0) *slot = drawn; }
    __syncthreads();
    return *slot;
}
#define UNIT_LOOP(ctr_, total_, body_) do { unsigned* c__ = (ctr_); \
    for (;;) { const int d__ = q_draw(c__, wave0); const int u = q_pub(d__, lds, wave0); if (u >= (total_)) break; body_ } } while (0)

__device__ __forceinline__ int win_src_col(int n) {
    if (n < 3072) return n;
    if (n < 7168) return n + 16;
    if (n < 14336) return n + 32;
    if (n < 14352) return 3072 + (n - 14336);
    if (n < 14368) return 7184 + (n - 14352);
    return -1;
}
template <bool MAP> __device__ __forceinline__ void transpose_item(const float* W, int K, int Nsrc, bf16_t* WT, float* scr, int kb, int nb, int lane) {
    const int k0 = 64 * kb, n0 = 32 * nb;
    const int nn = n0 + (lane & 31); const int src = MAP ? win_src_col(nn) : nn;
#pragma unroll 8
    for (int i = 0; i < 32; ++i) { const int kk = 2 * i + (lane >> 5); scr[kk * 33 + (lane & 31)] = (src >= 0) ? W[(size_t)(k0 + kk) * Nsrc + src] : 0.f; }
    LDS_WAIT();
    const int c = lane & 7;
#pragma unroll
    for (int j = 0; j < 4; ++j) { const int n = (lane >> 3) + 8 * j; const float* s = scr + (8 * c) * 33 + n;
        u32x4 o; o.x = pk2(s[0 * 33], s[1 * 33]); o.y = pk2(s[2 * 33], s[3 * 33]); o.z = pk2(s[4 * 33], s[5 * 33]); o.w = pk2(s[6 * 33], s[7 * 33]);
        *(u32x4*)(WT + (size_t)(n0 + n) * K + k0 + 8 * c) = o; }
    LDS_WAIT();
}
__device__ __forceinline__ void p0_prologue(const Args& a, unsigned char* lds, int w0) {
    THREAD_IDS();
    unsigned char* ws = wsl(a.ws);
    float* scr = (float*)(lds + wave * 8448);
    const int gw = blockIdx.x * NWAVES + wave, NGW = gridDim.x * NWAVES;
    constexpr int I_IN = 16 * (NP / 32), I_SQ = 16 * 32;
    constexpr int NITEMS = 2 * I_IN + 8 * I_SQ;
    for (int it = gw; it < NITEMS; it += NGW) {
        int r = it;
        if (r < 2 * I_IN) { const int layer = r / I_IN; r -= layer * I_IN;
            transpose_item<true>(a.in[2] + (size_t)layer * 1024 * NIN, 1024, NIN, (bf16_t*)(ws + WS_WIN) + (size_t)layer * NP * 1024, scr, r / (NP / 32), r % (NP / 32), lane); continue; }
        r -= 2 * I_IN;
        if (r < 6 * I_SQ) { const int mi = r / I_SQ; r -= mi * I_SQ;
            transpose_item<false>(a.in[12] + (size_t)mi * 1024 * 1024, 1024, 1024, (bf16_t*)(ws + WS_WBR) + (size_t)mi * 1024 * 1024, scr, r / 32, r % 32, lane); continue; }
        r -= 6 * I_SQ;
        { const int mi = r / I_SQ; r -= mi * I_SQ;
            transpose_item<false>(a.in[13] + (size_t)mi * 1024 * 1024, 1024, 1024, (bf16_t*)(ws + WS_WOUT) + (size_t)mi * 1024 * 1024, scr, r / 32, r % 32, lane); }
    }
    for (int idx = blockIdx.x * NTHR + tid; idx < SEQ * 8; idx += gridDim.x * NTHR) {
        const int pos = idx >> 3, i = idx & 7;
        const float inv = powf(500000.0f, -(float)(2 * i) / 16.0f);
        const float ang = (float)pos * inv;
        ((f32x2*)(ws + WS_ROPE))[idx] = (f32x2){cosf(ang), sinf(ang)};
    }
    if (blockIdx.x == 0) {
        if (tid < 128) ((unsigned*)(ws + WS_CTR))[tid * 64] = 0u;
        if (tid >= 128 && tid < 192) { const int k = tid - 128, layer = k >> 5, c = k & 31;
            ((float*)(ws + WS_LAM))[16 + k] = (c < 16) ? a.in[3][layer * 16 + c] : a.in[6][layer * 16 + c - 16]; }
        if (tid >= 64 && tid < 66) { const int layer = tid - 64; const float* lp = a.in[10] + layer * 256;
            float s1 = 0.f, s2 = 0.f;
            for (int d = 0; d < 64; ++d) { s1 += lp[d] * lp[64 + d]; s2 += lp[128 + d] * lp[192 + d]; }
            const float li = 0.8f - 0.6f * expf(-0.3f * (float)layer);
            ((float*)(ws + WS_LAM))[layer * 2] = expf(s1) - expf(s2) + li; ((float*)(ws + WS_LAM))[layer * 2 + 1] = li; }
    }
}
template <bool TOBF> __device__ __forceinline__ void norm_rows(const float* X, const float* w, bf16_t* ob, float* of, int w0) {
    THREAD_IDS();
    const int gw = blockIdx.x * NWAVES + wave, NGW = gridDim.x * NWAVES;
    f32x4 wv[4];
#pragma unroll
    for (int j = 0; j < 4; ++j) wv[j] = ((const f32x4*)w)[64 * j + lane];
    for (int m = gw; m < MT; m += 2 * NGW) {
        const int m2 = m + NGW;
        const f32x4* xr = (const f32x4*)(X + (size_t)m * DM) + lane; const f32x4* xr2 = (const f32x4*)(X + (size_t)m2 * DM) + lane;
        f32x4 v[4], v2[4]; float s = 0.f, s2 = 0.f;
#pragma unroll
        for (int j = 0; j < 4; ++j) { v[j] = xr[64 * j]; v2[j] = xr2[64 * j]; }
#pragma unroll
        for (int j = 0; j < 4; ++j) { s += (v[j].x * v[j].x + v[j].y * v[j].y) + (v[j].z * v[j].z + v[j].w * v[j].w); s2 += (v2[j].x * v2[j].x + v2[j].y * v2[j].y) + (v2[j].z * v2[j].z + v2[j].w * v2[j].w); }
        const float rs = rsqrtf(wave_sum(s, lane) * (1.0f / DM) + EPS), rs2 = rsqrtf(wave_sum(s2, lane) * (1.0f / DM) + EPS);
#pragma unroll
        for (int j = 0; j < 4; ++j) { const f32x4 o = v[j] * rs * wv[j], o2 = v2[j] * rs2 * wv[j];
            if (TOBF) { u32x2 p; p.x = pk2(o.x, o.y); p.y = pk2(o.z, o.w); ((u32x2*)(ob + (size_t)m * DM))[64 * j + lane] = p;
                        u32x2 q; q.x = pk2(o2.x, o2.y); q.y = pk2(o2.z, o2.w); ((u32x2*)(ob + (size_t)m2 * DM))[64 * j + lane] = q; }
            else { ((f32x4*)(of + (size_t)m * DM))[64 * j + lane] = o; ((f32x4*)(of + (size_t)m2 * DM))[64 * j + lane] = o2; } }
    }
}

constexpr int SL_ACS = 0, SL_DT = 1024, SL_PART = 2048, SL_XT = 4096, SL_B = SL_XT + 256 * 144, SL_C = SL_B + 18432;
constexpr int XTP = 144, BNP = 272;

__device__ __forceinline__ void ssd_acs(unsigned char* lds, const float* small, size_t row0, int g, const float* a_log, int wave, int lane) {
    if (wave < 4) {
        const int h = 4 * g + wave;
        const float dt = small[(row0 + lane) * 32 + 16 + h];
        float v = -expf(a_log[h]) * dt;
#pragma unroll
        for (int o = 1; o < 64; o <<= 1) { const float t = lx_up(v, o, lane); if (lane >= o) v += t; }
        ((float*)(lds + SL_ACS))[wave * 64 + lane] = v;
        ((float*)(lds + SL_DT))[wave * 64 + lane] = dt;
    }
}
__device__ __forceinline__ void conv8x8(float (&out)[8][8], const bf16_t* xb, int pg, int c, const float* cw, const float* cb) {
    u32x4 raw[11];
#pragma unroll
    for (int i = 0; i < 11; ++i) { const int rr = pg * 8 - 3 + i;
        if (rr >= 0 || c > 0) raw[i] = *(const u32x4*)(xb + (ptrdiff_t)rr * LDP); else raw[i] = (u32x4){0u, 0u, 0u, 0u}; }
    float w[4][8], bias[8];
#pragma unroll
    for (int k = 0; k < 4; ++k) { const f32x4 a = *(const f32x4*)(cw + k * 2048), b = *(const f32x4*)(cw + k * 2048 + 4);
        w[k][0] = a.x; w[k][1] = a.y; w[k][2] = a.z; w[k][3] = a.w; w[k][4] = b.x; w[k][5] = b.y; w[k][6] = b.z; w[k][7] = b.w; }
    { const f32x4 a = *(const f32x4*)cb, b = *(const f32x4*)(cb + 4); bias[0] = a.x; bias[1] = a.y; bias[2] = a.z; bias[3] = a.w; bias[4] = b.x; bias[5] = b.y; bias[6] = b.z; bias[7] = b.w; }
#pragma unroll
    for (int p = 0; p < 8; ++p) {
#pragma unroll
        for (int ch = 0; ch < 8; ++ch) { float s = bias[ch];
#pragma unroll
            for (int k = 0; k < 4; ++k) { const unsigned wd = raw[p + k][ch >> 1]; const float u = (ch & 1) ? bfhi(wd) : bflo(wd); s += w[k][ch] * u; }
            out[p][ch] = pg8::silu_f(s); }
    }
}
__device__ __forceinline__ void put_T(unsigned char* img, int chrow0, int s0, const float (&v)[8][8]) {
#pragma unroll
    for (int ch = 0; ch < 8; ++ch) { u32x4 o; o.x = pk2(v[0][ch], v[1][ch]); o.y = pk2(v[2][ch], v[3][ch]); o.z = pk2(v[4][ch], v[5][ch]); o.w = pk2(v[6][ch], v[7][ch]);
        *(u32x4*)(img + (chrow0 + ch) * XTP + s0 * 2) = o; }
}
__device__ __forceinline__ void put_N(unsigned char* img, int n0, int s0, const float (&v)[8][8]) {
#pragma unroll
    for (int p = 0; p < 8; ++p) { u32x4 o; o.x = pk2(v[p][0], v[p][1]); o.y = pk2(v[p][2], v[p][3]); o.z = pk2(v[p][4], v[p][5]); o.w = pk2(v[p][6], v[p][7]);
        *(u32x4*)(img + (s0 + p) * BNP + n0 * 2) = o; }
}

__device__ __forceinline__ void ssd_states_unit(const Args& a, int layer, int u, unsigned char* lds, int w0) {
    THREAD_IDS();
    const int g = u & 3, c = (u >> 2) & 31, bl = u >> 7;
    unsigned char* ws = wsl(a.ws);
    const bf16_t* PROJ = (const bf16_t*)(ws + WS_PROJ);
    const size_t row0 = (size_t)bl * SEQ + c * 64;
    ssd_acs(lds, (const float*)(ws + WS_SMALL), row0, g, a.in[7] + layer * 16, wave, lane);
    __syncthreads();
    const float* ACS = (const float*)(lds + SL_ACS); const float* DTL = (const float*)(lds + SL_DT);
    const int cgi = tid & 63, pg = tid >> 6;
    if (cgi < 48) {
        const int chx = (cgi < 32) ? (g * 256 + cgi * 8) : (1024 + g * 128 + (cgi - 32) * 8);
        float v[8][8];
        conv8x8(v, PROJ + row0 * LDP + C_XBC + chx, pg, c, a.in[4] + (size_t)layer * 4 * 2048 + chx, a.in[5] + layer * 2048 + chx);
        if (cgi < 32) { const int hh = cgi >> 3; const float al = ACS[hh * 64 + 63];
#pragma unroll
            for (int p = 0; p < 8; ++p) { const int s = pg * 8 + p; const float sc = __expf(al - ACS[hh * 64 + s]) * DTL[hh * 64 + s];
#pragma unroll
                for (int ch = 0; ch < 8; ++ch) v[p][ch] *= sc; }
            put_T(lds + SL_XT, cgi * 8, pg * 8, v);
        } else put_T(lds + SL_B, (cgi - 32) * 8, pg * 8, v);
    }
    __syncthreads();
    const int fr = lane & 15, fq = lane >> 4, hh = wave >> 1, nh = wave & 1;
    f32x4 acc[4][4];
#pragma unroll
    for (int i = 0; i < 4; ++i)
#pragma unroll
        for (int j = 0; j < 4; ++j) acc[i][j] = (f32x4){0.f, 0.f, 0.f, 0.f};
    {   bf16x8 af[2][4], bf[2][4];
#pragma unroll
        for (int ks = 0; ks < 2; ++ks) {
#pragma unroll
            for (int i = 0; i < 4; ++i) af[ks][i] = *(const bf16x8*)(lds + SL_B + (64 * nh + 16 * i + fr) * XTP + (32 * ks + 8 * fq) * 2);
#pragma unroll
            for (int j = 0; j < 4; ++j) bf[ks][j] = *(const bf16x8*)(lds + SL_XT + (hh * 64 + 16 * j + fr) * XTP + (32 * ks + 8 * fq) * 2); }
        __builtin_amdgcn_sched_barrier(0);
#pragma unroll
        for (int ks = 0; ks < 2; ++ks)
#pragma unroll
            for (int i = 0; i < 4; ++i)
#pragma unroll
                for (int j = 0; j < 4; ++j) acc[i][j] = MFMA16(af[ks][i], bf[ks][j], acc[i][j]);
    }
    const int h = 4 * g + hh;
    bf16_t* ST = (bf16_t*)(ws + WS_ST) + ((size_t)(bl * 32 + c) * 16 + h) * 8192;
#pragma unroll
    for (int i = 0; i < 4; ++i)
#pragma unroll
        for (int j = 0; j < 4; ++j) { u32x2 w; w.x = pk2m(acc[i][j][0], acc[i][j][1]); w.y = pk2m(acc[i][j][2], acc[i][j][3]);
            *(u32x2*)(ST + (16 * j + fr) * 128 + 64 * nh + 16 * i + 4 * fq) = w; }
    if (tid < 4) ((float*)(ws + WS_CD))[(bl * 32 + c) * 16 + 4 * g + tid] = __expf(ACS[tid * 64 + 63]);
}

__device__ __forceinline__ void ssd_scan_unit(const Args& a, int u, int w0) {
    THREAD_IDS();
    const int qt = u & 3, h = (u >> 2) & 15, bl = u >> 6;
    const bf16_t* ST = (const bf16_t*)(wsl(a.ws) + WS_ST); bf16_t* PV = (bf16_t*)(wsl(a.ws) + WS_PREV); const float* CD = (const float*)(wsl(a.ws) + WS_CD);
    const int e = qt * 2048 + tid * 4;
    float z0 = 0.f; asm volatile("" : "+v"(z0));
    f32x4 hc = (f32x4){z0, z0, z0, z0};
#pragma unroll 1
    for (int c0 = 0; c0 < 32; c0 += 16) {
        u32x2 sv[16];
#pragma unroll
        for (int c = 0; c < 16; ++c) sv[c] = *(const u32x2*)(ST + ((size_t)(bl * 32 + c0 + c) * 16 + h) * 8192 + e);
#pragma unroll
        for (int c = 0; c < 16; ++c) { const float dec = CD[(bl * 32 + c0 + c) * 16 + h];
            u32x2 w; w.x = pk2(hc[0], hc[1]); w.y = pk2(hc[2], hc[3]);
            *(u32x2*)(PV + ((size_t)(bl * 32 + c0 + c) * 16 + h) * 8192 + e) = w;
            hc = hc * dec + (f32x4){bflo(sv[c].x), bfhi(sv[c].x), bflo(sv[c].y), bfhi(sv[c].y)}; }
    }
}

__device__ __forceinline__ void ssd_out_unit(const Args& a, int layer, int u, unsigned char* lds, int w0, bool dry = false) {
    THREAD_IDS();
    const int g = u & 3, c = (u >> 2) & 31, bl = u >> 7;
    unsigned char* ws = wsl(a.ws);
    bf16_t* PROJ = (bf16_t*)(ws + WS_PROJ);
    const size_t row0 = (size_t)bl * SEQ + c * 64;
    ssd_acs(lds, (const float*)(ws + WS_SMALL), row0, g, a.in[7] + layer * 16, wave, lane);
    const int cgi = tid & 63, pg = tid >> 6;
    {
        const int chx = (cgi < 32) ? (g * 256 + cgi * 8) : (cgi < 48) ? (1024 + g * 128 + (cgi - 32) * 8) : (1536 + g * 128 + (cgi - 48) * 8);
        float v[8][8];
        conv8x8(v, PROJ + row0 * LDP + C_XBC + chx, pg, c, a.in[4] + (size_t)layer * 4 * 2048 + chx, a.in[5] + layer * 2048 + chx);
        if (cgi < 32) put_T(lds + SL_XT, cgi * 8, pg * 8, v);
        else if (cgi < 48) put_N(lds + SL_B, (cgi - 32) * 8, pg * 8, v);
        else put_N(lds + SL_C, (cgi - 48) * 8, pg * 8, v);
    }
    const int fr = lane & 15, fq = lane >> 4, hh = wave >> 1, lh = wave & 1, h = 4 * g + hh;
    const bf16_t* PV = (const bf16_t*)(ws + WS_PREV) + ((size_t)(bl * 32 + c) * 16 + h) * 8192;
    bf16x8 pa[4][4];
#pragma unroll
    for (int ks = 0; ks < 4; ++ks)
#pragma unroll
        for (int pt = 0; pt < 4; ++pt) pa[ks][pt] = *(const bf16x8*)(PV + (16 * pt + fr) * 128 + 32 * ks + 8 * fq);
    __syncthreads();
    const float* ACS = (const float*)(lds + SL_ACS); const float* DTL = (const float*)(lds + SL_DT);
    f32x4 acc[4][2], dd[4][2];
#pragma unroll
    for (int i = 0; i < 4; ++i)
#pragma unroll
        for (int j = 0; j < 2; ++j) { acc[i][j] = (f32x4){0.f, 0.f, 0.f, 0.f}; dd[i][j] = (f32x4){0.f, 0.f, 0.f, 0.f}; }
    bf16x8 cf[4][2];
#pragma unroll
    for (int ks = 0; ks < 4; ++ks)
#pragma unroll
        for (int lt = 0; lt < 2; ++lt) cf[ks][lt] = *(const bf16x8*)(lds + SL_C + (32 * lh + 16 * lt + fr) * BNP + (32 * ks + 8 * fq) * 2);
    __builtin_amdgcn_sched_barrier(0);
#pragma unroll
    for (int ks = 0; ks < 4; ++ks)
#pragma unroll
        for (int pt = 0; pt < 4; ++pt)
#pragma unroll
            for (int lt = 0; lt < 2; ++lt) acc[pt][lt] = MFMA16(pa[ks][pt], cf[ks][lt], acc[pt][lt]);
    __builtin_amdgcn_sched_barrier(0);
    {   bf16x8 bq[4][4];
#pragma unroll
        for (int ks = 0; ks < 4; ++ks)
#pragma unroll
            for (int st = 0; st < 4; ++st) if (st < 2 || lh) bq[ks][st] = *(const bf16x8*)(lds + SL_B + (16 * st + fr) * BNP + (32 * ks + 8 * fq) * 2);
        __builtin_amdgcn_sched_barrier(0);
#pragma unroll
        for (int ks = 0; ks < 4; ++ks)
#pragma unroll
            for (int st = 0; st < 4; ++st) if (st < 2 || lh) {
#pragma unroll
                for (int lt = 0; lt < 2; ++lt) dd[st][lt] = MFMA16(bq[ks][st], cf[ks][lt], dd[st][lt]); }
    }
    float acl[2];
#pragma unroll
    for (int lt = 0; lt < 2; ++lt) { acl[lt] = ACS[hh * 64 + 32 * lh + 16 * lt + fr]; const float e = __expf(acl[lt]);
#pragma unroll
        for (int pt = 0; pt < 4; ++pt) acc[pt][lt] *= e; }
#pragma unroll
    for (int st = 0; st < 4; ++st) if (st < 2 || lh) {
#pragma unroll
        for (int r = 0; r < 4; ++r) { const int s = 16 * st + 4 * fq + r; const float as = ACS[hh * 64 + s], ds = DTL[hh * 64 + s];
#pragma unroll
            for (int lt = 0; lt < 2; ++lt) { const int l = 32 * lh + 16 * lt + fr; dd[st][lt][r] = (s <= l) ? dd[st][lt][r] * __expf(acl[lt] - as) * ds : 0.f; } }
    }
#pragma unroll
    for (int kk = 0; kk < 2; ++kk) if (kk == 0 || lh) {
        bf16x8 mb[2];
#pragma unroll
        for (int lt = 0; lt < 2; ++lt) { u32x4 w; w.x = pk2(dd[2 * kk][lt][0], dd[2 * kk][lt][1]); w.y = pk2(dd[2 * kk][lt][2], dd[2 * kk][lt][3]);
            w.z = pk2(dd[2 * kk + 1][lt][0], dd[2 * kk + 1][lt][1]); w.w = pk2(dd[2 * kk + 1][lt][2], dd[2 * kk + 1][lt][3]); mb[lt] = __builtin_bit_cast(bf16x8, w); }
#pragma unroll
        for (int pt = 0; pt < 4; ++pt) { const unsigned char* xr = lds + SL_XT + (hh * 64 + 16 * pt + fr) * XTP + (32 * kk + 4 * fq) * 2;
            const u32x2 lo = *(const u32x2*)xr, hi2 = *(const u32x2*)(xr + 32);
            const bf16x8 af = __builtin_bit_cast(bf16x8, (u32x4){lo.x, lo.y, hi2.x, hi2.y});
#pragma unroll
            for (int lt = 0; lt < 2; ++lt) acc[pt][lt] = MFMA16(af, mb[lt], acc[pt][lt]); }
    }
    const float dsk = a.in[8][layer * 16 + h];
    float ss[2] = {0.f, 0.f};
#pragma unroll
    for (int lt = 0; lt < 2; ++lt) { const int l = 32 * lh + 16 * lt + fr;
#pragma unroll
        for (int pt = 0; pt < 4; ++pt) { const int p4 = 16 * pt + 4 * fq;
            const u32x2 zw = *(const u32x2*)(PROJ + (row0 + l) * LDP + C_SZ + h * 64 + p4);
            const float zz[4] = {bflo(zw.x), bfhi(zw.x), bflo(zw.y), bfhi(zw.y)};
#pragma unroll
            for (int r = 0; r < 4; ++r) { const float xv = bf1(*(const bf16_t*)(lds + SL_XT + (hh * 64 + p4 + r) * XTP + l * 2));
                const float y = (acc[pt][lt][r] + xv * dsk) * zz[r]; acc[pt][lt][r] = y; ss[lt] += y * y; } } }
#pragma unroll
    for (int lt = 0; lt < 2; ++lt) { ss[lt] += lx_xor(ss[lt], 16, lane); ss[lt] += lx_xor(ss[lt], 32, lane);
        if (fq == 0) ((float*)(lds + SL_PART))[hh * 64 + 32 * lh + 16 * lt + fr] = ss[lt]; }
    __syncthreads();
    const float* nw = a.in[9] + layer * 1024 + h * 64;
#pragma unroll
    for (int lt = 0; lt < 2; ++lt) { const int l = 32 * lh + 16 * lt + fr; const float* pr = (const float*)(lds + SL_PART);
        const float tot = (pr[l] + pr[64 + l]) + (pr[128 + l] + pr[192 + l]);
        const float rs = rsqrtf(tot * (1.0f / 256.0f) + EPS);
#pragma unroll
        for (int pt = 0; pt < 4; ++pt) { const int p4 = 16 * pt + 4 * fq; const f32x4 wv = *(const f32x4*)(nw + p4);
            u32x2 o; o.x = pk2(acc[pt][lt][0] * rs * wv.x, acc[pt][lt][1] * rs * wv.y); o.y = pk2(acc[pt][lt][2] * rs * wv.z, acc[pt][lt][3] * rs * wv.w);
            if (dry) *(u32x2*)((bf16_t*)(ws + WS_M16) + (row0 + l) * 1024 + h * 64 + p4) = o; else *(u32x2*)(PROJ + (row0 + l) * LDP + C_SZ + h * 64 + p4) = o; } }
}

__device__ __forceinline__ void fcum_unit(const Args& a, int fu, int w0) {
    THREAD_IDS();
    const int task = fu * 8 + wave, bl = task >> 4, h = task & 15;
    const float* sm = (const float*)(wsl(a.ws) + WS_SMALL) + ((size_t)bl * SEQ + lane * 32) * 32 + h;
    float v[32]; float run = 0.f;
#pragma unroll
    for (int i = 0; i < 32; ++i) { run += sm[i * 32]; v[i] = run; }
    float sc = run;
#pragma unroll
    for (int o = 1; o < 64; o <<= 1) { const float t = lx_up(sc, o, lane); if (lane >= o) sc += t; }
    const float off = sc - run;
    float* F = (float*)(wsl(a.ws) + WS_F2) + (size_t)task * SEQ + lane * 32;
#pragma unroll
    for (int i = 0; i < 32; i += 4) *(f32x4*)(F + i) = (f32x4){(off + v[i]) * LOG2E, (off + v[i + 1]) * LOG2E, (off + v[i + 2]) * LOG2E, (off + v[i + 3]) * LOG2E};
}
__device__ __forceinline__ void rope_unit(const Args& a, int ru, int w0) {
    THREAD_IDS();
    const int row = ru * 64 + (tid >> 3), j = tid & 7, pos = row & (SEQ - 1);
    bf16_t* PROJ = (bf16_t*)(wsl(a.ws) + WS_PROJ);
    const f32x2* cs = (const f32x2*)(wsl(a.ws) + WS_ROPE) + pos * 8;
    f32x2 t[8];
#pragma unroll
    for (int i = 0; i < 8; ++i) t[i] = cs[i];
#pragma unroll
    for (int k = 0; k < 4; ++k) { const int hc = 4 * j + k; const int col = (hc < 16) ? (C_DQ + hc * 64) : (C_DK + (hc - 16) * 64);
        u32x4* p = (u32x4*)(PROJ + (size_t)row * LDP + col);
        const u32x4 a1 = p[0], a2 = p[1]; u32x4 o1, o2;
#pragma unroll
        for (int w = 0; w < 4; ++w) {
            const float x1l = bflo(a1[w]), x1h = bfhi(a1[w]), x2l = bflo(a2[w]), x2h = bfhi(a2[w]);
            const f32x2 c0 = t[2 * w], c1 = t[2 * w + 1];
            o1[w] = pk2(x1l * c0.x - x2l * c0.y, x1h * c1.x - x2h * c1.y);
            o2[w] = pk2(x2l * c0.x + x1l * c0.y, x2h * c1.x + x1h * c1.y); }
        p[0] = o1; p[1] = o2; }
}

__device__ __forceinline__ v4i16_t vtr(const unsigned char* p) { return __builtin_amdgcn_ds_read_tr16_b64_v4i16((LAS v4i16_t*)(LAS unsigned char*)p); }
__device__ __forceinline__ float max3f(float a, float b, float c) { float r; asm("v_max3_f32 %0, %1, %2, %3" : "=v"(r) : "v"(a), "v"(b), "v"(c)); return r; }
template <int DV, bool FOX>
__device__ __forceinline__ void attn_pass(f32x16 (&o)[DV / 32], float& l_out, const bf16_t* Qw, const bf16_t* Kb, const bf16_t* Vb, const float* F2,
                                          int q0, unsigned char* lds, int w0) {
    THREAD_IDS(); const int wid = wave;
    constexpr int KP = 144, VP = DV * 2 + 64, OFF_K = 0, OFF_V = 64 * KP, OFF_F = OFF_V + 64 * VP, STAGE = OFF_F + 256, NV = DV / 64;
    const int r32 = lane & 31, hi = lane >> 5;
    const int NT = (q0 + 256) / 64, my_nt = (q0 + 32 * wid) / 64 + 1;
    bf16x8 qf[4];
#pragma unroll
    for (int d0 = 0; d0 < 4; ++d0) qf[d0] = *(const bf16x8*)(Qw + (size_t)r32 * LDP + d0 * 16 + hi * 8);
    float m = -INFINITY, l = 0.f;
#pragma unroll
    for (int i = 0; i < DV / 32; ++i)
#pragma unroll
        for (int r = 0; r < 16; ++r) o[i][r] = 0.f;
    u32x4 kreg, vreg[NV]; float freg = 0.f;
    const int krow = tid >> 3, kch = tid & 7;
#define ATT_LOAD(t) do { kreg = *(const u32x4*)(Kb + (size_t)(64 * (t) + krow) * LDP + kch * 8); \
        _Pragma("unroll") for (int i_ = 0; i_ < NV; ++i_) { const int idx_ = tid + 512 * i_; const int vr_ = (DV == 64) ? (idx_ >> 3) : (idx_ >> 4), vc_ = (DV == 64) ? (idx_ & 7) : (idx_ & 15); \
            vreg[i_] = *(const u32x4*)(Vb + (size_t)(64 * (t) + vr_) * LDP + vc_ * 8); } \
        if (FOX && tid < 64) freg = -F2[64 * (t) + tid]; } while (0)
#define ATT_STORE(sb_) do { *(u32x4*)((sb_) + OFF_K + krow * KP + kch * 16) = kreg; \
        _Pragma("unroll") for (int i_ = 0; i_ < NV; ++i_) { const int idx_ = tid + 512 * i_; const int vr_ = (DV == 64) ? (idx_ >> 3) : (idx_ >> 4), vc_ = (DV == 64) ? (idx_ & 7) : (idx_ & 15); \
            *(u32x4*)((sb_) + OFF_V + vr_ * VP + vc_ * 16) = vreg[i_]; } \
        if (FOX && tid < 64) ((float*)((sb_) + OFF_F))[tid] = freg; } while (0)
    __syncthreads();
    ATT_LOAD(0); ATT_STORE(lds);
    if (NT > 1) ATT_LOAD(1);
    __syncthreads();
    for (int t = 0; t < NT; ++t) {
        const unsigned char* sb = lds + (t & 1) * STAGE;
        if (t < my_nt) {
            bf16x8 kf[8];
#pragma unroll
            for (int d0 = 0; d0 < 4; ++d0) { kf[2 * d0] = *(const bf16x8*)(sb + OFF_K + r32 * KP + d0 * 32 + hi * 16);
                kf[2 * d0 + 1] = *(const bf16x8*)(sb + OFF_K + (32 + r32) * KP + d0 * 32 + hi * 16); }
            const unsigned char* vb = sb + OFF_V + (4 * hi + ((lane & 15) >> 2)) * VP + (16 * ((lane >> 4) & 1) + 4 * (lane & 3)) * 2;
            f32x4 fka[4], fkb[4];
            if (FOX) { const float* fk = (const float*)(sb + OFF_F);
#pragma unroll
                for (int g4 = 0; g4 < 4; ++g4) { fka[g4] = *(const f32x4*)(fk + 8 * g4 + 4 * hi); fkb[g4] = *(const f32x4*)(fk + 32 + 8 * g4 + 4 * hi); } }
            v4i16_t vs[2][DV / 32][2];
#pragma unroll
            for (int dvt = 0; dvt < DV / 32; ++dvt) { vs[0][dvt][0] = vtr(vb + dvt * 64); vs[0][dvt][1] = vtr(vb + 8 * VP + dvt * 64); }
            __builtin_amdgcn_sched_barrier(0);
            f32x16 p0, p1;
#pragma unroll
            for (int r = 0; r < 16; ++r) { p0[r] = 0.f; p1[r] = 0.f; }
#pragma unroll
            for (int d0 = 0; d0 < 4; ++d0) { p0 = MFMA32(kf[2 * d0], qf[d0], p0); p1 = MFMA32(kf[2 * d0 + 1], qf[d0], p1); }
            if (FOX) {
#pragma unroll
                for (int g4 = 0; g4 < 4; ++g4) { const f32x4 fa = fka[g4], fb = fkb[g4];
#pragma unroll
                    for (int i = 0; i < 4; ++i) { p0[4 * g4 + i] = p0[4 * g4 + i] * C2 + fa[i]; p1[4 * g4 + i] = p1[4 * g4 + i] * C2 + fb[i]; } }
                if (t == my_nt - 1) { const int qpos = q0 + 32 * wid + r32;
#pragma unroll
                    for (int r = 0; r < 16; ++r) { const int kp = 64 * t + crow(r, hi); if (kp > qpos) p0[r] = -INFINITY; if (kp + 32 > qpos) p1[r] = -INFINITY; } }
            } else {
                asm volatile("s_nop 15\n\ts_nop 7" : "+v"(p0), "+v"(p1));
            }
            float ma = max3f(p0[0], p0[1], p1[0]), mb = max3f(p0[2], p0[3], p1[1]);
            ma = max3f(ma, p1[2], p1[3]);
#pragma unroll
            for (int r = 4; r < 16; r += 4) { ma = max3f(ma, p0[r], p0[r + 1]); mb = max3f(mb, p0[r + 2], p0[r + 3]); ma = max3f(ma, p1[r], p1[r + 1]); mb = max3f(mb, p1[r + 2], p1[r + 3]); }
            float mx = max3f(ma, mb, ma);
            if (!FOX) mx *= C2;
            mx = max3f(mx, lx_xor(mx, 32, lane), mx);
            if (__any(mx > m)) {
                const float mn = max3f(m, mx, mx), alpha = __builtin_amdgcn_exp2f(m - mn);
                m = mn; l *= alpha;
#pragma unroll
                for (int i = 0; i < DV / 32; ++i)
#pragma unroll
                    for (int r = 0; r < 16; ++r) o[i][r] *= alpha;
            }
            float rsa = 0.f, rsb = 0.f;
#pragma unroll
            for (int r = 0; r < 16; r += 2) {
                f32x2 a = {p0[r], p0[r + 1]}, b = {p1[r], p1[r + 1]};
                if (FOX) { a = a - (f32x2){m, m}; b = b - (f32x2){m, m}; }
                else { a = a * (f32x2){C2, C2} - (f32x2){m, m}; b = b * (f32x2){C2, C2} - (f32x2){m, m}; }
                p0[r] = __builtin_amdgcn_exp2f(a.x); p0[r + 1] = __builtin_amdgcn_exp2f(a.y); p1[r] = __builtin_amdgcn_exp2f(b.x); p1[r + 1] = __builtin_amdgcn_exp2f(b.y);
                rsa += p0[r] + p0[r + 1]; rsb += p1[r] + p1[r + 1]; }
            l += rsa + rsb;
            bf16x8 pf[4];
            { u32x4 w;
              w.x = pk2(p0[0], p0[1]); w.y = pk2(p0[2], p0[3]); w.z = pk2(p0[4], p0[5]); w.w = pk2(p0[6], p0[7]); pf[0] = __builtin_bit_cast(bf16x8, w);
              w.x = pk2(p0[8], p0[9]); w.y = pk2(p0[10], p0[11]); w.z = pk2(p0[12], p0[13]); w.w = pk2(p0[14], p0[15]); pf[1] = __builtin_bit_cast(bf16x8, w);
              w.x = pk2(p1[0], p1[1]); w.y = pk2(p1[2], p1[3]); w.z = pk2(p1[4], p1[5]); w.w = pk2(p1[6], p1[7]); pf[2] = __builtin_bit_cast(bf16x8, w);
              w.x = pk2(p1[8], p1[9]); w.y = pk2(p1[10], p1[11]); w.z = pk2(p1[12], p1[13]); w.w = pk2(p1[14], p1[15]); pf[3] = __builtin_bit_cast(bf16x8, w); }
            __builtin_amdgcn_sched_barrier(0);
#pragma unroll
            for (int ks = 0; ks < 4; ++ks) {
                if (ks + 1 < 4) {
#pragma unroll
                    for (int dvt = 0; dvt < DV / 32; ++dvt) { vs[(ks + 1) & 1][dvt][0] = vtr(vb + 16 * (ks + 1) * VP + dvt * 64); vs[(ks + 1) & 1][dvt][1] = vtr(vb + (16 * (ks + 1) + 8) * VP + dvt * 64); }
                    __builtin_amdgcn_sched_barrier(0);
                }
#pragma unroll
                for (int dvt = 0; dvt < DV / 32; ++dvt) {
                    const v4i16_t lo = vs[ks & 1][dvt][0], h8 = vs[ks & 1][dvt][1];
                    const bf16x8 vf = (bf16x8){lo[0], lo[1], lo[2], lo[3], h8[0], h8[1], h8[2], h8[3]};
                    o[dvt] = MFMA32(vf, pf[ks], o[dvt]);
                }
                __builtin_amdgcn_sched_barrier(0);
            }
        }
        if (t + 1 < NT) { ATT_STORE(lds + ((t + 1) & 1) * STAGE); if (t + 2 < NT) ATT_LOAD(t + 2); }
        __syncthreads();
    }
#undef ATT_LOAD
#undef ATT_STORE
    l_out = l + lx_xor(l, 32, lane);
}

__device__ __forceinline__ void fox_unit(const Args& a, int bh, int qb, unsigned char* lds, int w0, bool dry = false) {
    THREAD_IDS(); const int wid = wave;
    const int bl = bh >> 4, h = bh & 15, q0 = qb * 256, r32 = lane & 31, hi = lane >> 5;
    bf16_t* PROJ = (bf16_t*)(wsl(a.ws) + WS_PROJ);
    const size_t rowb = (size_t)bl * SEQ;
    f32x16 o[2]; float l;
    attn_pass<64, true>(o, l, PROJ + (rowb + q0 + 32 * wid) * LDP + C_FQ + h * 64, PROJ + rowb * LDP + C_FK + h * 64, PROJ + rowb * LDP + C_FV + h * 64,
                        (const float*)(wsl(a.ws) + WS_F2) + (size_t)bh * SEQ, q0, lds, w0);
    const float inv = 1.0f / l;
    bf16_t* orow = PROJ + (rowb + q0 + 32 * wid + r32) * LDP;
    bf16_t* owr = dry ? (bf16_t*)(wsl(a.ws) + WS_M16) + (rowb + q0 + 32 * wid + r32) * 1024 : orow + C_FQ;
#pragma unroll
    for (int dvt = 0; dvt < 2; ++dvt)
#pragma unroll
        for (int g4 = 0; g4 < 4; ++g4) { const int dv = 32 * dvt + 8 * g4 + 4 * hi;
            const u32x2 gw = *(const u32x2*)(orow + C_FG + h * 64 + dv);
            u32x2 w; w.x = pk2(o[dvt][4 * g4] * inv * bflo(gw.x), o[dvt][4 * g4 + 1] * inv * bfhi(gw.x)); w.y = pk2(o[dvt][4 * g4 + 2] * inv * bflo(gw.y), o[dvt][4 * g4 + 3] * inv * bfhi(gw.y));
            *(u32x2*)(owr + h * 64 + dv) = w; }
}
__device__ __forceinline__ void diff_unit(const Args& a, int layer, int bh, int qb, unsigned char* lds, int w0, bool dry = false) {
    THREAD_IDS(); const int wid = wave;
    const int bl = bh >> 3, h = bh & 7, q0 = qb * 256, r32 = lane & 31, hi = lane >> 5;
    bf16_t* PROJ = (bf16_t*)(wsl(a.ws) + WS_PROJ);
    const size_t rowb = (size_t)bl * SEQ;
    const float lam = ((const float*)(wsl(a.ws) + WS_LAM))[layer * 2], lami = ((const float*)(wsl(a.ws) + WS_LAM))[layer * 2 + 1];
    f32x16 o1[4]; float l1, l2;
    float* scr = (float*)(wsl(a.ws) + WS_M32) + ((size_t)((bh * 8 + qb) * 8 + wid) * 64 + lane) * 64;
    attn_pass<128, false>(o1, l1, PROJ + (rowb + q0 + 32 * wid) * LDP + C_DQ + h * 128, PROJ + rowb * LDP + C_DK + h * 128, PROJ + rowb * LDP + C_DV + h * 128, nullptr, q0, lds, w0);
    { const float inv = 1.0f / l1;
#pragma unroll
      for (int i = 0; i < 4; ++i)
#pragma unroll
          for (int r = 0; r < 16; r += 4) *(f32x4*)(scr + i * 16 + r) = (f32x4){o1[i][r] * inv, o1[i][r + 1] * inv, o1[i][r + 2] * inv, o1[i][r + 3] * inv}; }
    attn_pass<128, false>(o1, l2, PROJ + (rowb + q0 + 32 * wid) * LDP + C_DQ + h * 128 + 64, PROJ + rowb * LDP + C_DK + h * 128 + 64, PROJ + rowb * LDP + C_DV + h * 128, nullptr, q0, lds, w0);
    const float sc2 = lam / l2; float ss = 0.f;
#pragma unroll
    for (int i = 0; i < 4; ++i)
#pragma unroll
        for (int r = 0; r < 16; r += 4) { const f32x4 c1 = *(const f32x4*)(scr + i * 16 + r);
#pragma unroll
            for (int k = 0; k < 4; ++k) { const float v = c1[k] - sc2 * o1[i][r + k]; o1[i][r + k] = v; ss += v * v; } }
    ss += lx_xor(ss, 32, lane);
    const float rs = rsqrtf(ss * (1.0f / 128.0f) + EPS) * (1.0f - lami);
    bf16_t* orow = PROJ + (rowb + q0 + 32 * wid + r32) * LDP;
    const float* sw = a.in[11] + layer * 128;
    bf16_t* owr = dry ? (bf16_t*)(wsl(a.ws) + WS_M16) + (rowb + q0 + 32 * wid + r32) * 1024 : orow + C_DQ;
#pragma unroll
    for (int dvt = 0; dvt < 4; ++dvt)
#pragma unroll
        for (int g4 = 0; g4 < 4; ++g4) { const int dv = 32 * dvt + 8 * g4 + 4 * hi;
            const u32x2 gw = *(const u32x2*)(orow + C_DG + h * 128 + dv); const f32x4 wv = *(const f32x4*)(sw + dv);
            u32x2 w; w.x = pk2(o1[dvt][4 * g4] * rs * wv.x * bflo(gw.x), o1[dvt][4 * g4 + 1] * rs * wv.y * bfhi(gw.x));
            w.y = pk2(o1[dvt][4 * g4 + 2] * rs * wv.z * bflo(gw.y), o1[dvt][4 * g4 + 3] * rs * wv.w * bfhi(gw.y));
            *(u32x2*)(owr + h * 128 + dv) = w; }
}

#define XB_TMO      128
#define XB_XCNT(j)  (256  + 64 * (j))
#define XB_XSUB(j)  (1280 + 64 * (j))
#define XB_XGEN(j)  (2304 + 64 * (j))
#define XB_TOP      3328
#define XB_TOPGEN   3392
#define XCD_BAR_WORDS 3456
#define XB_SPIN_CAP (1u << 18)

__device__ __forceinline__ unsigned xb_ld(unsigned* p)              { return __hip_atomic_load(p, __ATOMIC_RELAXED, __HIP_MEMORY_SCOPE_AGENT); }
__device__ __forceinline__ unsigned xb_add(unsigned* p, unsigned v) { return __hip_atomic_fetch_add(p, v, __ATOMIC_RELAXED, __HIP_MEMORY_SCOPE_AGENT); }
__device__ __forceinline__ unsigned xb_xcc_id() { return (unsigned)__builtin_amdgcn_s_getreg((3 << 11) | 20) & 0xFu; }
#define XB_SPIN(cond, bar) do { unsigned _sp = 0; while (cond) { __builtin_amdgcn_s_sleep(1); \
    if ((++_sp & 255u) == 0u) { if (xb_ld(&(bar)[XB_TMO])) break; if (_sp > XB_SPIN_CAP) { atomicAdd(&(bar)[XB_TMO], 1u); break; } } } } while (0)

struct XcdBarrier {
    unsigned* bar; unsigned x;
    volatile LAS unsigned* st;
};

__device__ __forceinline__ XcdBarrier xcd_barrier_post(unsigned* bar, volatile LAS unsigned* st) {
    XcdBarrier b; b.bar = bar; b.x = xb_xcc_id(); b.st = st;
    if (threadIdx.x == 0) (void)xb_add(&bar[XB_XCNT(b.x)], 1u);
    return b;
}
__device__ __forceinline__ void xcd_barrier_complete(unsigned* bar, unsigned x, unsigned& nloc, unsigned& nx) {
    const unsigned G = gridDim.x * gridDim.y * gridDim.z;
    unsigned sum, cnt, mine, sp = 0u;
    for (;;) {
        sum = 0u; cnt = 0u; mine = 0u;
#pragma unroll
        for (unsigned j = 0; j < 16; ++j) { const unsigned c = xb_ld(&bar[XB_XCNT(j)]); sum += c; cnt += (c > 0u) ? 1u : 0u; mine = (j == x) ? c : mine; }
        if (sum == G) break;
        __builtin_amdgcn_s_sleep(1);
        if ((++sp & 255u) == 0u) { if (xb_ld(&bar[XB_TMO])) break; if (sp > XB_SPIN_CAP) { atomicAdd(&bar[XB_TMO], 1u); break; } }
    }
    nloc = mine > 0u ? mine : 1u; nx = cnt > 0u ? cnt : 1u;
}

__device__ __forceinline__ bool is_thread0(int w0) { int lane; asm volatile("v_mbcnt_lo_u32_b32 %0, -1, 0\n\tv_mbcnt_hi_u32_b32 %0, -1, %0" : "=v"(lane)); return w0 == 0 && lane == 0; }
__device__ __forceinline__ void xcd_barrier(const XcdBarrier& b, int w0) {
    asm volatile("s_waitcnt vmcnt(0)" ::: "memory");
    __syncthreads();
    if (is_thread0(w0)) {
        unsigned* bar = b.bar;
        __builtin_amdgcn_s_waitcnt(0);
        unsigned nloc = b.st[0], nx = b.st[1];
        if (nloc == 0u) { xcd_barrier_complete(bar, b.x, nloc, nx); b.st[0] = nloc; b.st[1] = nx; }
        const unsigned old = xb_add(&bar[XB_XSUB(b.x)], 1u);
        const unsigned gen = old / nloc;
        if (old + 1u == (gen + 1u) * nloc) {
            __builtin_amdgcn_fence(__ATOMIC_RELEASE, "agent");
            asm volatile("s_waitcnt vmcnt(0)" ::: "memory");
            const unsigned og = xb_add(&bar[XB_TOP], 1u);
            const unsigned tg = og / nx;
            if (og + 1u == (tg + 1u) * nx) xb_add(&bar[XB_TOPGEN], 1u);
            else XB_SPIN(xb_ld(&bar[XB_TOPGEN]) == tg, bar);
            __builtin_amdgcn_fence(__ATOMIC_ACQUIRE, "agent");
            xb_add(&bar[XB_XGEN(b.x)], 1u);
            asm volatile("s_waitcnt vmcnt(0)" ::: "memory");
        } else {
            XB_SPIN(xb_ld(&bar[XB_XGEN(b.x)]) == gen, bar);
            __builtin_amdgcn_fence(__ATOMIC_ACQUIRE, "agent");
            asm volatile("s_waitcnt vmcnt(0)" ::: "memory");
        }
    }
    __syncthreads();
}

__global__ void __launch_bounds__(NTHR, 2) hybrid_fwd(Args args) {
    extern __shared__ __attribute__((aligned(16))) unsigned char lds[];
    cg::grid_group grid = cg::this_grid();
    const int wave0 = __builtin_amdgcn_readfirstlane((int)threadIdx.x >> 6);
#define ws (wsl(args.ws))
#define CTR ((unsigned*)(ws + WS_CTR))
    LAS unsigned char* ldsl = (LAS unsigned char*)lds;

#ifndef PHM
#define PHM 0xffff
#endif
    { volatile LAS unsigned* st0 = (volatile LAS unsigned*)(ldsl + LDS_MISC + 64); if (threadIdx.x < 2) st0[threadIdx.x] = 0u; }
    if (blockIdx.x == 0) { unsigned* bw = (unsigned*)(ws + WS_BAR); for (int i = threadIdx.x; i < XCD_BAR_WORDS; i += NTHR) bw[i] = 0u; }
    __syncthreads();
    p0_prologue(args, lds, wave0);
    grid.sync();
    const XcdBarrier xbar = xcd_barrier_post((unsigned*)(ws + WS_BAR), (volatile LAS unsigned*)(ldsl + LDS_MISC + 64));
#define GRID_SYNC() xcd_barrier(xbar, wave0)
#ifndef TMASK
#define TMASK 0
#endif
    unsigned long long t_acc = 0ull, t_0 = 0ull;
#define T_BEGIN(bit) do { if (TMASK & (bit)) t_0 = __builtin_amdgcn_s_memrealtime(); } while (0)
#define T_END(bit) do { if (TMASK & (bit)) t_acc += __builtin_amdgcn_s_memrealtime() - t_0; } while (0)
    for (int layer = 0; layer < 2; ++layer) {
        const float* xin = (layer == 0) ? args.in[0] : args.out;
        if (PHM & 2) norm_rows<true>(xin, args.in[1] + layer * 1024, (bf16_t*)(ws + WS_H), nullptr, wave0);
        GRID_SYNC();
        for (int g = 0; g < NGRP; ++g) {
            const int pass = layer * NGRP + g;
            T_BEGIN(1);
            if (PHM & 4) { pg8::Gemm gm{(const bf16_t*)(ws + WS_H) + (size_t)g * TG * 1024, (const bf16_t*)(ws + WS_WIN) + (size_t)layer * NP * 1024, TG, NP, 1024, 1024};
              pg8::StaticOrder S; S.init(TG, NP, (int)gridDim.x, lbx());
              pg8::EpiProj E{(bf16_t*)(ws + WS_PROJ), (float*)(ws + WS_SMALL), (const float*)(ws + WS_LAM) + 16 + layer * 32};
              pg8::gemm_phase<pg8::EpiProj, pg8::StaticOrder, true, true>(ldsl, gm, S, E, wave0); }
            if (g > 0 && lbx() >= 128) {
              pg8::Gemm gm{(const bf16_t*)(ws + WS_M16), (const bf16_t*)(ws + WS_WOUT) + (size_t)layer * 1024 * 1024, TG, 1024, 1024, 1024};
              pg8::StaticOrder S; S.init(TG, 1024, (int)gridDim.x, lbx() - 128);
              pg8::EpiRes E{xin + (size_t)(g - 1) * TG * 1024, args.out + (size_t)(g - 1) * TG * 1024};
              pg8::gemm_phase<pg8::EpiRes, pg8::StaticOrder, true, true>(ldsl, gm, S, E, wave0); }
            GRID_SYNC();
            T_END(1); T_BEGIN(2);
#ifndef EXPER
#define EXPER 0
#endif
            if (EXPER == 2) { pg8::Gemm gm{(const bf16_t*)(ws + WS_H) + (size_t)g * TG * 1024, (const bf16_t*)(ws + WS_WIN) + (size_t)layer * NP * 1024, TG, NP, 1024, 1024};
              pg8::StaticOrder S; S.init(TG, NP, (int)gridDim.x, lbx());
              pg8::EpiProj E{(bf16_t*)(ws + WS_PROJ), (float*)(ws + WS_SMALL), (const float*)(ws + WS_LAM) + 16 + layer * 32};
              pg8::gemm_phase<pg8::EpiProj, pg8::StaticOrder, true, true>(ldsl, gm, S, E, wave0); GRID_SYNC(); }
            if (EXPER == 5) { for (int q = 0; q < 10; ++q) GRID_SYNC(); }
            UNIT_LOOP(CTR + (pass * 3 + 0) * 64, 648,
                  if (u < 8) fcum_unit(args, u, wave0);
                  else if (u < 136) rope_unit(args, u - 8, wave0);
                  else ssd_states_unit(args, layer, u - 136, lds, wave0););
            GRID_SYNC();
            T_END(2); T_BEGIN(4);
            UNIT_LOOP(CTR + (pass * 3 + 1) * 64, 1024,
                  if (u < 256) diff_unit(args, layer, u & 31, 7 - (u >> 5), lds, wave0);
                  else if (u < 512) ssd_scan_unit(args, u - 256, wave0);
                  else { const int j = u - 512; fox_unit(args, j & 63, 7 - (j >> 6), lds, wave0); });
            GRID_SYNC();
            T_END(4); T_BEGIN(8);
            { const int n = (lbx() < 128) ? 0 : 2;
              const int ycol = (n == 0) ? C_FQ : C_DQ;
              pg8::Gemm gm{(const bf16_t*)(ws + WS_PROJ) + ycol, (const bf16_t*)(ws + WS_WBR) + (size_t)(layer * 3 + n) * 1024 * 1024, TG, 1024, 1024, LDP};
              pg8::StaticOrder S; S.init(TG, 1024, (int)gridDim.x, lbx() & 127);
              pg8::EpiGate E{(const bf16_t*)(ws + WS_PROJ) + C_MG + n * 1024, (float*)(ws + WS_M32), (bf16_t*)(ws + WS_M16), n};
              pg8::gemm_phase<pg8::EpiGate, pg8::StaticOrder, true, true>(ldsl, gm, S, E, wave0); }
            UNIT_LOOP(CTR + (pass * 3 + 2) * 64, 512, ssd_out_unit(args, layer, u, lds, wave0););
            GRID_SYNC();
            T_END(8); T_BEGIN(16);
            { pg8::Gemm gm{(const bf16_t*)(ws + WS_PROJ) + C_SZ, (const bf16_t*)(ws + WS_WBR) + (size_t)(layer * 3 + 1) * 1024 * 1024, TG, 1024, 1024, LDP};
              pg8::StaticOrder S; S.init(TG, 1024, (int)gridDim.x, lbx());
              pg8::EpiGate E{(const bf16_t*)(ws + WS_PROJ) + C_MG + 1024, (float*)(ws + WS_M32), (bf16_t*)(ws + WS_M16), 1};
              pg8::gemm_phase<pg8::EpiGate, pg8::StaticOrder, true, true>(ldsl, gm, S, E, wave0); }
            GRID_SYNC();
            T_END(16);
        }
        { pg8::Gemm gm{(const bf16_t*)(ws + WS_M16), (const bf16_t*)(ws + WS_WOUT) + (size_t)layer * 1024 * 1024, TG, 1024, 1024, 1024};
          pg8::StaticOrder S; S.init(TG, 1024, (int)gridDim.x, lbx());
          pg8::EpiRes E{xin + (size_t)(NGRP - 1) * TG * 1024, args.out + (size_t)(NGRP - 1) * TG * 1024};
          pg8::gemm_phase<pg8::EpiRes, pg8::StaticOrder, true, true>(ldsl, gm, S, E, wave0); }
        if (TMASK && layer == 1 && blockIdx.x == 0) { const unsigned long long ts = __builtin_amdgcn_s_memrealtime(); while (__builtin_amdgcn_s_memrealtime() - ts < 4ull * t_acc) __builtin_amdgcn_s_sleep(32); }
        GRID_SYNC();
    }
#undef ws
#undef CTR
    if (PHM & 4096) norm_rows<false>(args.out, args.in[14], nullptr, args.out, wave0);
}

extern "C" void kernel_launch(void* const* d_in, const int* in_sizes, int n_in, void* d_out, int out_size, void* d_ws, size_t ws_size, hipStream_t stream) {
    static int grid = 0;
    if (grid == 0) {
        if (n_in != 15 || out_size != MT * DM || ws_size < WS_END) { fprintf(stderr, "kernel_launch: unexpected shapes (n_in %d out %d ws %zu need %zu)\n", n_in, out_size, ws_size, (size_t)WS_END); grid = -1; return; }
        int dev = 0, cus = 0, per_cu = 0;
        hipGetDevice(&dev); hipDeviceGetAttribute(&cus, hipDeviceAttributeMultiprocessorCount, dev);
        if (hipFuncSetAttribute((const void*)hybrid_fwd, hipFuncAttributeMaxDynamicSharedMemorySize, LDS_BYTES) != hipSuccess) { fprintf(stderr, "kernel_launch: hipFuncSetAttribute failed\n"); grid = -1; return; }
        if (hipOccupancyMaxActiveBlocksPerMultiprocessor(&per_cu, (const void*)hybrid_fwd, NTHR, LDS_BYTES) != hipSuccess || per_cu < 1) { fprintf(stderr, "kernel_launch: occupancy query gave %d\n", per_cu); per_cu = 1; }
        (void)hipGetLastError();
        grid = cus * 1;
    }
    if (grid < 0) return;
    Args a{};
    for (int i = 0; i < 15; ++i) a.in[i] = (const float*)d_in[i];
    a.out = (float*)d_out; a.ws = (unsigned char*)d_ws;
    void* kargs[] = {&a};
    hipError_t e = hipLaunchCooperativeKernel((const void*)hybrid_fwd, dim3(grid), dim3(NTHR), kargs, LDS_BYTES, stream);
    if (e != hipSuccess) fprintf(stderr, "kernel_launch: cooperative launch failed: %s (grid %d)\n", hipGetErrorString(e), grid);
}
```

```cpp
#include <hip/hip_runtime.h>
#include <hip/hip_cooperative_groups.h>
#include <cstdio>
#include <cstdint>
#include <cstddef>
#include <cmath>
namespace cg = cooperative_groups;
namespace pg8 {
#define PG8_LAS __attribute__((address_space(3)))
typedef unsigned short bf16_t;
typedef short bf16x8 __attribute__((ext_vector_type(8)));
typedef float f32x4 __attribute__((ext_vector_type(4)));
typedef unsigned u32x4 __attribute__((ext_vector_type(4)));
constexpr int BM = 256, BK = 64, HALF = 128, HTB = HALF * BK * 2  , STAGE_BYTES = 8 * HTB, NXCD = 8, WGM = 8;

__host__ __device__ __forceinline__ int lds_byte(int r, int c) { const int st = (r >> 4) * 2 + (c >> 5), rr = r & 15, cc = c & 31, ob = rr * 64 + cc * 2; return st * 1024 + (ob ^ (((ob >> 9) & 1) << 5)); }
__host__ __device__ __forceinline__ void stage_rc(int b, int& R, int& C) { const int st = b / 1024, sb = b % 1024, swz = sb ^ (((sb >> 9) & 1) << 5); R = (st >> 1) * 16 + swz / 64; C = (st & 1) * 32 + (swz % 64) / 2; }
__host__ __device__ __forceinline__ int perm32(int rho) { const int n = rho >> 4, i = rho & 15; return 8 * (i >> 2) + 4 * n + (i & 3); }

struct Unit { int pm, pn; };
struct Gemm { const bf16_t* A; const bf16_t* Bt; int M, N, K, lda; };

struct StaticOrder {
    int nM, nN, nwg, G, c;
    __host__ __device__ void init(int M, int N, int G_, int c_) { nM = M / BM; nN = N / BM; nwg = nM * nN; G = G_; c = c_; }
    __host__ __device__ bool next(int i, Unit& u) const {
        const long L = (long)i * G + c; if (L >= nwg) return false;
        int wgid = (int)L; { const int q = nwg / NXCD, r = nwg % NXCD, xcd = wgid % NXCD, off = wgid / NXCD; wgid = (xcd < r ? xcd * (q + 1) : r * (q + 1) + (xcd - r) * q) + off; }
        const int nig = WGM * nN, gid = wgid / nig, fm = gid * WGM, gsz = (nM - fm) < WGM ? (nM - fm) : WGM;
        u.pm = fm + ((wgid % nig) % gsz); u.pn = (wgid % nig) / gsz; return true;
    }
    __device__ __forceinline__ void a_ready(const Unit&) const {}
    __device__ __forceinline__ void done(const Unit&) const {}
};

__device__ __forceinline__ unsigned cvt_pk_bf16(float lo, float hi) { unsigned r; asm volatile("v_cvt_pk_bf16_f32 %0, %1, %2" : "=v"(r) : "v"(lo), "v"(hi)); return r; }

typedef unsigned u32x2 __attribute__((ext_vector_type(2)));
constexpr int LDP = 14336;
__device__ __forceinline__ float silu_f(float v) { return v * __builtin_amdgcn_rcpf(1.0f + __expf(-v)); }
__device__ __forceinline__ float sigm_f(float v) { return __builtin_amdgcn_rcpf(1.0f + __expf(-v)); }
__device__ __forceinline__ float bflo(unsigned w) { return __uint_as_float(w << 16); }
__device__ __forceinline__ float bfhi(unsigned w) { return __uint_as_float(w & 0xffff0000u); }

struct EpiProj {
    static constexpr bool PERM = true, AFTER_DRAIN = false;
    bf16_t* P; float* small; const float* sbias;
    __device__ __forceinline__ void operator()(const f32x4 (&acc)[2][2][4][2], const Unit& u, int wr, int wc, int fr, int fq) const {
        asm volatile("" : "+v"(fr));
        const int row0 = u.pm * BM + wr * 64 + fr;
        if (u.pn < 56) {
            const int pn = u.pn;
            const int mode = (pn < 12) ? 0 : (pn < 20) ? 1 : (pn < 40) ? 0 : (pn < 44) ? 1 : 2;
            const int col0 = pn * BM + wc * 32 + 8 * fq;
#pragma unroll
            for (int ai = 0; ai < 2; ++ai)
#pragma unroll
                for (int m = 0; m < 4; ++m) { bf16_t* rowp = P + (size_t)(row0 + ai * HALF + m * 16) * LDP + col0;
#pragma unroll
                    for (int bj = 0; bj < 2; ++bj) { f32x4 v0 = acc[ai][bj][m][0], v1 = acc[ai][bj][m][1];
                        if (mode == 1) {
#pragma unroll
                            for (int i = 0; i < 4; ++i) { v0[i] = silu_f(v0[i]); v1[i] = silu_f(v1[i]); } }
                        else if (mode == 2) {
#pragma unroll
                            for (int i = 0; i < 4; ++i) { v0[i] = sigm_f(v0[i]); v1[i] = sigm_f(v1[i]); } }
                        u32x4 w; w.x = cvt_pk_bf16(v0[0], v0[1]); w.y = cvt_pk_bf16(v0[2], v0[3]); w.z = cvt_pk_bf16(v1[0], v1[1]); w.w = cvt_pk_bf16(v1[2], v1[3]);
                        *(u32x4*)(rowp + bj * HALF) = w; } }
        } else if (wc == 0) {
            const float* sbp = sbias; asm volatile("" : "+s"(sbp));
            f32x4 bb[2]; bb[0] = *(const f32x4*)(sbp + 8 * fq); bb[1] = *(const f32x4*)(sbp + 8 * fq + 4);
#pragma unroll
            for (int ai = 0; ai < 2; ++ai)
#pragma unroll
                for (int m = 0; m < 4; ++m) { const int row = row0 + ai * HALF + m * 16;
#pragma unroll
                    for (int n = 0; n < 2; ++n) { f32x4 o;
#pragma unroll
                        for (int i = 0; i < 4; ++i) { const int c = 8 * fq + 4 * n + i; const float v = acc[ai][0][m][n][i];
                            const float xx = v + bb[n][i];
                            const float sp = __logf(1.0f + __expf(-fabsf(xx)));
                            o[i] = (c < 16) ? (fminf(xx, 0.f) - sp) : (fmaxf(xx, 0.f) + sp); }
                        *(f32x4*)(small + (size_t)row * 32 + 8 * fq + 4 * n) = o; } }
        }
    }
};
struct EpiGate {
    static constexpr bool PERM = false, AFTER_DRAIN = false;
    const bf16_t* gate; float* m32; bf16_t* m16; int nidx;
    __device__ __forceinline__ void operator()(const f32x4 (&acc)[2][2][4][2], const Unit& u, int wr, int wc, int fr, int fq) const {
        asm volatile("" : "+v"(fr));
        const int row0 = u.pm * BM + wr * 64 + fr, col0 = u.pn * BM + wc * 32 + 4 * fq;
        u32x2 gw[2][4]; f32x4 mv[2][4]; u32x2 hv[2][4];
#define EG_LOAD(c_, s_) do { const int row_ = row0 + ((c_) >> 2) * HALF + ((c_) & 3) * 16; \
        _Pragma("unroll") for (int e_ = 0; e_ < 4; ++e_) { const int col_ = col0 + (e_ >> 1) * HALF + (e_ & 1) * 16; \
            gw[s_][e_] = *(const u32x2*)(gate + (size_t)row_ * LDP + col_); \
            if (nidx == 1) { mv[s_][e_] = *(const f32x4*)(m32 + (size_t)row_ * 1024 + col_); hv[s_][e_] = *(const u32x2*)(m16 + (size_t)row_ * 1024 + col_); } } } while (0)
        EG_LOAD(0, 0);
#pragma unroll
        for (int c = 0; c < 8; ++c) {
            if (c + 1 < 8) EG_LOAD(c + 1, (c + 1) & 1);
            const int ai = c >> 2, m = c & 3, row = row0 + ai * HALF + m * 16;
#pragma unroll
            for (int e = 0; e < 4; ++e) { const int bj = e >> 1, n = e & 1, col = col0 + bj * HALF + n * 16;
                const u32x2 g2 = gw[c & 1][e];
                f32x4 v = acc[ai][bj][m][n];
                v[0] *= bflo(g2.x); v[1] *= bfhi(g2.x); v[2] *= bflo(g2.y); v[3] *= bfhi(g2.y);
                if (nidx == 0) *(f32x4*)(m32 + (size_t)row * 1024 + col) = v;
                else { if (nidx == 1) { const u32x2 t2 = hv[c & 1][e]; v += mv[c & 1][e]; v[0] += bflo(t2.x); v[1] += bfhi(t2.x); v[2] += bflo(t2.y); v[3] += bfhi(t2.y); }
                    u32x2 w; w.x = cvt_pk_bf16(v[0], v[1]); w.y = cvt_pk_bf16(v[2], v[3]); *(u32x2*)(m16 + (size_t)row * 1024 + col) = w; } }
        }
#undef EG_LOAD
    }
};
struct EpiRes {
    static constexpr bool PERM = false, AFTER_DRAIN = false;
    const float* xin; float* out;
    __device__ __forceinline__ void operator()(const f32x4 (&acc)[2][2][4][2], const Unit& u, int wr, int wc, int fr, int fq) const {
        asm volatile("" : "+v"(fr));
        const int row0 = u.pm * BM + wr * 64 + fr, col0 = u.pn * BM + wc * 32 + 4 * fq;
        f32x4 bx[2][4];
#define ER_LOAD(c_, s_) do { const size_t off_ = (size_t)(row0 + ((c_) >> 2) * HALF + ((c_) & 3) * 16) * 1024 + col0; \
        _Pragma("unroll") for (int e_ = 0; e_ < 4; ++e_) bx[s_][e_] = *(const f32x4*)(xin + off_ + (e_ >> 1) * HALF + (e_ & 1) * 16); } while (0)
        ER_LOAD(0, 0);
#pragma unroll
        for (int c = 0; c < 8; ++c) {
            if (c + 1 < 8) ER_LOAD(c + 1, (c + 1) & 1);
            const int ai = c >> 2, m = c & 3; const size_t off = (size_t)(row0 + ai * HALF + m * 16) * 1024 + col0;
#pragma unroll
            for (int e = 0; e < 4; ++e) { const int bj = e >> 1, n = e & 1; *(f32x4*)(out + off + bj * HALF + n * 16) = bx[c & 1][e] + acc[ai][bj][m][n]; }
        }
#undef ER_LOAD
    }
};
template <class Epi, class Sched, bool ALIGN_EPI = false, bool SP2 = false>
__device__ __forceinline__ void gemm_phase(PG8_LAS unsigned char* lds, const Gemm g, const Sched& S, const Epi& E, int w0) {
    int lane_; asm volatile("v_mbcnt_lo_u32_b32 %0, -1, 0\n\tv_mbcnt_hi_u32_b32 %0, -1, %0" : "=v"(lane_)); int wid = w0; asm volatile("" : "+s"(wid)); const int tid = wid * 64 + lane_, lane = tid & 63, wr = wid >> 2, wc = wid & 3, fr = lane & 15, fq = lane >> 4;
    const int K = g.K, nt = K / BK;
    unsigned voffA[2], voffB[2];
#pragma unroll
    for (int i = 0; i < 2; ++i) { int R, C; stage_rc(tid * 16 + i * 8192, R, C); const int Rb = Epi::PERM ? ((R & ~31) + perm32(R & 31)) : R;
        voffA[i] = (unsigned)(R * g.lda + C) * 2u; voffB[i] = (unsigned)(Rb * K + C) * 2u; }
    const size_t kstep = (size_t)(BK * 2);
    const size_t hstepA = (size_t)HALF * g.lda * 2, hstepB = (size_t)HALF * K * 2;
    const size_t tstepA = 2 * hstepA, tstepB = 2 * hstepB;
    const unsigned ldsw = (unsigned)wid * 1024u;
    const int aoff = lds_byte(wr * 64 + fr, fq * 8), boff = lds_byte(wc * 32 + fr, fq * 8);
#define PG8_SA(b, h) (((b) * 2 + (h)) * HTB)
#define PG8_SB(b, h) ((4 + (b) * 2 + (h)) * HTB)
#define PG8_STAGE(bufoff, gbase, voff) do { _Pragma("unroll") for (int _i = 0; _i < 2; ++_i) \
        __builtin_amdgcn_global_load_lds((const unsigned*)((const char*)(gbase) + (voff)[_i]), (PG8_LAS unsigned*)(lds + (bufoff) + ldsw + _i * 8192), 16, 0, 0); } while (0)
#define PG8_LDA(dst, b, h) do { _Pragma("unroll") for (int m = 0; m < 4; ++m) _Pragma("unroll") for (int k = 0; k < 2; ++k) dst[m][k] = *(const PG8_LAS bf16x8*)(lds + PG8_SA(b, h) + aoff + m * 2048 + k * 1024); } while (0)
#define PG8_LDB(dst, b, h) do { _Pragma("unroll") for (int n = 0; n < 2; ++n) _Pragma("unroll") for (int k = 0; k < 2; ++k) dst[n][k] = *(const PG8_LAS bf16x8*)(lds + PG8_SB(b, h) + boff + n * 2048 + k * 1024); } while (0)
#define PG8_MMA(ai, bj, At, Bt) do { __builtin_amdgcn_s_setprio(1); _Pragma("unroll") for (int m = 0; m < 4; ++m) _Pragma("unroll") for (int n = 0; n < 2; ++n) _Pragma("unroll") for (int k = 0; k < 2; ++k) \
        acc[ai][bj][m][n] = __builtin_amdgcn_mfma_f32_16x16x32_bf16(Bt[n][k], At[m][k], acc[ai][bj][m][n], 0, 0, 0); __builtin_amdgcn_s_setprio(0); } while (0)
#define PG8_WAIT_V(n) asm volatile("s_waitcnt vmcnt(" #n ")" ::: "memory")
#define PG8_WAIT_L(n) asm volatile("s_waitcnt lgkmcnt(" #n ")" ::: "memory")
#define PG8_BAR __builtin_amdgcn_s_barrier()
#define PG8_SCHED __builtin_amdgcn_sched_barrier(0)
    Unit cur, nxt; int ui = 0;
    if (!S.next(0, cur)) return;
    f32x4 acc[2][2][4][2];
#pragma unroll
    for (int a = 0; a < 2; ++a)
#pragma unroll
        for (int b = 0; b < 2; ++b)
#pragma unroll
            for (int m = 0; m < 4; ++m)
#pragma unroll
                for (int n = 0; n < 2; ++n) acc[a][b][m][n] = (f32x4){0.f, 0.f, 0.f, 0.f};
    bf16x8 At[4][2], B0[2][2], B1[2][2];
    const char* cA = (const char*)g.A + (size_t)cur.pm * tstepA; const char* cB = (const char*)g.Bt + (size_t)cur.pn * tstepB;
    S.a_ready(cur);
    if constexpr (SP2) {
        PG8_STAGE(PG8_SB(0, 0), cB, voffB); PG8_STAGE(PG8_SB(0, 1), cB + hstepB, voffB); PG8_STAGE(PG8_SA(0, 0), cA, voffA); PG8_STAGE(PG8_SA(0, 1), cA + hstepA, voffA);
        if (wr == 1) PG8_BAR;
        PG8_WAIT_V(2); PG8_BAR;
        PG8_STAGE(PG8_SB(1, 0), cB + kstep, voffB); PG8_STAGE(PG8_SA(1, 0), cA + kstep, voffA); PG8_STAGE(PG8_SB(1, 1), cB + hstepB + kstep, voffB);
        PG8_WAIT_V(6); PG8_BAR;
    } else {
        PG8_STAGE(PG8_SB(0, 0), cB, voffB); PG8_STAGE(PG8_SA(0, 0), cA, voffA); PG8_STAGE(PG8_SB(0, 1), cB + hstepB, voffB); PG8_STAGE(PG8_SA(0, 1), cA + hstepA, voffA);
        if (wr == 1) PG8_BAR;
        PG8_WAIT_V(4); PG8_BAR;
        PG8_STAGE(PG8_SB(1, 0), cB + kstep, voffB); PG8_STAGE(PG8_SA(1, 0), cA + kstep, voffA); PG8_STAGE(PG8_SB(1, 1), cB + hstepB + kstep, voffB);
        PG8_WAIT_V(6); PG8_BAR;
    }
    for (;;) {
        const bool has_next = S.next(ui + 1, nxt);
        const char* nA = has_next ? (const char*)g.A + (size_t)nxt.pm * tstepA : cA; const char* nB = has_next ? (const char*)g.Bt + (size_t)nxt.pn * tstepB : cB;
        for (int t = 0; t < nt; t += 2) {
            const bool last = (t == nt - 2);
            const char* a1 = cA + (size_t)(t + 1) * kstep;
            const char* a2 = last ? nA : cA + (size_t)(t + 2) * kstep; const char* b2 = last ? nB : cB + (size_t)(t + 2) * kstep;
            const char* a3 = a2 + kstep; const char* b3 = b2 + kstep;
            if (last && has_next) S.a_ready(nxt);
            if constexpr (SP2) {
            PG8_LDB(B0, 0, 0); PG8_LDB(B1, 0, 1); PG8_SCHED; PG8_LDA(At, 0, 0); PG8_STAGE(PG8_SA(1, 1), a1 + hstepA, voffA);
            PG8_WAIT_V(8); PG8_WAIT_L(0); PG8_BAR; PG8_MMA(0, 0, At, B0); PG8_MMA(0, 1, At, B1); PG8_BAR; PG8_SCHED;
            PG8_LDA(At, 0, 1); PG8_STAGE(PG8_SB(0, 0), b2, voffB); PG8_STAGE(PG8_SB(0, 1), b2 + hstepB, voffB); PG8_STAGE(PG8_SA(0, 0), a2, voffA);
            PG8_WAIT_V(8); PG8_WAIT_L(0); PG8_BAR; PG8_MMA(1, 0, At, B0); PG8_MMA(1, 1, At, B1); PG8_BAR; PG8_SCHED;
            PG8_LDB(B0, 1, 0); PG8_LDB(B1, 1, 1); PG8_SCHED; PG8_LDA(At, 1, 0); PG8_STAGE(PG8_SA(0, 1), a2 + hstepA, voffA);
            PG8_WAIT_V(8); PG8_WAIT_L(0); PG8_BAR; PG8_MMA(0, 0, At, B0); PG8_MMA(0, 1, At, B1); PG8_BAR; PG8_SCHED;
            PG8_LDA(At, 1, 1); PG8_STAGE(PG8_SB(1, 0), b3, voffB); PG8_STAGE(PG8_SB(1, 1), b3 + hstepB, voffB); PG8_STAGE(PG8_SA(1, 0), a3, voffA);
            PG8_WAIT_V(8); PG8_WAIT_L(0); PG8_BAR; PG8_MMA(1, 0, At, B0); PG8_MMA(1, 1, At, B1); PG8_BAR; PG8_SCHED;
            } else {
            PG8_LDB(B0, 0, 0); PG8_SCHED; PG8_LDA(At, 0, 0); PG8_STAGE(PG8_SA(1, 1), a1 + hstepA, voffA);
            PG8_WAIT_L(8); PG8_BAR; PG8_WAIT_L(0); PG8_MMA(0, 0, At, B0); PG8_BAR; PG8_SCHED;
            PG8_LDB(B1, 0, 1); PG8_STAGE(PG8_SB(0, 0), b2, voffB);
            PG8_BAR; PG8_WAIT_L(0); PG8_MMA(0, 1, At, B1); PG8_BAR;
            PG8_LDA(At, 0, 1); PG8_STAGE(PG8_SA(0, 0), a2, voffA);
            PG8_BAR; PG8_WAIT_L(0); PG8_MMA(1, 0, At, B0); PG8_BAR; PG8_SCHED;
            PG8_STAGE(PG8_SB(0, 1), b2 + hstepB, voffB);
            PG8_WAIT_V(6); PG8_BAR; PG8_MMA(1, 1, At, B1); PG8_BAR;
            PG8_LDB(B0, 1, 0); PG8_SCHED; PG8_LDA(At, 1, 0); PG8_STAGE(PG8_SA(0, 1), a2 + hstepA, voffA);
            PG8_WAIT_L(8); PG8_BAR; PG8_WAIT_L(0); PG8_MMA(0, 0, At, B0); PG8_BAR; PG8_SCHED;
            PG8_LDB(B1, 1, 1); PG8_STAGE(PG8_SB(1, 0), b3, voffB);
            PG8_BAR; PG8_WAIT_L(0); PG8_MMA(0, 1, At, B1); PG8_BAR;
            PG8_LDA(At, 1, 1); PG8_STAGE(PG8_SA(1, 0), a3, voffA);
            PG8_BAR; PG8_WAIT_L(0); PG8_MMA(1, 0, At, B0); PG8_BAR; PG8_SCHED;
            PG8_STAGE(PG8_SB(1, 1), b3 + hstepB, voffB);
            PG8_WAIT_V(6); PG8_BAR; PG8_MMA(1, 1, At, B1); PG8_BAR;
            }
        }
        if constexpr (ALIGN_EPI) { if (wr == 0) PG8_BAR; }
        if constexpr (!Epi::AFTER_DRAIN) { E(acc, cur, wr, wc, fr, fq); S.done(cur); }
        if (!has_next) break;
#pragma unroll
        for (int a = 0; a < 2; ++a)
#pragma unroll
            for (int b = 0; b < 2; ++b)
#pragma unroll
                for (int m = 0; m < 4; ++m)
#pragma unroll
                    for (int n = 0; n < 2; ++n) acc[a][b][m][n] = (f32x4){0.f, 0.f, 0.f, 0.f};
        cur = nxt; cA = nA; cB = nB; ++ui;
        if constexpr (ALIGN_EPI) { if (wr == 1) PG8_BAR; }
    }
    PG8_WAIT_V(0);
    if constexpr (!ALIGN_EPI) { if (wr == 0) PG8_BAR; }
    PG8_BAR;
    if constexpr (Epi::AFTER_DRAIN) { E.fused(acc, cur, wr, wc, fr, fq, lds, wid, lane); S.done(cur); }
#undef PG8_SA
#undef PG8_SB
#undef PG8_STAGE
#undef PG8_LDA
#undef PG8_LDB
#undef PG8_MMA
#undef PG8_WAIT_V
#undef PG8_WAIT_L
#undef PG8_BAR
#undef PG8_SCHED
}
}

#define LAS __attribute__((address_space(3)))
typedef unsigned short bf16_t;
typedef short bf16x8 __attribute__((ext_vector_type(8)));
typedef short v4i16_t __attribute__((ext_vector_type(4)));
typedef float f32x4 __attribute__((ext_vector_type(4)));
typedef float f32x16 __attribute__((ext_vector_type(16)));
typedef unsigned u32x4 __attribute__((ext_vector_type(4)));
typedef unsigned u32x2 __attribute__((ext_vector_type(2)));
typedef float f32x2 __attribute__((ext_vector_type(2)));

constexpr int DM = 1024, SEQ = 2048, NBATCH = 16, MT = NBATCH * SEQ;
constexpr int GB = 4, TG = GB * SEQ, NGRP = NBATCH / GB;
constexpr int LDP = pg8::LDP, NP = 14592, NIN = 14368;
constexpr int C_FQ = 0, C_FK = 1024, C_FV = 2048, C_FG = 3072, C_SZ = 4096, C_XBC = 5120, C_DQ = 7168, C_DK = 8192, C_DV = 9216, C_DG = 10240, C_MG = 11264;
constexpr float EPS = 1e-6f, LOG2E = 1.4426950408889634f, C2 = 0.125f * 1.4426950408889634f;
constexpr int NTHR = 512, NWAVES = 8;
constexpr int LDS_BYTES = 147456, LDS_MISC = 131072 + 8192;

constexpr size_t WS_CTR = 0, WS_BAR = 32768, WS_ROPE = 65536, WS_LAM = WS_ROPE + 131072, WS_WIN = 1u << 20;
constexpr size_t WS_WBR = WS_WIN + (size_t)2 * NP * 1024 * 2;
constexpr size_t WS_WOUT = WS_WBR + (size_t)6 * 1024 * 1024 * 2;
constexpr size_t WS_H = WS_WOUT + (size_t)2 * 1024 * 1024 * 2;
constexpr size_t WS_PROJ = WS_H + (size_t)MT * 1024 * 2;
constexpr size_t WS_SMALL = WS_PROJ + (size_t)TG * LDP * 2;
constexpr size_t WS_F2 = WS_SMALL + (size_t)TG * 32 * 4;
constexpr size_t WS_CD = WS_F2 + (size_t)GB * 16 * SEQ * 4;
constexpr size_t WS_M32 = WS_CD + 65536;
constexpr size_t WS_M16 = WS_M32 + (size_t)TG * 1024 * 4;
constexpr size_t WS_ST = WS_M16 + (size_t)TG * 1024 * 2;
constexpr size_t WS_PREV = WS_ST + (size_t)GB * 32 * 16 * 8192 * 2;
constexpr size_t WS_END = WS_ST + (size_t)GB * 32 * 16 * 8192 * 4;

struct Args { const float* in[15]; float* out; unsigned char* ws; };

__device__ __forceinline__ unsigned f2bf(float f) { unsigned u = __builtin_bit_cast(unsigned, f); return (u + 0x7fffu + ((u >> 16) & 1u)) >> 16; }
__device__ __forceinline__ unsigned pk2(float lo, float hi) { return pg8::cvt_pk_bf16(lo, hi); }
typedef __bf16 bf16x2_t __attribute__((ext_vector_type(2)));
__device__ __forceinline__ unsigned pk2m(float lo, float hi) { const f32x2 v = {lo, hi}; return __builtin_bit_cast(unsigned, __builtin_convertvector(v, bf16x2_t)); }
__device__ __forceinline__ float bflo(unsigned w) { return __uint_as_float(w << 16); }
__device__ __forceinline__ float bfhi(unsigned w) { return __uint_as_float(w & 0xffff0000u); }
__device__ __forceinline__ float bf1(bf16_t b) { return __uint_as_float(((unsigned)b) << 16); }
__device__ __forceinline__ float lx_xor(float v, int mask, int lane) { return __int_as_float(__builtin_amdgcn_ds_bpermute((lane ^ mask) << 2, __float_as_int(v))); }
__device__ __forceinline__ float lx_up(float v, int d, int lane) { return __int_as_float(__builtin_amdgcn_ds_bpermute((lane - d) << 2, __float_as_int(v))); }
__device__ __forceinline__ float wave_sum(float v, int lane) {
#pragma unroll
    for (int o = 1; o < 64; o <<= 1) v += lx_xor(v, o, lane);
    return v;
}
__device__ __forceinline__ int crow(int r, int hi) { return (r & 3) + 8 * (r >> 2) + 4 * hi; }
#define LDS_WAIT() asm volatile("s_waitcnt lgkmcnt(0)" ::: "memory")
#define THREAD_IDS() int lane; asm volatile("v_mbcnt_lo_u32_b32 %0, -1, 0\n\tv_mbcnt_hi_u32_b32 %0, -1, %0" : "=v"(lane)); int wave = w0; asm volatile("" : "+s"(wave)); const int tid = wave * 64 + lane; (void)tid
#define MFMA32(a, b, c) __builtin_amdgcn_mfma_f32_32x32x16_bf16((a), (b), (c), 0, 0, 0)
#define MFMA16(a, b, c) __builtin_amdgcn_mfma_f32_16x16x32_bf16((a), (b), (c), 0, 0, 0)

__device__ __forceinline__ int lbx() { int b = (int)blockIdx.x; asm volatile("" : "+s"(b)); return b; }
__device__ __forceinline__ unsigned char* wsl(unsigned char* p) { asm volatile("" : "+s"(p)); return p; }
__device__ __forceinline__ int q_draw(unsigned* ctr, int w0) { int v = 0; if (w0 == 0) { int lane; asm volatile("v_mbcnt_lo_u32_b32 %0, -1, 0\n\tv_mbcnt_hi_u32_b32 %0, -1, %0" : "=v"(lane)); if (lane == 0) v = (int)atomicAdd(ctr, 1u); } return v; }
__device__ __forceinline__ int q_pub(int drawn, unsigned char* lds, int w0) {
    volatile int* slot = (volatile int*)(lds + LDS_MISC);
    __syncthreads();
    if (w0 == 0) { int lane; asm volatile("v_mbcnt_lo_u32_b32 %0, -1, 0\n\tv_mbcnt_hi_u32_b32 %0, -1, %0" : "=v"(lane)); if (lane == 0) *slot = drawn; }
    __syncthreads();
    return *slot;
}
#define UNIT_LOOP(ctr_, total_, body_) do { unsigned* c__ = (ctr_); \
    for (;;) { const int d__ = q_draw(c__, wave0); const int u = q_pub(d__, lds, wave0); if (u >= (total_)) break; body_ } } while (0)

__device__ __forceinline__ int win_src_col(int n) {
    if (n < 3072) return n;
    if (n < 7168) return n + 16;
    if (n < 14336) return n + 32;
    if (n < 14352) return 3072 + (n - 14336);
    if (n < 14368) return 7184 + (n - 14352);
    return -1;
}
template <bool MAP> __device__ __forceinline__ void transpose_item(const float* W, int K, int Nsrc, bf16_t* WT, float* scr, int kb, int nb, int lane) {
    const int k0 = 64 * kb, n0 = 32 * nb;
    const int nn = n0 + (lane & 31); const int src = MAP ? win_src_col(nn) : nn;
#pragma unroll 8
    for (int i = 0; i < 32; ++i) { const int kk = 2 * i + (lane >> 5); scr[kk * 33 + (lane & 31)] = (src >= 0) ? W[(size_t)(k0 + kk) * Nsrc + src] : 0.f; }
    LDS_WAIT();
    const int c = lane & 7;
#pragma unroll
    for (int j = 0; j < 4; ++j) { const int n = (lane >> 3) + 8 * j; const float* s = scr + (8 * c) * 33 + n;
        u32x4 o; o.x = pk2(s[0 * 33], s[1 * 33]); o.y = pk2(s[2 * 33], s[3 * 33]); o.z = pk2(s[4 * 33], s[5 * 33]); o.w = pk2(s[6 * 33], s[7 * 33]);
        *(u32x4*)(WT + (size_t)(n0 + n) * K + k0 + 8 * c) = o; }
    LDS_WAIT();
}
__device__ __forceinline__ void p0_prologue(const Args& a, unsigned char* lds, int w0) {
    THREAD_IDS();
    unsigned char* ws = wsl(a.ws);
    float* scr = (float*)(lds + wave * 8448);
    const int gw = blockIdx.x * NWAVES + wave, NGW = gridDim.x * NWAVES;
    constexpr int I_IN = 16 * (NP / 32), I_SQ = 16 * 32;
    constexpr int NITEMS = 2 * I_IN + 8 * I_SQ;
    for (int it = gw; it < NITEMS; it += NGW) {
        int r = it;
        if (r < 2 * I_IN) { const int layer = r / I_IN; r -= layer * I_IN;
            transpose_item<true>(a.in[2] + (size_t)layer * 1024 * NIN, 1024, NIN, (bf16_t*)(ws + WS_WIN) + (size_t)layer * NP * 1024, scr, r / (NP / 32), r % (NP / 32), lane); continue; }
        r -= 2 * I_IN;
        if (r < 6 * I_SQ) { const int mi = r / I_SQ; r -= mi * I_SQ;
            transpose_item<false>(a.in[12] + (size_t)mi * 1024 * 1024, 1024, 1024, (bf16_t*)(ws + WS_WBR) + (size_t)mi * 1024 * 1024, scr, r / 32, r % 32, lane); continue; }
        r -= 6 * I_SQ;
        { const int mi = r / I_SQ; r -= mi * I_SQ;
            transpose_item<false>(a.in[13] + (size_t)mi * 1024 * 1024, 1024, 1024, (bf16_t*)(ws + WS_WOUT) + (size_t)mi * 1024 * 1024, scr, r / 32, r % 32, lane); }
    }
    for (int idx = blockIdx.x * NTHR + tid; idx < SEQ * 8; idx += gridDim.x * NTHR) {
        const int pos = idx >> 3, i = idx & 7;
        const float inv = powf(500000.0f, -(float)(2 * i) / 16.0f);
        const float ang = (float)pos * inv;
        ((f32x2*)(ws + WS_ROPE))[idx] = (f32x2){cosf(ang), sinf(ang)};
    }
    if (blockIdx.x == 0) {
        if (tid < 128) ((unsigned*)(ws + WS_CTR))[tid * 64] = 0u;
        if (tid >= 128 && tid < 192) { const int k = tid - 128, layer = k >> 5, c = k & 31;
            ((float*)(ws + WS_LAM))[16 + k] = (c < 16) ? a.in[3][layer * 16 + c] : a.in[6][layer * 16 + c - 16]; }
        if (tid >= 64 && tid < 66) { const int layer = tid - 64; const float* lp = a.in[10] + layer * 256;
            float s1 = 0.f, s2 = 0.f;
            for (int d = 0; d < 64; ++d) { s1 += lp[d] * lp[64 + d]; s2 += lp[128 + d] * lp[192 + d]; }
            const float li = 0.8f - 0.6f * expf(-0.3f * (float)layer);
            ((float*)(ws + WS_LAM))[layer * 2] = expf(s1) - expf(s2) + li; ((float*)(ws + WS_LAM))[layer * 2 + 1] = li; }
    }
}
template <bool TOBF> __device__ __forceinline__ void norm_rows(const float* X, const float* w, bf16_t* ob, float* of, int w0) {
    THREAD_IDS();
    const int gw = blockIdx.x * NWAVES + wave, NGW = gridDim.x * NWAVES;
    f32x4 wv[4];
#pragma unroll
    for (int j = 0; j < 4; ++j) wv[j] = ((const f32x4*)w)[64 * j + lane];
    for (int m = gw; m < MT; m += 2 * NGW) {
        const int m2 = m + NGW;
        const f32x4* xr = (const f32x4*)(X + (size_t)m * DM) + lane; const f32x4* xr2 = (const f32x4*)(X + (size_t)m2 * DM) + lane;
        f32x4 v[4], v2[4]; float s = 0.f, s2 = 0.f;
#pragma unroll
        for (int j = 0; j < 4; ++j) { v[j] = xr[64 * j]; v2[j] = xr2[64 * j]; }
#pragma unroll
        for (int j = 0; j < 4; ++j) { s += (v[j].x * v[j].x + v[j].y * v[j].y) + (v[j].z * v[j].z + v[j].w * v[j].w); s2 += (v2[j].x * v2[j].x + v2[j].y * v2[j].y) + (v2[j].z * v2[j].z + v2[j].w * v2[j].w); }
        const float rs = rsqrtf(wave_sum(s, lane) * (1.0f / DM) + EPS), rs2 = rsqrtf(wave_sum(s2, lane) * (1.0f / DM) + EPS);
#pragma unroll
        for (int j = 0; j < 4; ++j) { const f32x4 o = v[j] * rs * wv[j], o2 = v2[j] * rs2 * wv[j];
            if (TOBF) { u32x2 p; p.x = pk2(o.x, o.y); p.y = pk2(o.z, o.w); ((u32x2*)(ob + (size_t)m * DM))[64 * j + lane] = p;
                        u32x2 q; q.x = pk2(o2.x, o2.y); q.y = pk2(o2.z, o2.w); ((u32x2*)(ob + (size_t)m2 * DM))[64 * j + lane] = q; }
            else { ((f32x4*)(of + (size_t)m * DM))[64 * j + lane] = o; ((f32x4*)(of + (size_t)m2 * DM))[64 * j + lane] = o2; } }
    }
}

constexpr int SL_ACS = 0, SL_DT = 1024, SL_PART = 2048, SL_XT = 4096, SL_B = SL_XT + 256 * 144, SL_C = SL_B + 18432;
constexpr int XTP = 144, BNP = 272;

__device__ __forceinline__ void ssd_acs(unsigned char* lds, const float* small, size_t row0, int g, const float* a_log, int wave, int lane) {
    if (wave < 4) {
        const int h = 4 * g + wave;
        const float dt = small[(row0 + lane) * 32 + 16 + h];
        float v = -expf(a_log[h]) * dt;
#pragma unroll
        for (int o = 1; o < 64; o <<= 1) { const float t = lx_up(v, o, lane); if (lane >= o) v += t; }
        ((float*)(lds + SL_ACS))[wave * 64 + lane] = v;
        ((float*)(lds + SL_DT))[wave * 64 + lane] = dt;
    }
}
__device__ __forceinline__ void conv8x8(float (&out)[8][8], const bf16_t* xb, int pg, int c, const float* cw, const float* cb) {
    u32x4 raw[11];
#pragma unroll
    for (int i = 0; i < 11; ++i) { const int rr = pg * 8 - 3 + i;
        if (rr >= 0 || c > 0) raw[i] = *(const u32x4*)(xb + (ptrdiff_t)rr * LDP); else raw[i] = (u32x4){0u, 0u, 0u, 0u}; }
    float w[4][8], bias[8];
#pragma unroll
    for (int k = 0; k < 4; ++k) { const f32x4 a = *(const f32x4*)(cw + k * 2048), b = *(const f32x4*)(cw + k * 2048 + 4);
        w[k][0] = a.x; w[k][1] = a.y; w[k][2] = a.z; w[k][3] = a.w; w[k][4] = b.x; w[k][5] = b.y; w[k][6] = b.z; w[k][7] = b.w; }
    { const f32x4 a = *(const f32x4*)cb, b = *(const f32x4*)(cb + 4); bias[0] = a.x; bias[1] = a.y; bias[2] = a.z; bias[3] = a.w; bias[4] = b.x; bias[5] = b.y; bias[6] = b.z; bias[7] = b.w; }
#pragma unroll
    for (int p = 0; p < 8; ++p) {
#pragma unroll
        for (int ch = 0; ch < 8; ++ch) { float s = bias[ch];
#pragma unroll
            for (int k = 0; k < 4; ++k) { const unsigned wd = raw[p + k][ch >> 1]; const float u = (ch & 1) ? bfhi(wd) : bflo(wd); s += w[k][ch] * u; }
            out[p][ch] = pg8::silu_f(s); }
    }
}
__device__ __forceinline__ void put_T(unsigned char* img, int chrow0, int s0, const float (&v)[8][8]) {
#pragma unroll
    for (int ch = 0; ch < 8; ++ch) { u32x4 o; o.x = pk2(v[0][ch], v[1][ch]); o.y = pk2(v[2][ch], v[3][ch]); o.z = pk2(v[4][ch], v[5][ch]); o.w = pk2(v[6][ch], v[7][ch]);
        *(u32x4*)(img + (chrow0 + ch) * XTP + s0 * 2) = o; }
}
__device__ __forceinline__ void put_N(unsigned char* img, int n0, int s0, const float (&v)[8][8]) {
#pragma unroll
    for (int p = 0; p < 8; ++p) { u32x4 o; o.x = pk2(v[p][0], v[p][1]); o.y = pk2(v[p][2], v[p][3]); o.z = pk2(v[p][4], v[p][5]); o.w = pk2(v[p][6], v[p][7]);
        *(u32x4*)(img + (s0 + p) * BNP + n0 * 2) = o; }
}

__device__ __forceinline__ void ssd_states_unit(const Args& a, int layer, int u, unsigned char* lds, int w0) {
    THREAD_IDS();
    const int g = u & 3, c = (u >> 2) & 31, bl = u >> 7;
    unsigned char* ws = wsl(a.ws);
    const bf16_t* PROJ = (const bf16_t*)(ws + WS_PROJ);
    const size_t row0 = (size_t)bl * SEQ + c * 64;
    ssd_acs(lds, (const float*)(ws + WS_SMALL), row0, g, a.in[7] + layer * 16, wave, lane);
    __syncthreads();
    const float* ACS = (const float*)(lds + SL_ACS); const float* DTL = (const float*)(lds + SL_DT);
    const int cgi = tid & 63, pg = tid >> 6;
    if (cgi < 48) {
        const int chx = (cgi < 32) ? (g * 256 + cgi * 8) : (1024 + g * 128 + (cgi - 32) * 8);
        float v[8][8];
        conv8x8(v, PROJ + row0 * LDP + C_XBC + chx, pg, c, a.in[4] + (size_t)layer * 4 * 2048 + chx, a.in[5] + layer * 2048 + chx);
        if (cgi < 32) { const int hh = cgi >> 3; const float al = ACS[hh * 64 + 63];
#pragma unroll
            for (int p = 0; p < 8; ++p) { const int s = pg * 8 + p; const float sc = __expf(al - ACS[hh * 64 + s]) * DTL[hh * 64 + s];
#pragma unroll
                for (int ch = 0; ch < 8; ++ch) v[p][ch] *= sc; }
            put_T(lds + SL_XT, cgi * 8, pg * 8, v);
        } else put_T(lds + SL_B, (cgi - 32) * 8, pg * 8, v);
    }
    __syncthreads();
    const int fr = lane & 15, fq = lane >> 4, hh = wave >> 1, nh = wave & 1;
    f32x4 acc[4][4];
#pragma unroll
    for (int i = 0; i < 4; ++i)
#pragma unroll
        for (int j = 0; j < 4; ++j) acc[i][j] = (f32x4){0.f, 0.f, 0.f, 0.f};
    {   bf16x8 af[2][4], bf[2][4];
#pragma unroll
        for (int ks = 0; ks < 2; ++ks) {
#pragma unroll
            for (int i = 0; i < 4; ++i) af[ks][i] = *(const bf16x8*)(lds + SL_B + (64 * nh + 16 * i + fr) * XTP + (32 * ks + 8 * fq) * 2);
#pragma unroll
            for (int j = 0; j < 4; ++j) bf[ks][j] = *(const bf16x8*)(lds + SL_XT + (hh * 64 + 16 * j + fr) * XTP + (32 * ks + 8 * fq) * 2); }
        __builtin_amdgcn_sched_barrier(0);
#pragma unroll
        for (int ks = 0; ks < 2; ++ks)
#pragma unroll
            for (int i = 0; i < 4; ++i)
#pragma unroll
                for (int j = 0; j < 4; ++j) acc[i][j] = MFMA16(af[ks][i], bf[ks][j], acc[i][j]);
    }
    const int h = 4 * g + hh;
    bf16_t* ST = (bf16_t*)(ws + WS_ST) + ((size_t)(bl * 32 + c) * 16 + h) * 8192;
#pragma unroll
    for (int i = 0; i < 4; ++i)
#pragma unroll
        for (int j = 0; j < 4; ++j) { u32x2 w; w.x = pk2m(acc[i][j][0], acc[i][j][1]); w.y = pk2m(acc[i][j][2], acc[i][j][3]);
            *(u32x2*)(ST + (16 * j + fr) * 128 + 64 * nh + 16 * i + 4 * fq) = w; }
    if (tid < 4) ((float*)(ws + WS_CD))[(bl * 32 + c) * 16 + 4 * g + tid] = __expf(ACS[tid * 64 + 63]);
}

__device__ __forceinline__ void ssd_scan_unit(const Args& a, int u, int w0) {
    THREAD_IDS();
    const int qt = u & 3, h = (u >> 2) & 15, bl = u >> 6;
    const bf16_t* ST = (const bf16_t*)(wsl(a.ws) + WS_ST); bf16_t* PV = (bf16_t*)(wsl(a.ws) + WS_PREV); const float* CD = (const float*)(wsl(a.ws) + WS_CD);
    const int e = qt * 2048 + tid * 4;
    float z0 = 0.f; asm volatile("" : "+v"(z0));
    f32x4 hc = (f32x4){z0, z0, z0, z0};
#pragma unroll 1
    for (int c0 = 0; c0 < 32; c0 += 16) {
        u32x2 sv[16];
#pragma unroll
        for (int c = 0; c < 16; ++c) sv[c] = *(const u32x2*)(ST + ((size_t)(bl * 32 + c0 + c) * 16 + h) * 8192 + e);
#pragma unroll
        for (int c = 0; c < 16; ++c) { const float dec = CD[(bl * 32 + c0 + c) * 16 + h];
            u32x2 w; w.x = pk2(hc[0], hc[1]); w.y = pk2(hc[2], hc[3]);
            *(u32x2*)(PV + ((size_t)(bl * 32 + c0 + c) * 16 + h) * 8192 + e) = w;
            hc = hc * dec + (f32x4){bflo(sv[c].x), bfhi(sv[c].x), bflo(sv[c].y), bfhi(sv[c].y)}; }
    }
}

__device__ __forceinline__ void ssd_out_unit(const Args& a, int layer, int u, unsigned char* lds, int w0, bool dry = false) {
    THREAD_IDS();
    const int g = u & 3, c = (u >> 2) & 31, bl = u >> 7;
    unsigned char* ws = wsl(a.ws);
    bf16_t* PROJ = (bf16_t*)(ws + WS_PROJ);
    const size_t row0 = (size_t)bl * SEQ + c * 64;
    ssd_acs(lds, (const float*)(ws + WS_SMALL), row0, g, a.in[7] + layer * 16, wave, lane);
    const int cgi = tid & 63, pg = tid >> 6;
    {
        const int chx = (cgi < 32) ? (g * 256 + cgi * 8) : (cgi < 48) ? (1024 + g * 128 + (cgi - 32) * 8) : (1536 + g * 128 + (cgi - 48) * 8);
        float v[8][8];
        conv8x8(v, PROJ + row0 * LDP + C_XBC + chx, pg, c, a.in[4] + (size_t)layer * 4 * 2048 + chx, a.in[5] + layer * 2048 + chx);
        if (cgi < 32) put_T(lds + SL_XT, cgi * 8, pg * 8, v);
        else if (cgi < 48) put_N(lds + SL_B, (cgi - 32) * 8, pg * 8, v);
        else put_N(lds + SL_C, (cgi - 48) * 8, pg * 8, v);
    }
    const int fr = lane & 15, fq = lane >> 4, hh = wave >> 1, lh = wave & 1, h = 4 * g + hh;
    const bf16_t* PV = (const bf16_t*)(ws + WS_PREV) + ((size_t)(bl * 32 + c) * 16 + h) * 8192;
    u32x2 zws[2][4]; f32x4 nwv[4];
#pragma unroll
    for (int lt = 0; lt < 2; ++lt)
#pragma unroll
        for (int pt = 0; pt < 4; ++pt) zws[lt][pt] = *(const u32x2*)(PROJ + (row0 + 32 * lh + 16 * lt + fr) * LDP + C_SZ + h * 64 + 16 * pt + 4 * fq);
#pragma unroll
    for (int pt = 0; pt < 4; ++pt) nwv[pt] = *(const f32x4*)(a.in[9] + layer * 1024 + h * 64 + 16 * pt + 4 * fq);
    bf16x8 pa[4][4];
#pragma unroll
    for (int ks = 0; ks < 4; ++ks)
#pragma unroll
        for (int pt = 0; pt < 4; ++pt) pa[ks][pt] = *(const bf16x8*)(PV + (16 * pt + fr) * 128 + 32 * ks + 8 * fq);
    __syncthreads();
    const float* ACS = (const float*)(lds + SL_ACS); const float* DTL = (const float*)(lds + SL_DT);
    f32x4 acc[4][2], dd[4][2];
#pragma unroll
    for (int i = 0; i < 4; ++i)
#pragma unroll
        for (int j = 0; j < 2; ++j) { acc[i][j] = (f32x4){0.f, 0.f, 0.f, 0.f}; dd[i][j] = (f32x4){0.f, 0.f, 0.f, 0.f}; }
    bf16x8 cf[4][2];
#pragma unroll
    for (int ks = 0; ks < 4; ++ks)
#pragma unroll
        for (int lt = 0; lt < 2; ++lt) cf[ks][lt] = *(const bf16x8*)(lds + SL_C + (32 * lh + 16 * lt + fr) * BNP + (32 * ks + 8 * fq) * 2);
    __builtin_amdgcn_sched_barrier(0);
#pragma unroll
    for (int ks = 0; ks < 4; ++ks)
#pragma unroll
        for (int pt = 0; pt < 4; ++pt)
#pragma unroll
            for (int lt = 0; lt < 2; ++lt) acc[pt][lt] = MFMA16(pa[ks][pt], cf[ks][lt], acc[pt][lt]);
    __builtin_amdgcn_sched_barrier(0);
    {   bf16x8 bq[4][4];
#pragma unroll
        for (int ks = 0; ks < 4; ++ks)
#pragma unroll
            for (int st = 0; st < 4; ++st) if (st < 2 || lh) bq[ks][st] = *(const bf16x8*)(lds + SL_B + (16 * st + fr) * BNP + (32 * ks + 8 * fq) * 2);
        __builtin_amdgcn_sched_barrier(0);
#pragma unroll
        for (int ks = 0; ks < 4; ++ks)
#pragma unroll
            for (int st = 0; st < 4; ++st) if (st < 2 || lh) {
#pragma unroll
                for (int lt = 0; lt < 2; ++lt) dd[st][lt] = MFMA16(bq[ks][st], cf[ks][lt], dd[st][lt]); }
    }
    float acl[2];
#pragma unroll
    for (int lt = 0; lt < 2; ++lt) { acl[lt] = ACS[hh * 64 + 32 * lh + 16 * lt + fr]; const float e = __expf(acl[lt]);
#pragma unroll
        for (int pt = 0; pt < 4; ++pt) acc[pt][lt] *= e; }
#pragma unroll
    for (int st = 0; st < 4; ++st) if (st < 2 || lh) {
#pragma unroll
        for (int r = 0; r < 4; ++r) { const int s = 16 * st + 4 * fq + r; const float as = ACS[hh * 64 + s], ds = DTL[hh * 64 + s];
#pragma unroll
            for (int lt = 0; lt < 2; ++lt) { const int l = 32 * lh + 16 * lt + fr; dd[st][lt][r] = (s <= l) ? dd[st][lt][r] * __expf(acl[lt] - as) * ds : 0.f; } }
    }
#pragma unroll
    for (int kk = 0; kk < 2; ++kk) if (kk == 0 || lh) {
        bf16x8 mb[2];
#pragma unroll
        for (int lt = 0; lt < 2; ++lt) { u32x4 w; w.x = pk2(dd[2 * kk][lt][0], dd[2 * kk][lt][1]); w.y = pk2(dd[2 * kk][lt][2], dd[2 * kk][lt][3]);
            w.z = pk2(dd[2 * kk + 1][lt][0], dd[2 * kk + 1][lt][1]); w.w = pk2(dd[2 * kk + 1][lt][2], dd[2 * kk + 1][lt][3]); mb[lt] = __builtin_bit_cast(bf16x8, w); }
#pragma unroll
        for (int pt = 0; pt < 4; ++pt) { const unsigned char* xr = lds + SL_XT + (hh * 64 + 16 * pt + fr) * XTP + (32 * kk + 4 * fq) * 2;
            const u32x2 lo = *(const u32x2*)xr, hi2 = *(const u32x2*)(xr + 32);
            const bf16x8 af = __builtin_bit_cast(bf16x8, (u32x4){lo.x, lo.y, hi2.x, hi2.y});
#pragma unroll
            for (int lt = 0; lt < 2; ++lt) acc[pt][lt] = MFMA16(af, mb[lt], acc[pt][lt]); }
    }
    const float dsk = a.in[8][layer * 16 + h];
    float ss[2] = {0.f, 0.f};
#pragma unroll
    for (int lt = 0; lt < 2; ++lt) { const int l = 32 * lh + 16 * lt + fr;
#pragma unroll
        for (int pt = 0; pt < 4; ++pt) { const int p4 = 16 * pt + 4 * fq;
            const u32x2 zw = zws[lt][pt];
            const float zz[4] = {bflo(zw.x), bfhi(zw.x), bflo(zw.y), bfhi(zw.y)};
#pragma unroll
            for (int r = 0; r < 4; ++r) { const float xv = bf1(*(const bf16_t*)(lds + SL_XT + (hh * 64 + p4 + r) * XTP + l * 2));
                const float y = (acc[pt][lt][r] + xv * dsk) * zz[r]; acc[pt][lt][r] = y; ss[lt] += y * y; } } }
#pragma unroll
    for (int lt = 0; lt < 2; ++lt) { ss[lt] += lx_xor(ss[lt], 16, lane); ss[lt] += lx_xor(ss[lt], 32, lane);
        if (fq == 0) ((float*)(lds + SL_PART))[hh * 64 + 32 * lh + 16 * lt + fr] = ss[lt]; }
    __syncthreads();
    const float* nw = a.in[9] + layer * 1024 + h * 64;
#pragma unroll
    for (int lt = 0; lt < 2; ++lt) { const int l = 32 * lh + 16 * lt + fr; const float* pr = (const float*)(lds + SL_PART);
        const float tot = (pr[l] + pr[64 + l]) + (pr[128 + l] + pr[192 + l]);
        const float rs = rsqrtf(tot * (1.0f / 256.0f) + EPS);
#pragma unroll
        for (int pt = 0; pt < 4; ++pt) { const int p4 = 16 * pt + 4 * fq; const f32x4 wv = nwv[pt];
            u32x2 o; o.x = pk2(acc[pt][lt][0] * rs * wv.x, acc[pt][lt][1] * rs * wv.y); o.y = pk2(acc[pt][lt][2] * rs * wv.z, acc[pt][lt][3] * rs * wv.w);
            if (dry) *(u32x2*)((bf16_t*)(ws + WS_M16) + (row0 + l) * 1024 + h * 64 + p4) = o; else *(u32x2*)(PROJ + (row0 + l) * LDP + C_SZ + h * 64 + p4) = o; } }
}

__device__ __forceinline__ void fcum_unit(const Args& a, int fu, int w0) {
    THREAD_IDS();
    const int task = fu * 8 + wave, bl = task >> 4, h = task & 15;
    const float* sm = (const float*)(wsl(a.ws) + WS_SMALL) + ((size_t)bl * SEQ + lane * 32) * 32 + h;
    float v[32]; float run = 0.f;
#pragma unroll
    for (int i = 0; i < 32; ++i) { run += sm[i * 32]; v[i] = run; }
    float sc = run;
#pragma unroll
    for (int o = 1; o < 64; o <<= 1) { const float t = lx_up(sc, o, lane); if (lane >= o) sc += t; }
    const float off = sc - run;
    float* F = (float*)(wsl(a.ws) + WS_F2) + (size_t)task * SEQ + lane * 32;
#pragma unroll
    for (int i = 0; i < 32; i += 4) *(f32x4*)(F + i) = (f32x4){(off + v[i]) * LOG2E, (off + v[i + 1]) * LOG2E, (off + v[i + 2]) * LOG2E, (off + v[i + 3]) * LOG2E};
}
__device__ __forceinline__ void rope_unit(const Args& a, int ru, int w0) {
    THREAD_IDS();
    const int row = ru * 64 + (tid >> 3), j = tid & 7, pos = row & (SEQ - 1);
    bf16_t* PROJ = (bf16_t*)(wsl(a.ws) + WS_PROJ);
    const f32x2* cs = (const f32x2*)(wsl(a.ws) + WS_ROPE) + pos * 8;
    f32x2 t[8];
#pragma unroll
    for (int i = 0; i < 8; ++i) t[i] = cs[i];
#pragma unroll
    for (int k = 0; k < 4; ++k) { const int hc = 4 * j + k; const int col = (hc < 16) ? (C_DQ + hc * 64) : (C_DK + (hc - 16) * 64);
        u32x4* p = (u32x4*)(PROJ + (size_t)row * LDP + col);
        const u32x4 a1 = p[0], a2 = p[1]; u32x4 o1, o2;
#pragma unroll
        for (int w = 0; w < 4; ++w) {
            const float x1l = bflo(a1[w]), x1h = bfhi(a1[w]), x2l = bflo(a2[w]), x2h = bfhi(a2[w]);
            const f32x2 c0 = t[2 * w], c1 = t[2 * w + 1];
            o1[w] = pk2(x1l * c0.x - x2l * c0.y, x1h * c1.x - x2h * c1.y);
            o2[w] = pk2(x2l * c0.x + x1l * c0.y, x2h * c1.x + x1h * c1.y); }
        p[0] = o1; p[1] = o2; }
}

__device__ __forceinline__ v4i16_t vtr(const unsigned char* p) { return __builtin_amdgcn_ds_read_tr16_b64_v4i16((LAS v4i16_t*)(LAS unsigned char*)p); }
__device__ __forceinline__ float max3f(float a, float b, float c) { float r; asm("v_max3_f32 %0, %1, %2, %3" : "=v"(r) : "v"(a), "v"(b), "v"(c)); return r; }
template <int DV, bool FOX>
__device__ __forceinline__ void attn_pass(f32x16 (&o)[DV / 32], float& l_out, const bf16_t* Qw, const bf16_t* Kb, const bf16_t* Vb, const float* F2,
                                          int q0, unsigned char* lds, int w0) {
    THREAD_IDS(); const int wid = wave;
    constexpr int KP = 144, VP = DV * 2 + 64, OFF_K = 0, OFF_V = 64 * KP, OFF_F = OFF_V + 64 * VP, STAGE = OFF_F + 256, NV = DV / 64;
    const int r32 = lane & 31, hi = lane >> 5;
    const int NT = (q0 + 256) / 64, my_nt = (q0 + 32 * wid) / 64 + 1;
    bf16x8 qf[4];
#pragma unroll
    for (int d0 = 0; d0 < 4; ++d0) qf[d0] = *(const bf16x8*)(Qw + (size_t)r32 * LDP + d0 * 16 + hi * 8);
    float m = -INFINITY, l = 0.f;
#pragma unroll
    for (int i = 0; i < DV / 32; ++i)
#pragma unroll
        for (int r = 0; r < 16; ++r) o[i][r] = 0.f;
    u32x4 kreg, vreg[NV]; float freg = 0.f;
    const int krow = tid >> 3, kch = tid & 7;
#define ATT_LOAD(t) do { kreg = *(const u32x4*)(Kb + (size_t)(64 * (t) + krow) * LDP + kch * 8); \
        _Pragma("unroll") for (int i_ = 0; i_ < NV; ++i_) { const int idx_ = tid + 512 * i_; const int vr_ = (DV == 64) ? (idx_ >> 3) : (idx_ >> 4), vc_ = (DV == 64) ? (idx_ & 7) : (idx_ & 15); \
            vreg[i_] = *(const u32x4*)(Vb + (size_t)(64 * (t) + vr_) * LDP + vc_ * 8); } \
        if (FOX && tid < 64) freg = -F2[64 * (t) + tid]; } while (0)
#define ATT_STORE(sb_) do { *(u32x4*)((sb_) + OFF_K + krow * KP + kch * 16) = kreg; \
        _Pragma("unroll") for (int i_ = 0; i_ < NV; ++i_) { const int idx_ = tid + 512 * i_; const int vr_ = (DV == 64) ? (idx_ >> 3) : (idx_ >> 4), vc_ = (DV == 64) ? (idx_ & 7) : (idx_ & 15); \
            *(u32x4*)((sb_) + OFF_V + vr_ * VP + vc_ * 16) = vreg[i_]; } \
        if (FOX && tid < 64) ((float*)((sb_) + OFF_F))[tid] = freg; } while (0)
    __syncthreads();
    ATT_LOAD(0); ATT_STORE(lds);
    if (NT > 1) ATT_LOAD(1);
    __syncthreads();
    for (int t = 0; t < NT; ++t) {
        const unsigned char* sb = lds + (t & 1) * STAGE;
        if (t < my_nt) {
            bf16x8 kf[8];
#pragma unroll
            for (int d0 = 0; d0 < 4; ++d0) { kf[2 * d0] = *(const bf16x8*)(sb + OFF_K + r32 * KP + d0 * 32 + hi * 16);
                kf[2 * d0 + 1] = *(const bf16x8*)(sb + OFF_K + (32 + r32) * KP + d0 * 32 + hi * 16); }
            const unsigned char* vb = sb + OFF_V + (4 * hi + ((lane & 15) >> 2)) * VP + (16 * ((lane >> 4) & 1) + 4 * (lane & 3)) * 2;
            f32x4 fka[4], fkb[4];
            if (FOX) { const float* fk = (const float*)(sb + OFF_F);
#pragma unroll
                for (int g4 = 0; g4 < 4; ++g4) { fka[g4] = *(const f32x4*)(fk + 8 * g4 + 4 * hi); fkb[g4] = *(const f32x4*)(fk + 32 + 8 * g4 + 4 * hi); } }
            v4i16_t vs[2][DV / 32][2];
#pragma unroll
            for (int dvt = 0; dvt < DV / 32; ++dvt) { vs[0][dvt][0] = vtr(vb + dvt * 64); vs[0][dvt][1] = vtr(vb + 8 * VP + dvt * 64); }
            __builtin_amdgcn_sched_barrier(0);
            f32x16 p0, p1;
#pragma unroll
            for (int r = 0; r < 16; ++r) { p0[r] = 0.f; p1[r] = 0.f; }
#pragma unroll
            for (int d0 = 0; d0 < 4; ++d0) { p0 = MFMA32(kf[2 * d0], qf[d0], p0); p1 = MFMA32(kf[2 * d0 + 1], qf[d0], p1); }
            if (FOX) {
#pragma unroll
                for (int g4 = 0; g4 < 4; ++g4) { const f32x4 fa = fka[g4], fb = fkb[g4];
#pragma unroll
                    for (int i = 0; i < 4; ++i) { p0[4 * g4 + i] = p0[4 * g4 + i] * C2 + fa[i]; p1[4 * g4 + i] = p1[4 * g4 + i] * C2 + fb[i]; } }
                if (t == my_nt - 1) { const int qpos = q0 + 32 * wid + r32;
#pragma unroll
                    for (int r = 0; r < 16; ++r) { const int kp = 64 * t + crow(r, hi); if (kp > qpos) p0[r] = -INFINITY; if (kp + 32 > qpos) p1[r] = -INFINITY; } }
            } else {
                asm volatile("s_nop 15\n\ts_nop 7" : "+v"(p0), "+v"(p1));
            }
            float ma = max3f(p0[0], p0[1], p1[0]), mb = max3f(p0[2], p0[3], p1[1]);
            ma = max3f(ma, p1[2], p1[3]);
#pragma unroll
            for (int r = 4; r < 16; r += 4) { ma = max3f(ma, p0[r], p0[r + 1]); mb = max3f(mb, p0[r + 2], p0[r + 3]); ma = max3f(ma, p1[r], p1[r + 1]); mb = max3f(mb, p1[r + 2], p1[r + 3]); }
            float mx = max3f(ma, mb, ma);
            if (!FOX) mx *= C2;
            mx = max3f(mx, lx_xor(mx, 32, lane), mx);
            if (__any(mx > m)) {
                const float mn = max3f(m, mx, mx), alpha = __builtin_amdgcn_exp2f(m - mn);
                m = mn; l *= alpha;
#pragma unroll
                for (int i = 0; i < DV / 32; ++i)
#pragma unroll
                    for (int r = 0; r < 16; ++r) o[i][r] *= alpha;
            }
            float rsa = 0.f, rsb = 0.f;
#pragma unroll
            for (int r = 0; r < 16; r += 2) {
                f32x2 a = {p0[r], p0[r + 1]}, b = {p1[r], p1[r + 1]};
                if (FOX) { a = a - (f32x2){m, m}; b = b - (f32x2){m, m}; }
                else { a = a * (f32x2){C2, C2} - (f32x2){m, m}; b = b * (f32x2){C2, C2} - (f32x2){m, m}; }
                p0[r] = __builtin_amdgcn_exp2f(a.x); p0[r + 1] = __builtin_amdgcn_exp2f(a.y); p1[r] = __builtin_amdgcn_exp2f(b.x); p1[r + 1] = __builtin_amdgcn_exp2f(b.y);
                rsa += p0[r] + p0[r + 1]; rsb += p1[r] + p1[r + 1]; }
            l += rsa + rsb;
            bf16x8 pf[4];
            { u32x4 w;
              w.x = pk2(p0[0], p0[1]); w.y = pk2(p0[2], p0[3]); w.z = pk2(p0[4], p0[5]); w.w = pk2(p0[6], p0[7]); pf[0] = __builtin_bit_cast(bf16x8, w);
              w.x = pk2(p0[8], p0[9]); w.y = pk2(p0[10], p0[11]); w.z = pk2(p0[12], p0[13]); w.w = pk2(p0[14], p0[15]); pf[1] = __builtin_bit_cast(bf16x8, w);
              w.x = pk2(p1[0], p1[1]); w.y = pk2(p1[2], p1[3]); w.z = pk2(p1[4], p1[5]); w.w = pk2(p1[6], p1[7]); pf[2] = __builtin_bit_cast(bf16x8, w);
              w.x = pk2(p1[8], p1[9]); w.y = pk2(p1[10], p1[11]); w.z = pk2(p1[12], p1[13]); w.w = pk2(p1[14], p1[15]); pf[3] = __builtin_bit_cast(bf16x8, w); }
            __builtin_amdgcn_sched_barrier(0);
#pragma unroll
            for (int ks = 0; ks < 4; ++ks) {
                if (ks + 1 < 4) {
#pragma unroll
                    for (int dvt = 0; dvt < DV / 32; ++dvt) { vs[(ks + 1) & 1][dvt][0] = vtr(vb + 16 * (ks + 1) * VP + dvt * 64); vs[(ks + 1) & 1][dvt][1] = vtr(vb + (16 * (ks + 1) + 8) * VP + dvt * 64); }
                    __builtin_amdgcn_sched_barrier(0);
                }
#pragma unroll
                for (int dvt = 0; dvt < DV / 32; ++dvt) {
                    const v4i16_t lo = vs[ks & 1][dvt][0], h8 = vs[ks & 1][dvt][1];
                    const bf16x8 vf = (bf16x8){lo[0], lo[1], lo[2], lo[3], h8[0], h8[1], h8[2], h8[3]};
                    o[dvt] = MFMA32(vf, pf[ks], o[dvt]);
                }
                __builtin_amdgcn_sched_barrier(0);
            }
        }
        if (t + 1 < NT) { ATT_STORE(lds + ((t + 1) & 1) * STAGE); if (t + 2 < NT) ATT_LOAD(t + 2); }
        __syncthreads();
    }
#undef ATT_LOAD
#undef ATT_STORE
    l_out = l + lx_xor(l, 32, lane);
}

__device__ __forceinline__ void fox_unit(const Args& a, int bh, int qb, unsigned char* lds, int w0, bool dry = false) {
    THREAD_IDS(); const int wid = wave;
    const int bl = bh >> 4, h = bh & 15, q0 = qb * 256, r32 = lane & 31, hi = lane >> 5;
    bf16_t* PROJ = (bf16_t*)(wsl(a.ws) + WS_PROJ);
    const size_t rowb = (size_t)bl * SEQ;
    f32x16 o[2]; float l;
    bf16_t* orow = PROJ + (rowb + q0 + 32 * wid + r32) * LDP;
    u32x2 gws[8];
#pragma unroll
    for (int k = 0; k < 8; ++k) gws[k] = *(const u32x2*)(orow + C_FG + h * 64 + 32 * (k >> 2) + 8 * (k & 3) + 4 * hi);
    attn_pass<64, true>(o, l, PROJ + (rowb + q0 + 32 * wid) * LDP + C_FQ + h * 64, PROJ + rowb * LDP + C_FK + h * 64, PROJ + rowb * LDP + C_FV + h * 64,
                        (const float*)(wsl(a.ws) + WS_F2) + (size_t)bh * SEQ, q0, lds, w0);
    const float inv = 1.0f / l;
    bf16_t* owr = dry ? (bf16_t*)(wsl(a.ws) + WS_M16) + (rowb + q0 + 32 * wid + r32) * 1024 : orow + C_FQ;
#pragma unroll
    for (int dvt = 0; dvt < 2; ++dvt)
#pragma unroll
        for (int g4 = 0; g4 < 4; ++g4) { const int dv = 32 * dvt + 8 * g4 + 4 * hi;
            const u32x2 gw = gws[dvt * 4 + g4];
            u32x2 w; w.x = pk2(o[dvt][4 * g4] * inv * bflo(gw.x), o[dvt][4 * g4 + 1] * inv * bfhi(gw.x)); w.y = pk2(o[dvt][4 * g4 + 2] * inv * bflo(gw.y), o[dvt][4 * g4 + 3] * inv * bfhi(gw.y));
            *(u32x2*)(owr + h * 64 + dv) = w; }
}
__device__ __forceinline__ void diff_unit(const Args& a, int layer, int bh, int qb, unsigned char* lds, int w0, bool dry = false) {
    THREAD_IDS(); const int wid = wave;
    const int bl = bh >> 3, h = bh & 7, q0 = qb * 256, r32 = lane & 31, hi = lane >> 5;
    bf16_t* PROJ = (bf16_t*)(wsl(a.ws) + WS_PROJ);
    const size_t rowb = (size_t)bl * SEQ;
    const float lam = ((const float*)(wsl(a.ws) + WS_LAM))[layer * 2], lami = ((const float*)(wsl(a.ws) + WS_LAM))[layer * 2 + 1];
    f32x16 o1[4]; float l1, l2;
    float* scr = (float*)(wsl(a.ws) + WS_M32) + ((size_t)((bh * 8 + qb) * 8 + wid) * 64 + lane) * 64;
    attn_pass<128, false>(o1, l1, PROJ + (rowb + q0 + 32 * wid) * LDP + C_DQ + h * 128, PROJ + rowb * LDP + C_DK + h * 128, PROJ + rowb * LDP + C_DV + h * 128, nullptr, q0, lds, w0);
    { const float inv = 1.0f / l1;
#pragma unroll
      for (int i = 0; i < 4; ++i)
#pragma unroll
          for (int r = 0; r < 16; r += 4) *(f32x4*)(scr + i * 16 + r) = (f32x4){o1[i][r] * inv, o1[i][r + 1] * inv, o1[i][r + 2] * inv, o1[i][r + 3] * inv}; }
    attn_pass<128, false>(o1, l2, PROJ + (rowb + q0 + 32 * wid) * LDP + C_DQ + h * 128 + 64, PROJ + rowb * LDP + C_DK + h * 128 + 64, PROJ + rowb * LDP + C_DV + h * 128, nullptr, q0, lds, w0);
    const float sc2 = lam / l2; float ss = 0.f;
    {   f32x4 c1[16];
#pragma unroll
        for (int k = 0; k < 16; ++k) c1[k] = *(const f32x4*)(scr + 4 * k);
#pragma unroll
        for (int k = 0; k < 16; ++k)
#pragma unroll
            for (int e = 0; e < 4; ++e) { const int i = k >> 2, r = 4 * (k & 3) + e; const float v = c1[k][e] - sc2 * o1[i][r]; o1[i][r] = v; ss += v * v; }
    }
    ss += lx_xor(ss, 32, lane);
    const float rs = rsqrtf(ss * (1.0f / 128.0f) + EPS) * (1.0f - lami);
    bf16_t* orow = PROJ + (rowb + q0 + 32 * wid + r32) * LDP;
    const float* sw = a.in[11] + layer * 128;
    bf16_t* owr = dry ? (bf16_t*)(wsl(a.ws) + WS_M16) + (rowb + q0 + 32 * wid + r32) * 1024 : orow + C_DQ;
#pragma unroll
    for (int half = 0; half < 2; ++half) {
        u32x2 gwv[8]; f32x4 wvv[8];
#pragma unroll
        for (int k = 0; k < 8; ++k) { const int dvt = 2 * half + (k >> 2), g4 = k & 3, dv = 32 * dvt + 8 * g4 + 4 * hi;
            gwv[k] = *(const u32x2*)(orow + C_DG + h * 128 + dv); wvv[k] = *(const f32x4*)(sw + dv); }
#pragma unroll
        for (int k = 0; k < 8; ++k) { const int dvt = 2 * half + (k >> 2), g4 = k & 3, dv = 32 * dvt + 8 * g4 + 4 * hi;
            const u32x2 gw = gwv[k]; const f32x4 wv = wvv[k];
            u32x2 w; w.x = pk2(o1[dvt][4 * g4] * rs * wv.x * bflo(gw.x), o1[dvt][4 * g4 + 1] * rs * wv.y * bfhi(gw.x));
            w.y = pk2(o1[dvt][4 * g4 + 2] * rs * wv.z * bflo(gw.y), o1[dvt][4 * g4 + 3] * rs * wv.w * bfhi(gw.y));
            *(u32x2*)(owr + h * 128 + dv) = w; }
    }
}

#define XB_TMO      128
#define XB_XCNT(j)  (256  + 64 * (j))
#define XB_XSUB(j)  (1280 + 64 * (j))
#define XB_XGEN(j)  (2304 + 64 * (j))
#define XB_TOP      3328
#define XB_TOPGEN   3392
#define XCD_BAR_WORDS 3456
#define XB_SPIN_CAP (1u << 18)

__device__ __forceinline__ unsigned xb_ld(unsigned* p)              { return __hip_atomic_load(p, __ATOMIC_RELAXED, __HIP_MEMORY_SCOPE_AGENT); }
__device__ __forceinline__ unsigned xb_add(unsigned* p, unsigned v) { return __hip_atomic_fetch_add(p, v, __ATOMIC_RELAXED, __HIP_MEMORY_SCOPE_AGENT); }
__device__ __forceinline__ unsigned xb_xcc_id() { return (unsigned)__builtin_amdgcn_s_getreg((3 << 11) | 20) & 0xFu; }
#define XB_SPIN(cond, bar) do { unsigned _sp = 0; while (cond) { __builtin_amdgcn_s_sleep(1); \
    if ((++_sp & 255u) == 0u) { if (xb_ld(&(bar)[XB_TMO])) break; if (_sp > XB_SPIN_CAP) { atomicAdd(&(bar)[XB_TMO], 1u); break; } } } } while (0)

struct XcdBarrier {
    unsigned* bar; unsigned x;
    volatile LAS unsigned* st;
};

__device__ __forceinline__ XcdBarrier xcd_barrier_post(unsigned* bar, volatile LAS unsigned* st) {
    XcdBarrier b; b.bar = bar; b.x = xb_xcc_id(); b.st = st;
    if (threadIdx.x == 0) (void)xb_add(&bar[XB_XCNT(b.x)], 1u);
    return b;
}
__device__ __forceinline__ void xcd_barrier_complete(unsigned* bar, unsigned x, unsigned& nloc, unsigned& nx) {
    const unsigned G = gridDim.x * gridDim.y * gridDim.z;
    unsigned sum, cnt, mine, sp = 0u;
    for (;;) {
        sum = 0u; cnt = 0u; mine = 0u;
#pragma unroll
        for (unsigned j = 0; j < 16; ++j) { const unsigned c = xb_ld(&bar[XB_XCNT(j)]); sum += c; cnt += (c > 0u) ? 1u : 0u; mine = (j == x) ? c : mine; }
        if (sum == G) break;
        __builtin_amdgcn_s_sleep(1);
        if ((++sp & 255u) == 0u) { if (xb_ld(&bar[XB_TMO])) break; if (sp > XB_SPIN_CAP) { atomicAdd(&bar[XB_TMO], 1u); break; } }
    }
    nloc = mine > 0u ? mine : 1u; nx = cnt > 0u ? cnt : 1u;
}

__device__ __forceinline__ bool is_thread0(int w0) { int lane; asm volatile("v_mbcnt_lo_u32_b32 %0, -1, 0\n\tv_mbcnt_hi_u32_b32 %0, -1, %0" : "=v"(lane)); return w0 == 0 && lane == 0; }
__device__ __forceinline__ void xcd_barrier(const XcdBarrier& b, int w0) {
    asm volatile("s_waitcnt vmcnt(0)" ::: "memory");
    __syncthreads();
    if (is_thread0(w0)) {
        unsigned* bar = b.bar;
        __builtin_amdgcn_s_waitcnt(0);
        unsigned nloc = b.st[0], nx = b.st[1];
        if (nloc == 0u) { xcd_barrier_complete(bar, b.x, nloc, nx); b.st[0] = nloc; b.st[1] = nx; }
        const unsigned old = xb_add(&bar[XB_XSUB(b.x)], 1u);
        const unsigned gen = old / nloc;
        if (old + 1u == (gen + 1u) * nloc) {
            __builtin_amdgcn_fence(__ATOMIC_RELEASE, "agent");
            asm volatile("s_waitcnt vmcnt(0)" ::: "memory");
            const unsigned og = xb_add(&bar[XB_TOP], 1u);
            const unsigned tg = og / nx;
            if (og + 1u == (tg + 1u) * nx) xb_add(&bar[XB_TOPGEN], 1u);
            else XB_SPIN(xb_ld(&bar[XB_TOPGEN]) == tg, bar);
            __builtin_amdgcn_fence(__ATOMIC_ACQUIRE, "agent");
            xb_add(&bar[XB_XGEN(b.x)], 1u);
            asm volatile("s_waitcnt vmcnt(0)" ::: "memory");
        } else {
            XB_SPIN(xb_ld(&bar[XB_XGEN(b.x)]) == gen, bar);
            __builtin_amdgcn_fence(__ATOMIC_ACQUIRE, "agent");
            asm volatile("s_waitcnt vmcnt(0)" ::: "memory");
        }
    }
    __syncthreads();
}

__global__ void __launch_bounds__(NTHR, 2) hybrid_fwd(Args args) {
    extern __shared__ __attribute__((aligned(16))) unsigned char lds[];
    cg::grid_group grid = cg::this_grid();
    const int wave0 = __builtin_amdgcn_readfirstlane((int)threadIdx.x >> 6);
#define ws (wsl(args.ws))
#define CTR ((unsigned*)(ws + WS_CTR))
    LAS unsigned char* ldsl = (LAS unsigned char*)lds;

#ifndef PHM
#define PHM 0xffff
#endif
    { volatile LAS unsigned* st0 = (volatile LAS unsigned*)(ldsl + LDS_MISC + 64); if (threadIdx.x < 2) st0[threadIdx.x] = 0u; }
    if (blockIdx.x == 0) { unsigned* bw = (unsigned*)(ws + WS_BAR); for (int i = threadIdx.x; i < XCD_BAR_WORDS; i += NTHR) bw[i] = 0u; }
    __syncthreads();
    p0_prologue(args, lds, wave0);
    grid.sync();
    const XcdBarrier xbar = xcd_barrier_post((unsigned*)(ws + WS_BAR), (volatile LAS unsigned*)(ldsl + LDS_MISC + 64));
#define GRID_SYNC() xcd_barrier(xbar, wave0)
#ifndef TMASK
#define TMASK 0
#endif
    unsigned long long t_acc = 0ull, t_0 = 0ull;
#define T_BEGIN(bit) do { if (TMASK & (bit)) t_0 = __builtin_amdgcn_s_memrealtime(); } while (0)
#define T_END(bit) do { if (TMASK & (bit)) t_acc += __builtin_amdgcn_s_memrealtime() - t_0; } while (0)
    for (int layer = 0; layer < 2; ++layer) {
        const float* xin = (layer == 0) ? args.in[0] : args.out;
        if (PHM & 2) norm_rows<true>(xin, args.in[1] + layer * 1024, (bf16_t*)(ws + WS_H), nullptr, wave0);
        GRID_SYNC();
        for (int g = 0; g < NGRP; ++g) {
            const int pass = layer * NGRP + g;
            T_BEGIN(1);
            if (PHM & 4) { pg8::Gemm gm{(const bf16_t*)(ws + WS_H) + (size_t)g * TG * 1024, (const bf16_t*)(ws + WS_WIN) + (size_t)layer * NP * 1024, TG, NP, 1024, 1024};
              pg8::StaticOrder S; S.init(TG, NP, (int)gridDim.x, lbx());
              pg8::EpiProj E{(bf16_t*)(ws + WS_PROJ), (float*)(ws + WS_SMALL), (const float*)(ws + WS_LAM) + 16 + layer * 32};
              pg8::gemm_phase<pg8::EpiProj, pg8::StaticOrder, true, true>(ldsl, gm, S, E, wave0); }
            if (g > 0 && lbx() >= 128) {
              pg8::Gemm gm{(const bf16_t*)(ws + WS_M16), (const bf16_t*)(ws + WS_WOUT) + (size_t)layer * 1024 * 1024, TG, 1024, 1024, 1024};
              pg8::StaticOrder S; S.init(TG, 1024, (int)gridDim.x, lbx() - 128);
              pg8::EpiRes E{xin + (size_t)(g - 1) * TG * 1024, args.out + (size_t)(g - 1) * TG * 1024};
              pg8::gemm_phase<pg8::EpiRes, pg8::StaticOrder, true, true>(ldsl, gm, S, E, wave0); }
            GRID_SYNC();
            T_END(1); T_BEGIN(2);
#ifndef EXPER
#define EXPER 0
#endif
            if (EXPER == 2) { pg8::Gemm gm{(const bf16_t*)(ws + WS_H) + (size_t)g * TG * 1024, (const bf16_t*)(ws + WS_WIN) + (size_t)layer * NP * 1024, TG, NP, 1024, 1024};
              pg8::StaticOrder S; S.init(TG, NP, (int)gridDim.x, lbx());
              pg8::EpiProj E{(bf16_t*)(ws + WS_PROJ), (float*)(ws + WS_SMALL), (const float*)(ws + WS_LAM) + 16 + layer * 32};
              pg8::gemm_phase<pg8::EpiProj, pg8::StaticOrder, true, true>(ldsl, gm, S, E, wave0); GRID_SYNC(); }
            if (EXPER == 5) { for (int q = 0; q < 10; ++q) GRID_SYNC(); }
            UNIT_LOOP(CTR + (pass * 3 + 0) * 64, 648,
                  if (u < 8) fcum_unit(args, u, wave0);
                  else if (u < 136) rope_unit(args, u - 8, wave0);
                  else ssd_states_unit(args, layer, u - 136, lds, wave0););
            GRID_SYNC();
            T_END(2); T_BEGIN(4);
            UNIT_LOOP(CTR + (pass * 3 + 1) * 64, 1024,
                  if (u < 256) diff_unit(args, layer, u & 31, 7 - (u >> 5), lds, wave0);
                  else if (u < 512) ssd_scan_unit(args, u - 256, wave0);
                  else { const int j = u - 512; fox_unit(args, j & 63, 7 - (j >> 6), lds, wave0); });
            GRID_SYNC();
            T_END(4); T_BEGIN(8);
            { const int n = (lbx() < 128) ? 0 : 2;
              const int ycol = (n == 0) ? C_FQ : C_DQ;
              pg8::Gemm gm{(const bf16_t*)(ws + WS_PROJ) + ycol, (const bf16_t*)(ws + WS_WBR) + (size_t)(layer * 3 + n) * 1024 * 1024, TG, 1024, 1024, LDP};
              pg8::StaticOrder S; S.init(TG, 1024, (int)gridDim.x, lbx() & 127);
              pg8::EpiGate E{(const bf16_t*)(ws + WS_PROJ) + C_MG + n * 1024, (float*)(ws + WS_M32), (bf16_t*)(ws + WS_M16), n};
              pg8::gemm_phase<pg8::EpiGate, pg8::StaticOrder, true, true>(ldsl, gm, S, E, wave0); }
            UNIT_LOOP(CTR + (pass * 3 + 2) * 64, 512, ssd_out_unit(args, layer, u, lds, wave0););
            GRID_SYNC();
            T_END(8); T_BEGIN(16);
            { pg8::Gemm gm{(const bf16_t*)(ws + WS_PROJ) + C_SZ, (const bf16_t*)(ws + WS_WBR) + (size_t)(layer * 3 + 1) * 1024 * 1024, TG, 1024, 1024, LDP};
              pg8::StaticOrder S; S.init(TG, 1024, (int)gridDim.x, lbx());
              pg8::EpiGate E{(const bf16_t*)(ws + WS_PROJ) + C_MG + 1024, (float*)(ws + WS_M32), (bf16_t*)(ws + WS_M16), 1};
              pg8::gemm_phase<pg8::EpiGate, pg8::StaticOrder, true, true>(ldsl, gm, S, E, wave0); }
            GRID_SYNC();
            T_END(16);
        }
        { pg8::Gemm gm{(const bf16_t*)(ws + WS_M16), (const bf16_t*)(ws + WS_WOUT) + (size_t)layer * 1024 * 1024, TG, 1024, 1024, 1024};
          pg8::StaticOrder S; S.init(TG, 1024, (int)gridDim.x, lbx());
          pg8::EpiRes E{xin + (size_t)(NGRP - 1) * TG * 1024, args.out + (size_t)(NGRP - 1) * TG * 1024};
          pg8::gemm_phase<pg8::EpiRes, pg8::StaticOrder, true, true>(ldsl, gm, S, E, wave0); }
        if (TMASK && layer == 1 && blockIdx.x == 0) { const unsigned long long ts = __builtin_amdgcn_s_memrealtime(); while (__builtin_amdgcn_s_memrealtime() - ts < 4ull * t_acc) __builtin_amdgcn_s_sleep(32); }
        GRID_SYNC();
    }
#undef ws
#undef CTR
    if (PHM & 4096) norm_rows<false>(args.out, args.in[14], nullptr, args.out, wave0);
}

extern "C" void kernel_launch(void* const* d_in, const int* in_sizes, int n_in, void* d_out, int out_size, void* d_ws, size_t ws_size, hipStream_t stream) {
    static int grid = 0;
    if (grid == 0) {
        if (n_in != 15 || out_size != MT * DM || ws_size < WS_END) { fprintf(stderr, "kernel_launch: unexpected shapes (n_in %d out %d ws %zu need %zu)\n", n_in, out_size, ws_size, (size_t)WS_END); grid = -1; return; }
        int dev = 0, cus = 0, per_cu = 0;
        hipGetDevice(&dev); hipDeviceGetAttribute(&cus, hipDeviceAttributeMultiprocessorCount, dev);
        if (hipFuncSetAttribute((const void*)hybrid_fwd, hipFuncAttributeMaxDynamicSharedMemorySize, LDS_BYTES) != hipSuccess) { fprintf(stderr, "kernel_launch: hipFuncSetAttribute failed\n"); grid = -1; return; }
        if (hipOccupancyMaxActiveBlocksPerMultiprocessor(&per_cu, (const void*)hybrid_fwd, NTHR, LDS_BYTES) != hipSuccess || per_cu < 1) { fprintf(stderr, "kernel_launch: occupancy query gave %d\n", per_cu); per_cu = 1; }
        (void)hipGetLastError();
        grid = cus * 1;
    }
    if (grid < 0) return;
    Args a{};
    for (int i = 0; i < 15; ++i) a.in[i] = (const float*)d_in[i];
    a.out = (float*)d_out; a.ws = (unsigned char*)d_ws;
    void* kargs[] = {&a};
    hipError_t e = hipLaunchCooperativeKernel((const void*)hybrid_fwd, dim3(grid), dim3(NTHR), kargs, LDS_BYTES, stream);
    if (e != hipSuccess) fprintf(stderr, "kernel_launch: cooperative launch failed: %s (grid %d)\n", hipGetErrorString(e), grid);
}
```

```cpp
#include <hip/hip_runtime.h>
#include <hip/hip_cooperative_groups.h>
#include <cstdio>
#include <cstdint>
#include <cstddef>
#include <cmath>
namespace cg = cooperative_groups;
namespace pg8 {
#define PG8_LAS __attribute__((address_space(3)))
typedef unsigned short bf16_t;
typedef short bf16x8 __attribute__((ext_vector_type(8)));
typedef float f32x4 __attribute__((ext_vector_type(4)));
typedef unsigned u32x4 __attribute__((ext_vector_type(4)));
constexpr int BM = 256, BK = 64, HALF = 128, HTB = HALF * BK * 2  , STAGE_BYTES = 8 * HTB, NXCD = 8, WGM = 8;

__host__ __device__ __forceinline__ int lds_byte(int r, int c) { const int st = (r >> 4) * 2 + (c >> 5), rr = r & 15, cc = c & 31, ob = rr * 64 + cc * 2; return st * 1024 + (ob ^ (((ob >> 9) & 1) << 5)); }
__host__ __device__ __forceinline__ void stage_rc(int b, int& R, int& C) { const int st = b / 1024, sb = b % 1024, swz = sb ^ (((sb >> 9) & 1) << 5); R = (st >> 1) * 16 + swz / 64; C = (st & 1) * 32 + (swz % 64) / 2; }
__host__ __device__ __forceinline__ int perm32(int rho) { const int n = rho >> 4, i = rho & 15; return 8 * (i >> 2) + 4 * n + (i & 3); }

struct Unit { int pm, pn; };
struct Gemm { const bf16_t* A; const bf16_t* Bt; int M, N, K, lda; };

struct StaticOrder {
    int nM, nN, nwg, G, c;
    __host__ __device__ void init(int M, int N, int G_, int c_) { nM = M / BM; nN = N / BM; nwg = nM * nN; G = G_; c = c_; }
    __host__ __device__ bool next(int i, Unit& u) const {
        const long L = (long)i * G + c; if (L >= nwg) return false;
        int wgid = (int)L; { const int q = nwg / NXCD, r = nwg % NXCD, xcd = wgid % NXCD, off = wgid / NXCD; wgid = (xcd < r ? xcd * (q + 1) : r * (q + 1) + (xcd - r) * q) + off; }
        const int nig = WGM * nN, gid = wgid / nig, fm = gid * WGM, gsz = (nM - fm) < WGM ? (nM - fm) : WGM;
        u.pm = fm + ((wgid % nig) % gsz); u.pn = (wgid % nig) / gsz; return true;
    }
    __device__ __forceinline__ void a_ready(const Unit&) const {}
    __device__ __forceinline__ void done(const Unit&) const {}
};

__device__ __forceinline__ unsigned cvt_pk_bf16(float lo, float hi) { unsigned r; asm volatile("v_cvt_pk_bf16_f32 %0, %1, %2" : "=v"(r) : "v"(lo), "v"(hi)); return r; }

typedef unsigned u32x2 __attribute__((ext_vector_type(2)));
constexpr int LDP = 14336;
__device__ __forceinline__ float silu_f(float v) { return v * __builtin_amdgcn_rcpf(1.0f + __expf(-v)); }
__device__ __forceinline__ float sigm_f(float v) { return __builtin_amdgcn_rcpf(1.0f + __expf(-v)); }
__device__ __forceinline__ float bflo(unsigned w) { return __uint_as_float(w << 16); }
__device__ __forceinline__ float bfhi(unsigned w) { return __uint_as_float(w & 0xffff0000u); }

struct EpiProj {
    static constexpr bool PERM = true, AFTER_DRAIN = false;
    bf16_t* P; float* small; const float* sbias;
    __device__ __forceinline__ void operator()(const f32x4 (&acc)[2][2][4][2], const Unit& u, int wr, int wc, int fr, int fq) const {
        asm volatile("" : "+v"(fr));
        const int row0 = u.pm * BM + wr * 64 + fr;
        if (u.pn < 56) {
            const int pn = u.pn;
            const int mode = (pn < 12) ? 0 : (pn < 20) ? 1 : (pn < 40) ? 0 : (pn < 44) ? 1 : 2;
            const int col0 = pn * BM + wc * 32 + 8 * fq;
#pragma unroll
            for (int ai = 0; ai < 2; ++ai)
#pragma unroll
                for (int m = 0; m < 4; ++m) { bf16_t* rowp = P + (size_t)(row0 + ai * HALF + m * 16) * LDP + col0;
#pragma unroll
                    for (int bj = 0; bj < 2; ++bj) { f32x4 v0 = acc[ai][bj][m][0], v1 = acc[ai][bj][m][1];
                        if (mode == 1) {
#pragma unroll
                            for (int i = 0; i < 4; ++i) { v0[i] = silu_f(v0[i]); v1[i] = silu_f(v1[i]); } }
                        else if (mode == 2) {
#pragma unroll
                            for (int i = 0; i < 4; ++i) { v0[i] = sigm_f(v0[i]); v1[i] = sigm_f(v1[i]); } }
                        u32x4 w; w.x = cvt_pk_bf16(v0[0], v0[1]); w.y = cvt_pk_bf16(v0[2], v0[3]); w.z = cvt_pk_bf16(v1[0], v1[1]); w.w = cvt_pk_bf16(v1[2], v1[3]);
                        *(u32x4*)(rowp + bj * HALF) = w; } }
        } else if (wc == 0) {
            const float* sbp = sbias; asm volatile("" : "+s"(sbp));
            f32x4 bb[2]; bb[0] = *(const f32x4*)(sbp + 8 * fq); bb[1] = *(const f32x4*)(sbp + 8 * fq + 4);
#pragma unroll
            for (int ai = 0; ai < 2; ++ai)
#pragma unroll
                for (int m = 0; m < 4; ++m) { const int row = row0 + ai * HALF + m * 16;
#pragma unroll
                    for (int n = 0; n < 2; ++n) { f32x4 o;
#pragma unroll
                        for (int i = 0; i < 4; ++i) { const int c = 8 * fq + 4 * n + i; const float v = acc[ai][0][m][n][i];
                            const float xx = v + bb[n][i];
                            const float sp = __logf(1.0f + __expf(-fabsf(xx)));
                            o[i] = (c < 16) ? (fminf(xx, 0.f) - sp) : (fmaxf(xx, 0.f) + sp); }
                        *(f32x4*)(small + (size_t)row * 32 + 8 * fq + 4 * n) = o; } }
        }
    }
};
struct EpiGate {
    static constexpr bool PERM = false, AFTER_DRAIN = false;
    const bf16_t* gate; float* m32; bf16_t* m16; int nidx;
    __device__ __forceinline__ void operator()(const f32x4 (&acc)[2][2][4][2], const Unit& u, int wr, int wc, int fr, int fq) const {
        asm volatile("" : "+v"(fr));
        const int row0 = u.pm * BM + wr * 64 + fr, col0 = u.pn * BM + wc * 32 + 4 * fq;
        u32x2 gw[2][4]; f32x4 mv[2][4]; u32x2 hv[2][4];
#define EG_LOAD(c_, s_) do { const int row_ = row0 + ((c_) >> 2) * HALF + ((c_) & 3) * 16; \
        _Pragma("unroll") for (int e_ = 0; e_ < 4; ++e_) { const int col_ = col0 + (e_ >> 1) * HALF + (e_ & 1) * 16; \
            gw[s_][e_] = *(const u32x2*)(gate + (size_t)row_ * LDP + col_); \
            if (nidx == 1) { mv[s_][e_] = *(const f32x4*)(m32 + (size_t)row_ * 1024 + col_); hv[s_][e_] = *(const u32x2*)(m16 + (size_t)row_ * 1024 + col_); } } } while (0)
        EG_LOAD(0, 0);
#pragma unroll
        for (int c = 0; c < 8; ++c) {
            if (c + 1 < 8) EG_LOAD(c + 1, (c + 1) & 1);
            const int ai = c >> 2, m = c & 3, row = row0 + ai * HALF + m * 16;
#pragma unroll
            for (int e = 0; e < 4; ++e) { const int bj = e >> 1, n = e & 1, col = col0 + bj * HALF + n * 16;
                const u32x2 g2 = gw[c & 1][e];
                f32x4 v = acc[ai][bj][m][n];
                v[0] *= bflo(g2.x); v[1] *= bfhi(g2.x); v[2] *= bflo(g2.y); v[3] *= bfhi(g2.y);
                if (nidx == 0) *(f32x4*)(m32 + (size_t)row * 1024 + col) = v;
                else { if (nidx == 1) { const u32x2 t2 = hv[c & 1][e]; v += mv[c & 1][e]; v[0] += bflo(t2.x); v[1] += bfhi(t2.x); v[2] += bflo(t2.y); v[3] += bfhi(t2.y); }
                    u32x2 w; w.x = cvt_pk_bf16(v[0], v[1]); w.y = cvt_pk_bf16(v[2], v[3]); *(u32x2*)(m16 + (size_t)row * 1024 + col) = w; } }
        }
#undef EG_LOAD
    }
};
struct EpiRes {
    static constexpr bool PERM = false, AFTER_DRAIN = false;
    const float* xin; float* out;
    __device__ __forceinline__ void operator()(const f32x4 (&acc)[2][2][4][2], const Unit& u, int wr, int wc, int fr, int fq) const {
        asm volatile("" : "+v"(fr));
        const int row0 = u.pm * BM + wr * 64 + fr, col0 = u.pn * BM + wc * 32 + 4 * fq;
        f32x4 bx[2][4];
#define ER_LOAD(c_, s_) do { const size_t off_ = (size_t)(row0 + ((c_) >> 2) * HALF + ((c_) & 3) * 16) * 1024 + col0; \
        _Pragma("unroll") for (int e_ = 0; e_ < 4; ++e_) bx[s_][e_] = *(const f32x4*)(xin + off_ + (e_ >> 1) * HALF + (e_ & 1) * 16); } while (0)
        ER_LOAD(0, 0);
#pragma unroll
        for (int c = 0; c < 8; ++c) {
            if (c + 1 < 8) ER_LOAD(c + 1, (c + 1) & 1);
            const int ai = c >> 2, m = c & 3; const size_t off = (size_t)(row0 + ai * HALF + m * 16) * 1024 + col0;
#pragma unroll
            for (int e = 0; e < 4; ++e) { const int bj = e >> 1, n = e & 1; *(f32x4*)(out + off + bj * HALF + n * 16) = bx[c & 1][e] + acc[ai][bj][m][n]; }
        }
#undef ER_LOAD
    }
};
template <class Epi, class Sched, bool ALIGN_EPI = false, bool SP2 = false>
__device__ __forceinline__ void gemm_phase(PG8_LAS unsigned char* lds, const Gemm g, const Sched& S, const Epi& E, int w0) {
    int lane_; asm volatile("v_mbcnt_lo_u32_b32 %0, -1, 0\n\tv_mbcnt_hi_u32_b32 %0, -1, %0" : "=v"(lane_)); int wid = w0; asm volatile("" : "+s"(wid)); const int tid = wid * 64 + lane_, lane = tid & 63, wr = wid >> 2, wc = wid & 3, fr = lane & 15, fq = lane >> 4;
    const int K = g.K, nt = K / BK;
    unsigned voffA[2], voffB[2];
#pragma unroll
    for (int i = 0; i < 2; ++i) { int R, C; stage_rc(tid * 16 + i * 8192, R, C); const int Rb = Epi::PERM ? ((R & ~31) + perm32(R & 31)) : R;
        voffA[i] = (unsigned)(R * g.lda + C) * 2u; voffB[i] = (unsigned)(Rb * K + C) * 2u; }
    const size_t kstep = (size_t)(BK * 2);
    const size_t hstepA = (size_t)HALF * g.lda * 2, hstepB = (size_t)HALF * K * 2;
    const size_t tstepA = 2 * hstepA, tstepB = 2 * hstepB;
    const unsigned ldsw = (unsigned)wid * 1024u;
    const int aoff = lds_byte(wr * 64 + fr, fq * 8), boff = lds_byte(wc * 32 + fr, fq * 8);
#define PG8_SA(b, h) (((b) * 2 + (h)) * HTB)
#define PG8_SB(b, h) ((4 + (b) * 2 + (h)) * HTB)
#define PG8_STAGE(bufoff, gbase, voff) do { _Pragma("unroll") for (int _i = 0; _i < 2; ++_i) \
        __builtin_amdgcn_global_load_lds((const unsigned*)((const char*)(gbase) + (voff)[_i]), (PG8_LAS unsigned*)(lds + (bufoff) + ldsw + _i * 8192), 16, 0, 0); } while (0)
#define PG8_LDA(dst, b, h) do { _Pragma("unroll") for (int m = 0; m < 4; ++m) _Pragma("unroll") for (int k = 0; k < 2; ++k) dst[m][k] = *(const PG8_LAS bf16x8*)(lds + PG8_SA(b, h) + aoff + m * 2048 + k * 1024); } while (0)
#define PG8_LDB(dst, b, h) do { _Pragma("unroll") for (int n = 0; n < 2; ++n) _Pragma("unroll") for (int k = 0; k < 2; ++k) dst[n][k] = *(const PG8_LAS bf16x8*)(lds + PG8_SB(b, h) + boff + n * 2048 + k * 1024); } while (0)
#define PG8_MMA(ai, bj, At, Bt) do { __builtin_amdgcn_s_setprio(1); _Pragma("unroll") for (int m = 0; m < 4; ++m) _Pragma("unroll") for (int n = 0; n < 2; ++n) _Pragma("unroll") for (int k = 0; k < 2; ++k) \
        acc[ai][bj][m][n] = __builtin_amdgcn_mfma_f32_16x16x32_bf16(Bt[n][k], At[m][k], acc[ai][bj][m][n], 0, 0, 0); __builtin_amdgcn_s_setprio(0); } while (0)
#define PG8_WAIT_V(n) asm volatile("s_waitcnt vmcnt(" #n ")" ::: "memory")
#define PG8_WAIT_L(n) asm volatile("s_waitcnt lgkmcnt(" #n ")" ::: "memory")
#define PG8_BAR __builtin_amdgcn_s_barrier()
#define PG8_SCHED __builtin_amdgcn_sched_barrier(0)
    Unit cur, nxt; int ui = 0;
    if (!S.next(0, cur)) return;
    f32x4 acc[2][2][4][2];
#pragma unroll
    for (int a = 0; a < 2; ++a)
#pragma unroll
        for (int b = 0; b < 2; ++b)
#pragma unroll
            for (int m = 0; m < 4; ++m)
#pragma unroll
                for (int n = 0; n < 2; ++n) acc[a][b][m][n] = (f32x4){0.f, 0.f, 0.f, 0.f};
    bf16x8 At[4][2], B0[2][2], B1[2][2];
    const char* cA = (const char*)g.A + (size_t)cur.pm * tstepA; const char* cB = (const char*)g.Bt + (size_t)cur.pn * tstepB;
    S.a_ready(cur);
    if constexpr (SP2) {
        PG8_STAGE(PG8_SB(0, 0), cB, voffB); PG8_STAGE(PG8_SB(0, 1), cB + hstepB, voffB); PG8_STAGE(PG8_SA(0, 0), cA, voffA); PG8_STAGE(PG8_SA(0, 1), cA + hstepA, voffA);
        if (wr == 1) PG8_BAR;
        PG8_WAIT_V(2); PG8_BAR;
        PG8_STAGE(PG8_SB(1, 0), cB + kstep, voffB); PG8_STAGE(PG8_SA(1, 0), cA + kstep, voffA); PG8_STAGE(PG8_SB(1, 1), cB + hstepB + kstep, voffB);
        PG8_WAIT_V(6); PG8_BAR;
    } else {
        PG8_STAGE(PG8_SB(0, 0), cB, voffB); PG8_STAGE(PG8_SA(0, 0), cA, voffA); PG8_STAGE(PG8_SB(0, 1), cB + hstepB, voffB); PG8_STAGE(PG8_SA(0, 1), cA + hstepA, voffA);
        if (wr == 1) PG8_BAR;
        PG8_WAIT_V(4); PG8_BAR;
        PG8_STAGE(PG8_SB(1, 0), cB + kstep, voffB); PG8_STAGE(PG8_SA(1, 0), cA + kstep, voffA); PG8_STAGE(PG8_SB(1, 1), cB + hstepB + kstep, voffB);
        PG8_WAIT_V(6); PG8_BAR;
    }
    for (;;) {
        const bool has_next = S.next(ui + 1, nxt);
        const char* nA = has_next ? (const char*)g.A + (size_t)nxt.pm * tstepA : cA; const char* nB = has_next ? (const char*)g.Bt + (size_t)nxt.pn * tstepB : cB;
        for (int t = 0; t < nt; t += 2) {
            const bool last = (t == nt - 2);
            const char* a1 = cA + (size_t)(t + 1) * kstep;
            const char* a2 = last ? nA : cA + (size_t)(t + 2) * kstep; const char* b2 = last ? nB : cB + (size_t)(t + 2) * kstep;
            const char* a3 = a2 + kstep; const char* b3 = b2 + kstep;
            if (last && has_next) S.a_ready(nxt);
            if constexpr (SP2) {
            PG8_LDB(B0, 0, 0); PG8_LDB(B1, 0, 1); PG8_SCHED; PG8_LDA(At, 0, 0); PG8_STAGE(PG8_SA(1, 1), a1 + hstepA, voffA);
            PG8_WAIT_V(8); PG8_WAIT_L(0); PG8_BAR; PG8_MMA(0, 0, At, B0); PG8_MMA(0, 1, At, B1); PG8_BAR; PG8_SCHED;
            PG8_LDA(At, 0, 1); PG8_STAGE(PG8_SB(0, 0), b2, voffB); PG8_STAGE(PG8_SB(0, 1), b2 + hstepB, voffB); PG8_STAGE(PG8_SA(0, 0), a2, voffA);
            PG8_WAIT_V(8); PG8_WAIT_L(0); PG8_BAR; PG8_MMA(1, 0, At, B0); PG8_MMA(1, 1, At, B1); PG8_BAR; PG8_SCHED;
            PG8_LDB(B0, 1, 0); PG8_LDB(B1, 1, 1); PG8_SCHED; PG8_LDA(At, 1, 0); PG8_STAGE(PG8_SA(0, 1), a2 + hstepA, voffA);
            PG8_WAIT_V(8); PG8_WAIT_L(0); PG8_BAR; PG8_MMA(0, 0, At, B0); PG8_MMA(0, 1, At, B1); PG8_BAR; PG8_SCHED;
            PG8_LDA(At, 1, 1); PG8_STAGE(PG8_SB(1, 0), b3, voffB); PG8_STAGE(PG8_SB(1, 1), b3 + hstepB, voffB); PG8_STAGE(PG8_SA(1, 0), a3, voffA);
            PG8_WAIT_V(8); PG8_WAIT_L(0); PG8_BAR; PG8_MMA(1, 0, At, B0); PG8_MMA(1, 1, At, B1); PG8_BAR; PG8_SCHED;
            } else {
            PG8_LDB(B0, 0, 0); PG8_SCHED; PG8_LDA(At, 0, 0); PG8_STAGE(PG8_SA(1, 1), a1 + hstepA, voffA);
            PG8_WAIT_L(8); PG8_BAR; PG8_WAIT_L(0); PG8_MMA(0, 0, At, B0); PG8_BAR; PG8_SCHED;
            PG8_LDB(B1, 0, 1); PG8_STAGE(PG8_SB(0, 0), b2, voffB);
            PG8_BAR; PG8_WAIT_L(0); PG8_MMA(0, 1, At, B1); PG8_BAR;
            PG8_LDA(At, 0, 1); PG8_STAGE(PG8_SA(0, 0), a2, voffA);
            PG8_BAR; PG8_WAIT_L(0); PG8_MMA(1, 0, At, B0); PG8_BAR; PG8_SCHED;
            PG8_STAGE(PG8_SB(0, 1), b2 + hstepB, voffB);
            PG8_WAIT_V(6); PG8_BAR; PG8_MMA(1, 1, At, B1); PG8_BAR;
            PG8_LDB(B0, 1, 0); PG8_SCHED; PG8_LDA(At, 1, 0); PG8_STAGE(PG8_SA(0, 1), a2 + hstepA, voffA);
            PG8_WAIT_L(8); PG8_BAR; PG8_WAIT_L(0); PG8_MMA(0, 0, At, B0); PG8_BAR; PG8_SCHED;
            PG8_LDB(B1, 1, 1); PG8_STAGE(PG8_SB(1, 0), b3, voffB);
            PG8_BAR; PG8_WAIT_L(0); PG8_MMA(0, 1, At, B1); PG8_BAR;
            PG8_LDA(At, 1, 1); PG8_STAGE(PG8_SA(1, 0), a3, voffA);
            PG8_BAR; PG8_WAIT_L(0); PG8_MMA(1, 0, At, B0); PG8_BAR; PG8_SCHED;
            PG8_STAGE(PG8_SB(1, 1), b3 + hstepB, voffB);
            PG8_WAIT_V(6); PG8_BAR; PG8_MMA(1, 1, At, B1); PG8_BAR;
            }
        }
        if constexpr (ALIGN_EPI) { if (wr == 0) PG8_BAR; }
        if constexpr (!Epi::AFTER_DRAIN) { E(acc, cur, wr, wc, fr, fq); S.done(cur); }
        if (!has_next) break;
#pragma unroll
        for (int a = 0; a < 2; ++a)
#pragma unroll
            for (int b = 0; b < 2; ++b)
#pragma unroll
                for (int m = 0; m < 4; ++m)
#pragma unroll
                    for (int n = 0; n < 2; ++n) acc[a][b][m][n] = (f32x4){0.f, 0.f, 0.f, 0.f};
        cur = nxt; cA = nA; cB = nB; ++ui;
        if constexpr (ALIGN_EPI) { if (wr == 1) PG8_BAR; }
    }
    PG8_WAIT_V(0);
    if constexpr (!ALIGN_EPI) { if (wr == 0) PG8_BAR; }
    PG8_BAR;
    if constexpr (Epi::AFTER_DRAIN) { E.fused(acc, cur, wr, wc, fr, fq, lds, wid, lane); S.done(cur); }
#undef PG8_SA
#undef PG8_SB
#undef PG8_STAGE
#undef PG8_LDA
#undef PG8_LDB
#undef PG8_MMA
#undef PG8_WAIT_V
#undef PG8_WAIT_L
#undef PG8_BAR
#undef PG8_SCHED
}
}

#define LAS __attribute__((address_space(3)))
typedef unsigned short bf16_t;
typedef short bf16x8 __attribute__((ext_vector_type(8)));
typedef short v4i16_t __attribute__((ext_vector_type(4)));
typedef float f32x4 __attribute__((ext_vector_type(4)));
typedef float f32x16 __attribute__((ext_vector_type(16)));
typedef unsigned u32x4 __attribute__((ext_vector_type(4)));
typedef unsigned u32x2 __attribute__((ext_vector_type(2)));
typedef float f32x2 __attribute__((ext_vector_type(2)));

constexpr int DM = 1024, SEQ = 2048, NBATCH = 16, MT = NBATCH * SEQ;
constexpr int GB = 4, TG = GB * SEQ, NGRP = NBATCH / GB;
constexpr int LDP = pg8::LDP, NP = 14592, NIN = 14368;
constexpr int C_FQ = 0, C_FK = 1024, C_FV = 2048, C_FG = 3072, C_SZ = 4096, C_XBC = 5120, C_DQ = 7168, C_DK = 8192, C_DV = 9216, C_DG = 10240, C_MG = 11264;
constexpr float EPS = 1e-6f, LOG2E = 1.4426950408889634f, C2 = 0.125f * 1.4426950408889634f;
constexpr int NTHR = 512, NWAVES = 8;
constexpr int LDS_BYTES = 147456, LDS_MISC = 131072 + 8192;

constexpr size_t WS_CTR = 0, WS_BAR = 32768, WS_ROPE = 65536, WS_LAM = WS_ROPE + 131072, WS_WIN = 1u << 20;
constexpr size_t WS_WBR = WS_WIN + (size_t)2 * NP * 1024 * 2;
constexpr size_t WS_WOUT = WS_WBR + (size_t)6 * 1024 * 1024 * 2;
constexpr size_t WS_H = WS_WOUT + (size_t)2 * 1024 * 1024 * 2;
constexpr size_t WS_PROJ = WS_H + (size_t)MT * 1024 * 2;
constexpr size_t WS_SMALL = WS_PROJ + (size_t)TG * LDP * 2;
constexpr size_t WS_F2 = WS_SMALL + (size_t)TG * 32 * 4;
constexpr size_t WS_CD = WS_F2 + (size_t)GB * 16 * SEQ * 4;
constexpr size_t WS_M32 = WS_CD + 65536;
constexpr size_t WS_M16 = WS_M32 + (size_t)TG * 1024 * 4;
constexpr size_t WS_ST = WS_M16 + (size_t)TG * 1024 * 2;
constexpr size_t WS_PREV = WS_ST + (size_t)GB * 32 * 16 * 8192 * 2;
constexpr size_t WS_END = WS_ST + (size_t)GB * 32 * 16 * 8192 * 4;

struct Args { const float* in[15]; float* out; unsigned char* ws; };

__device__ __forceinline__ unsigned f2bf(float f) { unsigned u = __builtin_bit_cast(unsigned, f); return (u + 0x7fffu + ((u >> 16) & 1u)) >> 16; }
__device__ __forceinline__ unsigned pk2(float lo, float hi) { return pg8::cvt_pk_bf16(lo, hi); }
typedef __bf16 bf16x2_t __attribute__((ext_vector_type(2)));
__device__ __forceinline__ unsigned pk2m(float lo, float hi) { const f32x2 v = {lo, hi}; return __builtin_bit_cast(unsigned, __builtin_convertvector(v, bf16x2_t)); }
__device__ __forceinline__ float bflo(unsigned w) { return __uint_as_float(w << 16); }
__device__ __forceinline__ float bfhi(unsigned w) { return __uint_as_float(w & 0xffff0000u); }
__device__ __forceinline__ float bf1(bf16_t b) { return __uint_as_float(((unsigned)b) << 16); }
__device__ __forceinline__ float lx_xor(float v, int mask, int lane) { return __int_as_float(__builtin_amdgcn_ds_bpermute((lane ^ mask) << 2, __float_as_int(v))); }
__device__ __forceinline__ float lx_up(float v, int d, int lane) { return __int_as_float(__builtin_amdgcn_ds_bpermute((lane - d) << 2, __float_as_int(v))); }
__device__ __forceinline__ float wave_sum(float v, int lane) {
#pragma unroll
    for (int o = 1; o < 64; o <<= 1) v += lx_xor(v, o, lane);
    return v;
}
__device__ __forceinline__ int crow(int r, int hi) { return (r & 3) + 8 * (r >> 2) + 4 * hi; }
#define LDS_WAIT() asm volatile("s_waitcnt lgkmcnt(0)" ::: "memory")
#define THREAD_IDS() int lane; asm volatile("v_mbcnt_lo_u32_b32 %0, -1, 0\n\tv_mbcnt_hi_u32_b32 %0, -1, %0" : "=v"(lane)); int wave = w0; asm volatile("" : "+s"(wave)); const int tid = wave * 64 + lane; (void)tid
#define MFMA32(a, b, c) __builtin_amdgcn_mfma_f32_32x32x16_bf16((a), (b), (c), 0, 0, 0)
#define MFMA16(a, b, c) __builtin_amdgcn_mfma_f32_16x16x32_bf16((a), (b), (c), 0, 0, 0)

__device__ __forceinline__ int lbx() { int b = (int)blockIdx.x; asm volatile("" : "+s"(b)); return b; }
#define GAS __attribute__((address_space(1)))
__device__ __forceinline__ unsigned char* wsl(unsigned char* p) { GAS unsigned char* q = (GAS unsigned char*)p; asm volatile("" : "+s"(q)); return (unsigned char*)q; }
__device__ __forceinline__ int q_draw(unsigned* ctr, int w0) { int v = 0; if (w0 == 0) { int lane; asm volatile("v_mbcnt_lo_u32_b32 %0, -1, 0\n\tv_mbcnt_hi_u32_b32 %0, -1, %0" : "=v"(lane)); if (lane == 0) v = (int)atomicAdd(ctr, 1u); } return v; }
__device__ __forceinline__ int q_pub(int drawn, unsigned char* lds, int w0) {
    volatile int* slot = (volatile int*)(lds + LDS_MISC);
    __syncthreads();
    if (w0 == 0) { int lane; asm volatile("v_mbcnt_lo_u32_b32 %0, -1, 0\n\tv_mbcnt_hi_u32_b32 %0, -1, %0" : "=v"(lane)); if (lane == 0) *slot = drawn; }
    __syncthreads();
    return *slot;
}
#define UNIT_LOOP(ctr_, total_, body_) do { unsigned* c__ = (ctr_); \
    for (;;) { const int d__ = q_draw(c__, wave0); const int u = q_pub(d__, lds, wave0); if (u >= (total_)) break; body_ } } while (0)

__device__ __forceinline__ int win_src_col(int n) {
    if (n < 3072) return n;
    if (n < 7168) return n + 16;
    if (n < 14336) return n + 32;
    if (n < 14352) return 3072 + (n - 14336);
    if (n < 14368) return 7184 + (n - 14352);
    return -1;
}
template <bool MAP> __device__ __forceinline__ void transpose_item(const float* W, int K, int Nsrc, bf16_t* WT, float* scr, int kb, int nb, int lane) {
    const int k0 = 64 * kb, n0 = 32 * nb;
    const int nn = n0 + (lane & 31); const int src = MAP ? win_src_col(nn) : nn;
#pragma unroll 8
    for (int i = 0; i < 32; ++i) { const int kk = 2 * i + (lane >> 5); scr[kk * 33 + (lane & 31)] = (src >= 0) ? W[(size_t)(k0 + kk) * Nsrc + src] : 0.f; }
    LDS_WAIT();
    const int c = lane & 7;
#pragma unroll
    for (int j = 0; j < 4; ++j) { const int n = (lane >> 3) + 8 * j; const float* s = scr + (8 * c) * 33 + n;
        u32x4 o; o.x = pk2(s[0 * 33], s[1 * 33]); o.y = pk2(s[2 * 33], s[3 * 33]); o.z = pk2(s[4 * 33], s[5 * 33]); o.w = pk2(s[6 * 33], s[7 * 33]);
        *(u32x4*)(WT + (size_t)(n0 + n) * K + k0 + 8 * c) = o; }
    LDS_WAIT();
}
__device__ __forceinline__ void p0_prologue(const Args& a, unsigned char* lds, int w0) {
    THREAD_IDS();
    unsigned char* ws = wsl(a.ws);
    float* scr = (float*)(lds + wave * 8448);
    const int gw = blockIdx.x * NWAVES + wave, NGW = gridDim.x * NWAVES;
    constexpr int I_IN = 16 * (NP / 32), I_SQ = 16 * 32;
    constexpr int NITEMS = 2 * I_IN + 8 * I_SQ;
    for (int it = gw; it < NITEMS; it += NGW) {
        int r = it;
        if (r < 2 * I_IN) { const int layer = r / I_IN; r -= layer * I_IN;
            transpose_item<true>(a.in[2] + (size_t)layer * 1024 * NIN, 1024, NIN, (bf16_t*)(ws + WS_WIN) + (size_t)layer * NP * 1024, scr, r / (NP / 32), r % (NP / 32), lane); continue; }
        r -= 2 * I_IN;
        if (r < 6 * I_SQ) { const int mi = r / I_SQ; r -= mi * I_SQ;
            transpose_item<false>(a.in[12] + (size_t)mi * 1024 * 1024, 1024, 1024, (bf16_t*)(ws + WS_WBR) + (size_t)mi * 1024 * 1024, scr, r / 32, r % 32, lane); continue; }
        r -= 6 * I_SQ;
        { const int mi = r / I_SQ; r -= mi * I_SQ;
            transpose_item<false>(a.in[13] + (size_t)mi * 1024 * 1024, 1024, 1024, (bf16_t*)(ws + WS_WOUT) + (size_t)mi * 1024 * 1024, scr, r / 32, r % 32, lane); }
    }
    for (int idx = blockIdx.x * NTHR + tid; idx < SEQ * 8; idx += gridDim.x * NTHR) {
        const int pos = idx >> 3, i = idx & 7;
        const float inv = powf(500000.0f, -(float)(2 * i) / 16.0f);
        const float ang = (float)pos * inv;
        ((f32x2*)(ws + WS_ROPE))[idx] = (f32x2){cosf(ang), sinf(ang)};
    }
    if (blockIdx.x == 0) {
        if (tid < 128) ((unsigned*)(ws + WS_CTR))[tid * 64] = 0u;
        if (tid >= 128 && tid < 192) { const int k = tid - 128, layer = k >> 5, c = k & 31;
            ((float*)(ws + WS_LAM))[16 + k] = (c < 16) ? a.in[3][layer * 16 + c] : a.in[6][layer * 16 + c - 16]; }
        if (tid >= 64 && tid < 66) { const int layer = tid - 64; const float* lp = a.in[10] + layer * 256;
            float s1 = 0.f, s2 = 0.f;
            for (int d = 0; d < 64; ++d) { s1 += lp[d] * lp[64 + d]; s2 += lp[128 + d] * lp[192 + d]; }
            const float li = 0.8f - 0.6f * expf(-0.3f * (float)layer);
            ((float*)(ws + WS_LAM))[layer * 2] = expf(s1) - expf(s2) + li; ((float*)(ws + WS_LAM))[layer * 2 + 1] = li; }
    }
}
template <bool TOBF> __device__ __forceinline__ void norm_rows(const float* X, const float* w, bf16_t* ob, float* of, int w0) {
    THREAD_IDS();
    const int gw = blockIdx.x * NWAVES + wave, NGW = gridDim.x * NWAVES;
    f32x4 wv[4];
#pragma unroll
    for (int j = 0; j < 4; ++j) wv[j] = ((const f32x4*)w)[64 * j + lane];
    for (int m = gw; m < MT; m += 2 * NGW) {
        const int m2 = m + NGW;
        const f32x4* xr = (const f32x4*)(X + (size_t)m * DM) + lane; const f32x4* xr2 = (const f32x4*)(X + (size_t)m2 * DM) + lane;
        f32x4 v[4], v2[4]; float s = 0.f, s2 = 0.f;
#pragma unroll
        for (int j = 0; j < 4; ++j) { v[j] = xr[64 * j]; v2[j] = xr2[64 * j]; }
#pragma unroll
        for (int j = 0; j < 4; ++j) { s += (v[j].x * v[j].x + v[j].y * v[j].y) + (v[j].z * v[j].z + v[j].w * v[j].w); s2 += (v2[j].x * v2[j].x + v2[j].y * v2[j].y) + (v2[j].z * v2[j].z + v2[j].w * v2[j].w); }
        const float rs = rsqrtf(wave_sum(s, lane) * (1.0f / DM) + EPS), rs2 = rsqrtf(wave_sum(s2, lane) * (1.0f / DM) + EPS);
#pragma unroll
        for (int j = 0; j < 4; ++j) { const f32x4 o = v[j] * rs * wv[j], o2 = v2[j] * rs2 * wv[j];
            if (TOBF) { u32x2 p; p.x = pk2(o.x, o.y); p.y = pk2(o.z, o.w); ((u32x2*)(ob + (size_t)m * DM))[64 * j + lane] = p;
                        u32x2 q; q.x = pk2(o2.x, o2.y); q.y = pk2(o2.z, o2.w); ((u32x2*)(ob + (size_t)m2 * DM))[64 * j + lane] = q; }
            else { ((f32x4*)(of + (size_t)m * DM))[64 * j + lane] = o; ((f32x4*)(of + (size_t)m2 * DM))[64 * j + lane] = o2; } }
    }
}

constexpr int SL_ACS = 0, SL_DT = 1024, SL_PART = 2048, SL_XT = 4096, SL_B = SL_XT + 256 * 144, SL_C = SL_B + 18432;
constexpr int XTP = 144, BNP = 272;

__device__ __forceinline__ void ssd_acs(unsigned char* lds, const float* small, size_t row0, int g, const float* a_log, int wave, int lane) {
    if (wave < 4) {
        const int h = 4 * g + wave;
        const float dt = small[(row0 + lane) * 32 + 16 + h];
        float v = -expf(a_log[h]) * dt;
#pragma unroll
        for (int o = 1; o < 64; o <<= 1) { const float t = lx_up(v, o, lane); if (lane >= o) v += t; }
        ((float*)(lds + SL_ACS))[wave * 64 + lane] = v;
        ((float*)(lds + SL_DT))[wave * 64 + lane] = dt;
    }
}
__device__ __forceinline__ void conv8x8(float (&out)[8][8], const bf16_t* xb, int pg, int c, const float* cw, const float* cb) {
    u32x4 raw[11];
#pragma unroll
    for (int i = 0; i < 11; ++i) { const int rr = pg * 8 - 3 + i;
        if (rr >= 0 || c > 0) raw[i] = *(const u32x4*)(xb + (ptrdiff_t)rr * LDP); else raw[i] = (u32x4){0u, 0u, 0u, 0u}; }
    float w[4][8], bias[8];
#pragma unroll
    for (int k = 0; k < 4; ++k) { const f32x4 a = *(const f32x4*)(cw + k * 2048), b = *(const f32x4*)(cw + k * 2048 + 4);
        w[k][0] = a.x; w[k][1] = a.y; w[k][2] = a.z; w[k][3] = a.w; w[k][4] = b.x; w[k][5] = b.y; w[k][6] = b.z; w[k][7] = b.w; }
    { const f32x4 a = *(const f32x4*)cb, b = *(const f32x4*)(cb + 4); bias[0] = a.x; bias[1] = a.y; bias[2] = a.z; bias[3] = a.w; bias[4] = b.x; bias[5] = b.y; bias[6] = b.z; bias[7] = b.w; }
#pragma unroll
    for (int p = 0; p < 8; ++p) {
#pragma unroll
        for (int ch = 0; ch < 8; ++ch) { float s = bias[ch];
#pragma unroll
            for (int k = 0; k < 4; ++k) { const unsigned wd = raw[p + k][ch >> 1]; const float u = (ch & 1) ? bfhi(wd) : bflo(wd); s += w[k][ch] * u; }
            out[p][ch] = pg8::silu_f(s); }
    }
}
__device__ __forceinline__ void put_T(unsigned char* img, int chrow0, int s0, const float (&v)[8][8]) {
#pragma unroll
    for (int ch = 0; ch < 8; ++ch) { u32x4 o; o.x = pk2(v[0][ch], v[1][ch]); o.y = pk2(v[2][ch], v[3][ch]); o.z = pk2(v[4][ch], v[5][ch]); o.w = pk2(v[6][ch], v[7][ch]);
        *(u32x4*)(img + (chrow0 + ch) * XTP + s0 * 2) = o; }
}
__device__ __forceinline__ void put_N(unsigned char* img, int n0, int s0, const float (&v)[8][8]) {
#pragma unroll
    for (int p = 0; p < 8; ++p) { u32x4 o; o.x = pk2(v[p][0], v[p][1]); o.y = pk2(v[p][2], v[p][3]); o.z = pk2(v[p][4], v[p][5]); o.w = pk2(v[p][6], v[p][7]);
        *(u32x4*)(img + (s0 + p) * BNP + n0 * 2) = o; }
}

__device__ __forceinline__ void ssd_states_unit(const Args& a, int layer, int u, unsigned char* lds, int w0) {
    THREAD_IDS();
    const int g = u & 3, c = (u >> 2) & 31, bl = u >> 7;
    unsigned char* ws = wsl(a.ws);
    const bf16_t* PROJ = (const bf16_t*)(ws + WS_PROJ);
    const size_t row0 = (size_t)bl * SEQ + c * 64;
    ssd_acs(lds, (const float*)(ws + WS_SMALL), row0, g, a.in[7] + layer * 16, wave, lane);
    __syncthreads();
    const float* ACS = (const float*)(lds + SL_ACS); const float* DTL = (const float*)(lds + SL_DT);
    const int cgi = tid & 63, pg = tid >> 6;
    if (cgi < 48) {
        const int chx = (cgi < 32) ? (g * 256 + cgi * 8) : (1024 + g * 128 + (cgi - 32) * 8);
        float v[8][8];
        conv8x8(v, PROJ + row0 * LDP + C_XBC + chx, pg, c, a.in[4] + (size_t)layer * 4 * 2048 + chx, a.in[5] + layer * 2048 + chx);
        if (cgi < 32) { const int hh = cgi >> 3; const float al = ACS[hh * 64 + 63];
#pragma unroll
            for (int p = 0; p < 8; ++p) { const int s = pg * 8 + p; const float sc = __expf(al - ACS[hh * 64 + s]) * DTL[hh * 64 + s];
#pragma unroll
                for (int ch = 0; ch < 8; ++ch) v[p][ch] *= sc; }
            put_T(lds + SL_XT, cgi * 8, pg * 8, v);
        } else put_T(lds + SL_B, (cgi - 32) * 8, pg * 8, v);
    }
    __syncthreads();
    const int fr = lane & 15, fq = lane >> 4, hh = wave >> 1, nh = wave & 1;
    f32x4 acc[4][4];
#pragma unroll
    for (int i = 0; i < 4; ++i)
#pragma unroll
        for (int j = 0; j < 4; ++j) acc[i][j] = (f32x4){0.f, 0.f, 0.f, 0.f};
    {   bf16x8 af[2][4], bf[2][4];
#pragma unroll
        for (int ks = 0; ks < 2; ++ks) {
#pragma unroll
            for (int i = 0; i < 4; ++i) af[ks][i] = *(const bf16x8*)(lds + SL_B + (64 * nh + 16 * i + fr) * XTP + (32 * ks + 8 * fq) * 2);
#pragma unroll
            for (int j = 0; j < 4; ++j) bf[ks][j] = *(const bf16x8*)(lds + SL_XT + (hh * 64 + 16 * j + fr) * XTP + (32 * ks + 8 * fq) * 2); }
        __builtin_amdgcn_sched_barrier(0);
#pragma unroll
        for (int ks = 0; ks < 2; ++ks)
#pragma unroll
            for (int i = 0; i < 4; ++i)
#pragma unroll
                for (int j = 0; j < 4; ++j) acc[i][j] = MFMA16(af[ks][i], bf[ks][j], acc[i][j]);
    }
    const int h = 4 * g + hh;
    bf16_t* ST = (bf16_t*)(ws + WS_ST) + ((size_t)(bl * 32 + c) * 16 + h) * 8192;
#pragma unroll
    for (int i = 0; i < 4; ++i)
#pragma unroll
        for (int j = 0; j < 4; ++j) { u32x2 w; w.x = pk2m(acc[i][j][0], acc[i][j][1]); w.y = pk2m(acc[i][j][2], acc[i][j][3]);
            *(u32x2*)(ST + (16 * j + fr) * 128 + 64 * nh + 16 * i + 4 * fq) = w; }
    if (tid < 4) ((float*)(ws + WS_CD))[(bl * 32 + c) * 16 + 4 * g + tid] = __expf(ACS[tid * 64 + 63]);
}

__device__ __forceinline__ void ssd_scan_unit(const Args& a, int u, int w0) {
    THREAD_IDS();
    const int qt = u & 3, h = (u >> 2) & 15, bl = u >> 6;
    const bf16_t* ST = (const bf16_t*)(wsl(a.ws) + WS_ST); bf16_t* PV = (bf16_t*)(wsl(a.ws) + WS_PREV); const float* CD = (const float*)(wsl(a.ws) + WS_CD);
    const int e = qt * 2048 + tid * 4;
    float z0 = 0.f; asm volatile("" : "+v"(z0));
    f32x4 hc = (f32x4){z0, z0, z0, z0};
#pragma unroll 1
    for (int c0 = 0; c0 < 32; c0 += 16) {
        u32x2 sv[16]; float dcv[16];
#pragma unroll
        for (int c = 0; c < 16; ++c) { sv[c] = *(const u32x2*)(ST + ((size_t)(bl * 32 + c0 + c) * 16 + h) * 8192 + e); dcv[c] = CD[(bl * 32 + c0 + c) * 16 + h]; }
#pragma unroll
        for (int c = 0; c < 16; ++c) { const float dec = dcv[c];
            u32x2 w; w.x = pk2(hc[0], hc[1]); w.y = pk2(hc[2], hc[3]);
            *(u32x2*)(PV + ((size_t)(bl * 32 + c0 + c) * 16 + h) * 8192 + e) = w;
            hc = hc * dec + (f32x4){bflo(sv[c].x), bfhi(sv[c].x), bflo(sv[c].y), bfhi(sv[c].y)}; }
    }
}

__device__ __forceinline__ void ssd_out_unit(const Args& a, int layer, int u, unsigned char* lds, int w0, bool dry = false) {
    THREAD_IDS();
    const int g = u & 3, c = (u >> 2) & 31, bl = u >> 7;
    unsigned char* ws = wsl(a.ws);
    bf16_t* PROJ = (bf16_t*)(ws + WS_PROJ);
    const size_t row0 = (size_t)bl * SEQ + c * 64;
    ssd_acs(lds, (const float*)(ws + WS_SMALL), row0, g, a.in[7] + layer * 16, wave, lane);
    const int cgi = tid & 63, pg = tid >> 6;
    {
        const int chx = (cgi < 32) ? (g * 256 + cgi * 8) : (cgi < 48) ? (1024 + g * 128 + (cgi - 32) * 8) : (1536 + g * 128 + (cgi - 48) * 8);
        float v[8][8];
        conv8x8(v, PROJ + row0 * LDP + C_XBC + chx, pg, c, a.in[4] + (size_t)layer * 4 * 2048 + chx, a.in[5] + layer * 2048 + chx);
        if (cgi < 32) put_T(lds + SL_XT, cgi * 8, pg * 8, v);
        else if (cgi < 48) put_N(lds + SL_B, (cgi - 32) * 8, pg * 8, v);
        else put_N(lds + SL_C, (cgi - 48) * 8, pg * 8, v);
    }
    const int fr = lane & 15, fq = lane >> 4, hh = wave >> 1, lh = wave & 1, h = 4 * g + hh;
    const bf16_t* PV = (const bf16_t*)(ws + WS_PREV) + ((size_t)(bl * 32 + c) * 16 + h) * 8192;
    u32x2 zws[2][4]; f32x4 nwv[4];
#pragma unroll
    for (int lt = 0; lt < 2; ++lt)
#pragma unroll
        for (int pt = 0; pt < 4; ++pt) zws[lt][pt] = *(const u32x2*)(PROJ + (row0 + 32 * lh + 16 * lt + fr) * LDP + C_SZ + h * 64 + 16 * pt + 4 * fq);
#pragma unroll
    for (int pt = 0; pt < 4; ++pt) nwv[pt] = *(const f32x4*)(a.in[9] + layer * 1024 + h * 64 + 16 * pt + 4 * fq);
    bf16x8 pa[4][4];
#pragma unroll
    for (int ks = 0; ks < 4; ++ks)
#pragma unroll
        for (int pt = 0; pt < 4; ++pt) pa[ks][pt] = *(const bf16x8*)(PV + (16 * pt + fr) * 128 + 32 * ks + 8 * fq);
    __syncthreads();
    const float* ACS = (const float*)(lds + SL_ACS); const float* DTL = (const float*)(lds + SL_DT);
    f32x4 acc[4][2], dd[4][2];
#pragma unroll
    for (int i = 0; i < 4; ++i)
#pragma unroll
        for (int j = 0; j < 2; ++j) { acc[i][j] = (f32x4){0.f, 0.f, 0.f, 0.f}; dd[i][j] = (f32x4){0.f, 0.f, 0.f, 0.f}; }
    bf16x8 cf[4][2];
#pragma unroll
    for (int ks = 0; ks < 4; ++ks)
#pragma unroll
        for (int lt = 0; lt < 2; ++lt) cf[ks][lt] = *(const bf16x8*)(lds + SL_C + (32 * lh + 16 * lt + fr) * BNP + (32 * ks + 8 * fq) * 2);
    __builtin_amdgcn_sched_barrier(0);
#pragma unroll
    for (int ks = 0; ks < 4; ++ks)
#pragma unroll
        for (int pt = 0; pt < 4; ++pt)
#pragma unroll
            for (int lt = 0; lt < 2; ++lt) acc[pt][lt] = MFMA16(pa[ks][pt], cf[ks][lt], acc[pt][lt]);
    __builtin_amdgcn_sched_barrier(0);
    {   bf16x8 bq[4][4];
#pragma unroll
        for (int ks = 0; ks < 4; ++ks)
#pragma unroll
            for (int st = 0; st < 4; ++st) if (st < 2 || lh) bq[ks][st] = *(const bf16x8*)(lds + SL_B + (16 * st + fr) * BNP + (32 * ks + 8 * fq) * 2);
        __builtin_amdgcn_sched_barrier(0);
#pragma unroll
        for (int ks = 0; ks < 4; ++ks)
#pragma unroll
            for (int st = 0; st < 4; ++st) if (st < 2 || lh) {
#pragma unroll
                for (int lt = 0; lt < 2; ++lt) dd[st][lt] = MFMA16(bq[ks][st], cf[ks][lt], dd[st][lt]); }
    }
    float acl[2];
#pragma unroll
    for (int lt = 0; lt < 2; ++lt) { acl[lt] = ACS[hh * 64 + 32 * lh + 16 * lt + fr]; const float e = __expf(acl[lt]);
#pragma unroll
        for (int pt = 0; pt < 4; ++pt) acc[pt][lt] *= e; }
#pragma unroll
    for (int st = 0; st < 4; ++st) if (st < 2 || lh) {
#pragma unroll
        for (int r = 0; r < 4; ++r) { const int s = 16 * st + 4 * fq + r; const float as = ACS[hh * 64 + s], ds = DTL[hh * 64 + s];
#pragma unroll
            for (int lt = 0; lt < 2; ++lt) { const int l = 32 * lh + 16 * lt + fr; dd[st][lt][r] = (s <= l) ? dd[st][lt][r] * __expf(acl[lt] - as) * ds : 0.f; } }
    }
#pragma unroll
    for (int kk = 0; kk < 2; ++kk) if (kk == 0 || lh) {
        bf16x8 mb[2];
#pragma unroll
        for (int lt = 0; lt < 2; ++lt) { u32x4 w; w.x = pk2(dd[2 * kk][lt][0], dd[2 * kk][lt][1]); w.y = pk2(dd[2 * kk][lt][2], dd[2 * kk][lt][3]);
            w.z = pk2(dd[2 * kk + 1][lt][0], dd[2 * kk + 1][lt][1]); w.w = pk2(dd[2 * kk + 1][lt][2], dd[2 * kk + 1][lt][3]); mb[lt] = __builtin_bit_cast(bf16x8, w); }
#pragma unroll
        for (int pt = 0; pt < 4; ++pt) { const unsigned char* xr = lds + SL_XT + (hh * 64 + 16 * pt + fr) * XTP + (32 * kk + 4 * fq) * 2;
            const u32x2 lo = *(const u32x2*)xr, hi2 = *(const u32x2*)(xr + 32);
            const bf16x8 af = __builtin_bit_cast(bf16x8, (u32x4){lo.x, lo.y, hi2.x, hi2.y});
#pragma unroll
            for (int lt = 0; lt < 2; ++lt) acc[pt][lt] = MFMA16(af, mb[lt], acc[pt][lt]); }
    }
    const float dsk = a.in[8][layer * 16 + h];
    float ss[2] = {0.f, 0.f};
#pragma unroll
    for (int lt = 0; lt < 2; ++lt) { const int l = 32 * lh + 16 * lt + fr;
#pragma unroll
        for (int pt = 0; pt < 4; ++pt) { const int p4 = 16 * pt + 4 * fq;
            const u32x2 zw = zws[lt][pt];
            const float zz[4] = {bflo(zw.x), bfhi(zw.x), bflo(zw.y), bfhi(zw.y)};
#pragma unroll
            for (int r = 0; r < 4; ++r) { const float xv = bf1(*(const bf16_t*)(lds + SL_XT + (hh * 64 + p4 + r) * XTP + l * 2));
                const float y = (acc[pt][lt][r] + xv * dsk) * zz[r]; acc[pt][lt][r] = y; ss[lt] += y * y; } } }
#pragma unroll
    for (int lt = 0; lt < 2; ++lt) { ss[lt] += lx_xor(ss[lt], 16, lane); ss[lt] += lx_xor(ss[lt], 32, lane);
        if (fq == 0) ((float*)(lds + SL_PART))[hh * 64 + 32 * lh + 16 * lt + fr] = ss[lt]; }
    __syncthreads();
    const float* nw = a.in[9] + layer * 1024 + h * 64;
#pragma unroll
    for (int lt = 0; lt < 2; ++lt) { const int l = 32 * lh + 16 * lt + fr; const float* pr = (const float*)(lds + SL_PART);
        const float tot = (pr[l] + pr[64 + l]) + (pr[128 + l] + pr[192 + l]);
        const float rs = rsqrtf(tot * (1.0f / 256.0f) + EPS);
#pragma unroll
        for (int pt = 0; pt < 4; ++pt) { const int p4 = 16 * pt + 4 * fq; const f32x4 wv = nwv[pt];
            u32x2 o; o.x = pk2(acc[pt][lt][0] * rs * wv.x, acc[pt][lt][1] * rs * wv.y); o.y = pk2(acc[pt][lt][2] * rs * wv.z, acc[pt][lt][3] * rs * wv.w);
            if (dry) *(u32x2*)((bf16_t*)(ws + WS_M16) + (row0 + l) * 1024 + h * 64 + p4) = o; else *(u32x2*)(PROJ + (row0 + l) * LDP + C_SZ + h * 64 + p4) = o; } }
}

__device__ __forceinline__ void fcum_unit(const Args& a, int fu, int w0) {
    THREAD_IDS();
    const int task = fu * 8 + wave, bl = task >> 4, h = task & 15;
    const float* sm = (const float*)(wsl(a.ws) + WS_SMALL) + ((size_t)bl * SEQ + lane * 32) * 32 + h;
    float v[32]; float run = 0.f;
#pragma unroll
    for (int i = 0; i < 32; ++i) { run += sm[i * 32]; v[i] = run; }
    float sc = run;
#pragma unroll
    for (int o = 1; o < 64; o <<= 1) { const float t = lx_up(sc, o, lane); if (lane >= o) sc += t; }
    const float off = sc - run;
    float* F = (float*)(wsl(a.ws) + WS_F2) + (size_t)task * SEQ + lane * 32;
#pragma unroll
    for (int i = 0; i < 32; i += 4) *(f32x4*)(F + i) = (f32x4){(off + v[i]) * LOG2E, (off + v[i + 1]) * LOG2E, (off + v[i + 2]) * LOG2E, (off + v[i + 3]) * LOG2E};
}
__device__ __forceinline__ void rope_unit(const Args& a, int ru, int w0) {
    THREAD_IDS();
    const int row = ru * 64 + (tid >> 3), j = tid & 7, pos = row & (SEQ - 1);
    bf16_t* PROJ = (bf16_t*)(wsl(a.ws) + WS_PROJ);
    const f32x2* cs = (const f32x2*)(wsl(a.ws) + WS_ROPE) + pos * 8;
    f32x2 t[8];
#pragma unroll
    for (int i = 0; i < 8; ++i) t[i] = cs[i];
#pragma unroll
    for (int k = 0; k < 4; ++k) { const int hc = 4 * j + k; const int col = (hc < 16) ? (C_DQ + hc * 64) : (C_DK + (hc - 16) * 64);
        u32x4* p = (u32x4*)(PROJ + (size_t)row * LDP + col);
        const u32x4 a1 = p[0], a2 = p[1]; u32x4 o1, o2;
#pragma unroll
        for (int w = 0; w < 4; ++w) {
            const float x1l = bflo(a1[w]), x1h = bfhi(a1[w]), x2l = bflo(a2[w]), x2h = bfhi(a2[w]);
            const f32x2 c0 = t[2 * w], c1 = t[2 * w + 1];
            o1[w] = pk2(x1l * c0.x - x2l * c0.y, x1h * c1.x - x2h * c1.y);
            o2[w] = pk2(x2l * c0.x + x1l * c0.y, x2h * c1.x + x1h * c1.y); }
        p[0] = o1; p[1] = o2; }
}

__device__ __forceinline__ v4i16_t vtr(const unsigned char* p) { return __builtin_amdgcn_ds_read_tr16_b64_v4i16((LAS v4i16_t*)(LAS unsigned char*)p); }
__device__ __forceinline__ float max3f(float a, float b, float c) { float r; asm("v_max3_f32 %0, %1, %2, %3" : "=v"(r) : "v"(a), "v"(b), "v"(c)); return r; }
template <int DV, bool FOX>
__device__ __forceinline__ void attn_pass(f32x16 (&o)[DV / 32], float& l_out, const bf16_t* Qw, const bf16_t* Kb, const bf16_t* Vb, const float* F2,
                                          int q0, unsigned char* lds, int w0) {
    THREAD_IDS(); const int wid = wave;
    constexpr int KP = 144, VP = DV * 2 + 64, OFF_K = 0, OFF_V = 64 * KP, OFF_F = OFF_V + 64 * VP, STAGE = OFF_F + 256, NV = DV / 64;
    const int r32 = lane & 31, hi = lane >> 5;
    const int NT = (q0 + 256) / 64, my_nt = (q0 + 32 * wid) / 64 + 1;
    bf16x8 qf[4];
#pragma unroll
    for (int d0 = 0; d0 < 4; ++d0) qf[d0] = *(const bf16x8*)(Qw + (size_t)r32 * LDP + d0 * 16 + hi * 8);
    float m = -INFINITY, l = 0.f;
#pragma unroll
    for (int i = 0; i < DV / 32; ++i)
#pragma unroll
        for (int r = 0; r < 16; ++r) o[i][r] = 0.f;
    u32x4 kreg, vreg[NV]; float freg = 0.f;
    const int krow = tid >> 3, kch = tid & 7;
#define ATT_LOAD(t) do { kreg = *(const u32x4*)(Kb + (size_t)(64 * (t) + krow) * LDP + kch * 8); \
        _Pragma("unroll") for (int i_ = 0; i_ < NV; ++i_) { const int idx_ = tid + 512 * i_; const int vr_ = (DV == 64) ? (idx_ >> 3) : (idx_ >> 4), vc_ = (DV == 64) ? (idx_ & 7) : (idx_ & 15); \
            vreg[i_] = *(const u32x4*)(Vb + (size_t)(64 * (t) + vr_) * LDP + vc_ * 8); } \
        if (FOX && tid < 64) freg = -F2[64 * (t) + tid]; } while (0)
#define ATT_STORE(sb_) do { *(u32x4*)((sb_) + OFF_K + krow * KP + kch * 16) = kreg; \
        _Pragma("unroll") for (int i_ = 0; i_ < NV; ++i_) { const int idx_ = tid + 512 * i_; const int vr_ = (DV == 64) ? (idx_ >> 3) : (idx_ >> 4), vc_ = (DV == 64) ? (idx_ & 7) : (idx_ & 15); \
            *(u32x4*)((sb_) + OFF_V + vr_ * VP + vc_ * 16) = vreg[i_]; } \
        if (FOX && tid < 64) ((float*)((sb_) + OFF_F))[tid] = freg; } while (0)
    __syncthreads();
    ATT_LOAD(0); ATT_STORE(lds);
    if (NT > 1) ATT_LOAD(1);
    __syncthreads();
    for (int t = 0; t < NT; ++t) {
        const unsigned char* sb = lds + (t & 1) * STAGE;
        if (t < my_nt) {
            bf16x8 kf[8];
#pragma unroll
            for (int d0 = 0; d0 < 4; ++d0) { kf[2 * d0] = *(const bf16x8*)(sb + OFF_K + r32 * KP + d0 * 32 + hi * 16);
                kf[2 * d0 + 1] = *(const bf16x8*)(sb + OFF_K + (32 + r32) * KP + d0 * 32 + hi * 16); }
            const unsigned char* vb = sb + OFF_V + (4 * hi + ((lane & 15) >> 2)) * VP + (16 * ((lane >> 4) & 1) + 4 * (lane & 3)) * 2;
            f32x4 fka[4], fkb[4];
            if (FOX) { const float* fk = (const float*)(sb + OFF_F);
#pragma unroll
                for (int g4 = 0; g4 < 4; ++g4) { fka[g4] = *(const f32x4*)(fk + 8 * g4 + 4 * hi); fkb[g4] = *(const f32x4*)(fk + 32 + 8 * g4 + 4 * hi); } }
            v4i16_t vs[2][DV / 32][2];
#pragma unroll
            for (int dvt = 0; dvt < DV / 32; ++dvt) { vs[0][dvt][0] = vtr(vb + dvt * 64); vs[0][dvt][1] = vtr(vb + 8 * VP + dvt * 64); }
            __builtin_amdgcn_sched_barrier(0);
            f32x16 p0, p1;
#pragma unroll
            for (int r = 0; r < 16; ++r) { p0[r] = 0.f; p1[r] = 0.f; }
#pragma unroll
            for (int d0 = 0; d0 < 4; ++d0) { p0 = MFMA32(kf[2 * d0], qf[d0], p0); p1 = MFMA32(kf[2 * d0 + 1], qf[d0], p1); }
            if (FOX) {
#pragma unroll
                for (int g4 = 0; g4 < 4; ++g4) { const f32x4 fa = fka[g4], fb = fkb[g4];
#pragma unroll
                    for (int i = 0; i < 4; ++i) { p0[4 * g4 + i] = p0[4 * g4 + i] * C2 + fa[i]; p1[4 * g4 + i] = p1[4 * g4 + i] * C2 + fb[i]; } }
                if (t == my_nt - 1) { const int qpos = q0 + 32 * wid + r32;
#pragma unroll
                    for (int r = 0; r < 16; ++r) { const int kp = 64 * t + crow(r, hi); if (kp > qpos) p0[r] = -INFINITY; if (kp + 32 > qpos) p1[r] = -INFINITY; } }
            } else {
                asm volatile("s_nop 15\n\ts_nop 7" : "+v"(p0), "+v"(p1));
            }
            float ma = max3f(p0[0], p0[1], p1[0]), mb = max3f(p0[2], p0[3], p1[1]);
            ma = max3f(ma, p1[2], p1[3]);
#pragma unroll
            for (int r = 4; r < 16; r += 4) { ma = max3f(ma, p0[r], p0[r + 1]); mb = max3f(mb, p0[r + 2], p0[r + 3]); ma = max3f(ma, p1[r], p1[r + 1]); mb = max3f(mb, p1[r + 2], p1[r + 3]); }
            float mx = max3f(ma, mb, ma);
            if (!FOX) mx *= C2;
            mx = max3f(mx, lx_xor(mx, 32, lane), mx);
            if (__any(mx > m)) {
                const float mn = max3f(m, mx, mx), alpha = __builtin_amdgcn_exp2f(m - mn);
                m = mn; l *= alpha;
#pragma unroll
                for (int i = 0; i < DV / 32; ++i)
#pragma unroll
                    for (int r = 0; r < 16; ++r) o[i][r] *= alpha;
            }
            float rsa = 0.f, rsb = 0.f;
#pragma unroll
            for (int r = 0; r < 16; r += 2) {
                f32x2 a = {p0[r], p0[r + 1]}, b = {p1[r], p1[r + 1]};
                if (FOX) { a = a - (f32x2){m, m}; b = b - (f32x2){m, m}; }
                else { a = a * (f32x2){C2, C2} - (f32x2){m, m}; b = b * (f32x2){C2, C2} - (f32x2){m, m}; }
                p0[r] = __builtin_amdgcn_exp2f(a.x); p0[r + 1] = __builtin_amdgcn_exp2f(a.y); p1[r] = __builtin_amdgcn_exp2f(b.x); p1[r + 1] = __builtin_amdgcn_exp2f(b.y);
                rsa += p0[r] + p0[r + 1]; rsb += p1[r] + p1[r + 1]; }
            l += rsa + rsb;
            bf16x8 pf[4];
            { u32x4 w;
              w.x = pk2(p0[0], p0[1]); w.y = pk2(p0[2], p0[3]); w.z = pk2(p0[4], p0[5]); w.w = pk2(p0[6], p0[7]); pf[0] = __builtin_bit_cast(bf16x8, w);
              w.x = pk2(p0[8], p0[9]); w.y = pk2(p0[10], p0[11]); w.z = pk2(p0[12], p0[13]); w.w = pk2(p0[14], p0[15]); pf[1] = __builtin_bit_cast(bf16x8, w);
              w.x = pk2(p1[0], p1[1]); w.y = pk2(p1[2], p1[3]); w.z = pk2(p1[4], p1[5]); w.w = pk2(p1[6], p1[7]); pf[2] = __builtin_bit_cast(bf16x8, w);
              w.x = pk2(p1[8], p1[9]); w.y = pk2(p1[10], p1[11]); w.z = pk2(p1[12], p1[13]); w.w = pk2(p1[14], p1[15]); pf[3] = __builtin_bit_cast(bf16x8, w); }
            __builtin_amdgcn_sched_barrier(0);
#pragma unroll
            for (int ks = 0; ks < 4; ++ks) {
                if (ks + 1 < 4) {
#pragma unroll
                    for (int dvt = 0; dvt < DV / 32; ++dvt) { vs[(ks + 1) & 1][dvt][0] = vtr(vb + 16 * (ks + 1) * VP + dvt * 64); vs[(ks + 1) & 1][dvt][1] = vtr(vb + (16 * (ks + 1) + 8) * VP + dvt * 64); }
                    __builtin_amdgcn_sched_barrier(0);
                }
#pragma unroll
                for (int dvt = 0; dvt < DV / 32; ++dvt) {
                    const v4i16_t lo = vs[ks & 1][dvt][0], h8 = vs[ks & 1][dvt][1];
                    const bf16x8 vf = (bf16x8){lo[0], lo[1], lo[2], lo[3], h8[0], h8[1], h8[2], h8[3]};
                    o[dvt] = MFMA32(vf, pf[ks], o[dvt]);
                }
                __builtin_amdgcn_sched_barrier(0);
            }
        }
        if (t + 1 < NT) { ATT_STORE(lds + ((t + 1) & 1) * STAGE); if (t + 2 < NT) ATT_LOAD(t + 2); }
        __syncthreads();
    }
#undef ATT_LOAD
#undef ATT_STORE
    l_out = l + lx_xor(l, 32, lane);
}

__device__ __forceinline__ void fox_unit(const Args& a, int bh, int qb, unsigned char* lds, int w0, bool dry = false) {
    THREAD_IDS(); const int wid = wave;
    const int bl = bh >> 4, h = bh & 15, q0 = qb * 256, r32 = lane & 31, hi = lane >> 5;
    bf16_t* PROJ = (bf16_t*)(wsl(a.ws) + WS_PROJ);
    const size_t rowb = (size_t)bl * SEQ;
    f32x16 o[2]; float l;
    bf16_t* orow = PROJ + (rowb + q0 + 32 * wid + r32) * LDP;
    u32x2 gws[8];
#pragma unroll
    for (int k = 0; k < 8; ++k) gws[k] = *(const u32x2*)(orow + C_FG + h * 64 + 32 * (k >> 2) + 8 * (k & 3) + 4 * hi);
    attn_pass<64, true>(o, l, PROJ + (rowb + q0 + 32 * wid) * LDP + C_FQ + h * 64, PROJ + rowb * LDP + C_FK + h * 64, PROJ + rowb * LDP + C_FV + h * 64,
                        (const float*)(wsl(a.ws) + WS_F2) + (size_t)bh * SEQ, q0, lds, w0);
    const float inv = 1.0f / l;
    bf16_t* owr = dry ? (bf16_t*)(wsl(a.ws) + WS_M16) + (rowb + q0 + 32 * wid + r32) * 1024 : orow + C_FQ;
#pragma unroll
    for (int dvt = 0; dvt < 2; ++dvt)
#pragma unroll
        for (int g4 = 0; g4 < 4; ++g4) { const int dv = 32 * dvt + 8 * g4 + 4 * hi;
            const u32x2 gw = gws[dvt * 4 + g4];
            u32x2 w; w.x = pk2(o[dvt][4 * g4] * inv * bflo(gw.x), o[dvt][4 * g4 + 1] * inv * bfhi(gw.x)); w.y = pk2(o[dvt][4 * g4 + 2] * inv * bflo(gw.y), o[dvt][4 * g4 + 3] * inv * bfhi(gw.y));
            *(u32x2*)(owr + h * 64 + dv) = w; }
}
__device__ __forceinline__ void diff_unit(const Args& a, int layer, int bh, int qb, unsigned char* lds, int w0, bool dry = false) {
    THREAD_IDS(); const int wid = wave;
    const int bl = bh >> 3, h = bh & 7, q0 = qb * 256, r32 = lane & 31, hi = lane >> 5;
    bf16_t* PROJ = (bf16_t*)(wsl(a.ws) + WS_PROJ);
    const size_t rowb = (size_t)bl * SEQ;
    const float lam = ((const float*)(wsl(a.ws) + WS_LAM))[layer * 2], lami = ((const float*)(wsl(a.ws) + WS_LAM))[layer * 2 + 1];
    f32x16 o1[4]; float l1, l2;
    float* scr = (float*)(wsl(a.ws) + WS_M32) + ((size_t)((bh * 8 + qb) * 8 + wid) * 64 + lane) * 64;
    attn_pass<128, false>(o1, l1, PROJ + (rowb + q0 + 32 * wid) * LDP + C_DQ + h * 128, PROJ + rowb * LDP + C_DK + h * 128, PROJ + rowb * LDP + C_DV + h * 128, nullptr, q0, lds, w0);
    { const float inv = 1.0f / l1;
#pragma unroll
      for (int i = 0; i < 4; ++i)
#pragma unroll
          for (int r = 0; r < 16; r += 4) *(f32x4*)(scr + i * 16 + r) = (f32x4){o1[i][r] * inv, o1[i][r + 1] * inv, o1[i][r + 2] * inv, o1[i][r + 3] * inv}; }
    attn_pass<128, false>(o1, l2, PROJ + (rowb + q0 + 32 * wid) * LDP + C_DQ + h * 128 + 64, PROJ + rowb * LDP + C_DK + h * 128 + 64, PROJ + rowb * LDP + C_DV + h * 128, nullptr, q0, lds, w0);
    const float sc2 = lam / l2; float ss = 0.f;
    {   f32x4 c1[16];
#pragma unroll
        for (int k = 0; k < 16; ++k) c1[k] = *(const f32x4*)(scr + 4 * k);
#pragma unroll
        for (int k = 0; k < 16; ++k)
#pragma unroll
            for (int e = 0; e < 4; ++e) { const int i = k >> 2, r = 4 * (k & 3) + e; const float v = c1[k][e] - sc2 * o1[i][r]; o1[i][r] = v; ss += v * v; }
    }
    ss += lx_xor(ss, 32, lane);
    const float rs = rsqrtf(ss * (1.0f / 128.0f) + EPS) * (1.0f - lami);
    bf16_t* orow = PROJ + (rowb + q0 + 32 * wid + r32) * LDP;
    const float* sw = a.in[11] + layer * 128;
    bf16_t* owr = dry ? (bf16_t*)(wsl(a.ws) + WS_M16) + (rowb + q0 + 32 * wid + r32) * 1024 : orow + C_DQ;
#pragma unroll
    for (int half = 0; half < 2; ++half) {
        u32x2 gwv[8]; f32x4 wvv[8];
#pragma unroll
        for (int k = 0; k < 8; ++k) { const int dvt = 2 * half + (k >> 2), g4 = k & 3, dv = 32 * dvt + 8 * g4 + 4 * hi;
            gwv[k] = *(const u32x2*)(orow + C_DG + h * 128 + dv); wvv[k] = *(const f32x4*)(sw + dv); }
#pragma unroll
        for (int k = 0; k < 8; ++k) { const int dvt = 2 * half + (k >> 2), g4 = k & 3, dv = 32 * dvt + 8 * g4 + 4 * hi;
            const u32x2 gw = gwv[k]; const f32x4 wv = wvv[k];
            u32x2 w; w.x = pk2(o1[dvt][4 * g4] * rs * wv.x * bflo(gw.x), o1[dvt][4 * g4 + 1] * rs * wv.y * bfhi(gw.x));
            w.y = pk2(o1[dvt][4 * g4 + 2] * rs * wv.z * bflo(gw.y), o1[dvt][4 * g4 + 3] * rs * wv.w * bfhi(gw.y));
            *(u32x2*)(owr + h * 128 + dv) = w; }
    }
}

#define XB_TMO      128
#define XB_XCNT(j)  (256  + 64 * (j))
#define XB_XSUB(j)  (1280 + 64 * (j))
#define XB_XGEN(j)  (2304 + 64 * (j))
#define XB_TOP      3328
#define XB_TOPGEN   3392
#define XCD_BAR_WORDS 3456
#define XB_SPIN_CAP (1u << 18)

__device__ __forceinline__ unsigned xb_ld(unsigned* p)              { return __hip_atomic_load(p, __ATOMIC_RELAXED, __HIP_MEMORY_SCOPE_AGENT); }
__device__ __forceinline__ unsigned xb_add(unsigned* p, unsigned v) { return __hip_atomic_fetch_add(p, v, __ATOMIC_RELAXED, __HIP_MEMORY_SCOPE_AGENT); }
__device__ __forceinline__ unsigned xb_xcc_id() { return (unsigned)__builtin_amdgcn_s_getreg((3 << 11) | 20) & 0xFu; }
#define XB_SPIN(cond, bar) do { unsigned _sp = 0; while (cond) { __builtin_amdgcn_s_sleep(1); \
    if ((++_sp & 255u) == 0u) { if (xb_ld(&(bar)[XB_TMO])) break; if (_sp > XB_SPIN_CAP) { atomicAdd(&(bar)[XB_TMO], 1u); break; } } } } while (0)

struct XcdBarrier {
    unsigned* bar; unsigned x;
    volatile LAS unsigned* st;
};

__device__ __forceinline__ XcdBarrier xcd_barrier_post(unsigned* bar, volatile LAS unsigned* st) {
    XcdBarrier b; b.bar = bar; b.x = xb_xcc_id(); b.st = st;
    if (threadIdx.x == 0) (void)xb_add(&bar[XB_XCNT(b.x)], 1u);
    return b;
}
__device__ __forceinline__ void xcd_barrier_complete(unsigned* bar, unsigned x, unsigned& nloc, unsigned& nx) {
    const unsigned G = gridDim.x * gridDim.y * gridDim.z;
    unsigned sum, cnt, mine, sp = 0u;
    for (;;) {
        sum = 0u; cnt = 0u; mine = 0u;
#pragma unroll
        for (unsigned j = 0; j < 16; ++j) { const unsigned c = xb_ld(&bar[XB_XCNT(j)]); sum += c; cnt += (c > 0u) ? 1u : 0u; mine = (j == x) ? c : mine; }
        if (sum == G) break;
        __builtin_amdgcn_s_sleep(1);
        if ((++sp & 255u) == 0u) { if (xb_ld(&bar[XB_TMO])) break; if (sp > XB_SPIN_CAP) { atomicAdd(&bar[XB_TMO], 1u); break; } }
    }
    nloc = mine > 0u ? mine : 1u; nx = cnt > 0u ? cnt : 1u;
}

__device__ __forceinline__ bool is_thread0(int w0) { int lane; asm volatile("v_mbcnt_lo_u32_b32 %0, -1, 0\n\tv_mbcnt_hi_u32_b32 %0, -1, %0" : "=v"(lane)); return w0 == 0 && lane == 0; }
__device__ __forceinline__ void xcd_barrier(const XcdBarrier& b, int w0) {
    asm volatile("s_waitcnt vmcnt(0)" ::: "memory");
    __syncthreads();
    if (is_thread0(w0)) {
        unsigned* bar = b.bar;
        __builtin_amdgcn_s_waitcnt(0);
        unsigned nloc = b.st[0], nx = b.st[1];
        if (nloc == 0u) { xcd_barrier_complete(bar, b.x, nloc, nx); b.st[0] = nloc; b.st[1] = nx; }
        const unsigned old = xb_add(&bar[XB_XSUB(b.x)], 1u);
        const unsigned gen = old / nloc;
        if (old + 1u == (gen + 1u) * nloc) {
            __builtin_amdgcn_fence(__ATOMIC_RELEASE, "agent");
            asm volatile("s_waitcnt vmcnt(0)" ::: "memory");
            const unsigned og = xb_add(&bar[XB_TOP], 1u);
            const unsigned tg = og / nx;
            if (og + 1u == (tg + 1u) * nx) xb_add(&bar[XB_TOPGEN], 1u);
            else XB_SPIN(xb_ld(&bar[XB_TOPGEN]) == tg, bar);
            __builtin_amdgcn_fence(__ATOMIC_ACQUIRE, "agent");
            xb_add(&bar[XB_XGEN(b.x)], 1u);
            asm volatile("s_waitcnt vmcnt(0)" ::: "memory");
        } else {
            XB_SPIN(xb_ld(&bar[XB_XGEN(b.x)]) == gen, bar);
            __builtin_amdgcn_fence(__ATOMIC_ACQUIRE, "agent");
            asm volatile("s_waitcnt vmcnt(0)" ::: "memory");
        }
    }
    __syncthreads();
}

__global__ void __launch_bounds__(NTHR, 2) hybrid_fwd(Args args) {
    extern __shared__ __attribute__((aligned(16))) unsigned char lds[];
    cg::grid_group grid = cg::this_grid();
    const int wave0 = __builtin_amdgcn_readfirstlane((int)threadIdx.x >> 6);
    Args A2;
#pragma unroll
    for (int i = 0; i < 15; ++i) A2.in[i] = (const float*)(GAS const float*)args.in[i];
    A2.out = (float*)(GAS float*)args.out; A2.ws = (unsigned char*)(GAS unsigned char*)args.ws;
#define args A2
#define ws (wsl(args.ws))
#define CTR ((unsigned*)(ws + WS_CTR))
    LAS unsigned char* ldsl = (LAS unsigned char*)lds;

#ifndef PHM
#define PHM 0xffff
#endif
    { volatile LAS unsigned* st0 = (volatile LAS unsigned*)(ldsl + LDS_MISC + 64); if (threadIdx.x < 2) st0[threadIdx.x] = 0u; }
    if (blockIdx.x == 0) { unsigned* bw = (unsigned*)(ws + WS_BAR); for (int i = threadIdx.x; i < XCD_BAR_WORDS; i += NTHR) bw[i] = 0u; }
    __syncthreads();
    p0_prologue(args, lds, wave0);
    grid.sync();
    const XcdBarrier xbar = xcd_barrier_post((unsigned*)(ws + WS_BAR), (volatile LAS unsigned*)(ldsl + LDS_MISC + 64));
#define GRID_SYNC() xcd_barrier(xbar, wave0)
#ifndef TMASK
#define TMASK 0
#endif
    unsigned long long t_acc = 0ull, t_0 = 0ull;
#define T_BEGIN(bit) do { if (TMASK & (bit)) t_0 = __builtin_amdgcn_s_memrealtime(); } while (0)
#define T_END(bit) do { if (TMASK & (bit)) t_acc += __builtin_amdgcn_s_memrealtime() - t_0; } while (0)
    for (int layer = 0; layer < 2; ++layer) {
        const float* xin = (layer == 0) ? args.in[0] : args.out;
        if (PHM & 2) norm_rows<true>(xin, args.in[1] + layer * 1024, (bf16_t*)(ws + WS_H), nullptr, wave0);
        GRID_SYNC();
        for (int g = 0; g < NGRP; ++g) {
            const int pass = layer * NGRP + g;
            T_BEGIN(1);
            if (PHM & 4) { pg8::Gemm gm{(const bf16_t*)(ws + WS_H) + (size_t)g * TG * 1024, (const bf16_t*)(ws + WS_WIN) + (size_t)layer * NP * 1024, TG, NP, 1024, 1024};
              pg8::StaticOrder S; S.init(TG, NP, (int)gridDim.x, lbx());
              pg8::EpiProj E{(bf16_t*)(ws + WS_PROJ), (float*)(ws + WS_SMALL), (const float*)(ws + WS_LAM) + 16 + layer * 32};
              pg8::gemm_phase<pg8::EpiProj, pg8::StaticOrder, true, true>(ldsl, gm, S, E, wave0); }
            if (g > 0 && lbx() >= 128) {
              pg8::Gemm gm{(const bf16_t*)(ws + WS_M16), (const bf16_t*)(ws + WS_WOUT) + (size_t)layer * 1024 * 1024, TG, 1024, 1024, 1024};
              pg8::StaticOrder S; S.init(TG, 1024, (int)gridDim.x, lbx() - 128);
              pg8::EpiRes E{xin + (size_t)(g - 1) * TG * 1024, args.out + (size_t)(g - 1) * TG * 1024};
              pg8::gemm_phase<pg8::EpiRes, pg8::StaticOrder, true, true>(ldsl, gm, S, E, wave0); }
            GRID_SYNC();
            T_END(1); T_BEGIN(2);
#ifndef EXPER
#define EXPER 0
#endif
            if (EXPER == 2) { pg8::Gemm gm{(const bf16_t*)(ws + WS_H) + (size_t)g * TG * 1024, (const bf16_t*)(ws + WS_WIN) + (size_t)layer * NP * 1024, TG, NP, 1024, 1024};
              pg8::StaticOrder S; S.init(TG, NP, (int)gridDim.x, lbx());
              pg8::EpiProj E{(bf16_t*)(ws + WS_PROJ), (float*)(ws + WS_SMALL), (const float*)(ws + WS_LAM) + 16 + layer * 32};
              pg8::gemm_phase<pg8::EpiProj, pg8::StaticOrder, true, true>(ldsl, gm, S, E, wave0); GRID_SYNC(); }
            if (EXPER == 5) { for (int q = 0; q < 10; ++q) GRID_SYNC(); }
            UNIT_LOOP(CTR + (pass * 3 + 0) * 64, 648,
                  if (u < 8) fcum_unit(args, u, wave0);
                  else if (u < 136) rope_unit(args, u - 8, wave0);
                  else ssd_states_unit(args, layer, u - 136, lds, wave0););
            GRID_SYNC();
            T_END(2); T_BEGIN(4);
            UNIT_LOOP(CTR + (pass * 3 + 1) * 64, 1024,
                  if (u < 256) diff_unit(args, layer, u & 31, 7 - (u >> 5), lds, wave0);
                  else if (u < 512) ssd_scan_unit(args, u - 256, wave0);
                  else { const int j = u - 512; fox_unit(args, j & 63, 7 - (j >> 6), lds, wave0); });
            GRID_SYNC();
            T_END(4); T_BEGIN(8);
            { const int n = (lbx() < 128) ? 0 : 2;
              const int ycol = (n == 0) ? C_FQ : C_DQ;
              pg8::Gemm gm{(const bf16_t*)(ws + WS_PROJ) + ycol, (const bf16_t*)(ws + WS_WBR) + (size_t)(layer * 3 + n) * 1024 * 1024, TG, 1024, 1024, LDP};
              pg8::StaticOrder S; S.init(TG, 1024, (int)gridDim.x, lbx() & 127);
              pg8::EpiGate E{(const bf16_t*)(ws + WS_PROJ) + C_MG + n * 1024, (float*)(ws + WS_M32), (bf16_t*)(ws + WS_M16), n};
              pg8::gemm_phase<pg8::EpiGate, pg8::StaticOrder, true, true>(ldsl, gm, S, E, wave0); }
            UNIT_LOOP(CTR + (pass * 3 + 2) * 64, 512, ssd_out_unit(args, layer, u, lds, wave0););
            GRID_SYNC();
            T_END(8); T_BEGIN(16);
            { pg8::Gemm gm{(const bf16_t*)(ws + WS_PROJ) + C_SZ, (const bf16_t*)(ws + WS_WBR) + (size_t)(layer * 3 + 1) * 1024 * 1024, TG, 1024, 1024, LDP};
              pg8::StaticOrder S; S.init(TG, 1024, (int)gridDim.x, lbx());
              pg8::EpiGate E{(const bf16_t*)(ws + WS_PROJ) + C_MG + 1024, (float*)(ws + WS_M32), (bf16_t*)(ws + WS_M16), 1};
              pg8::gemm_phase<pg8::EpiGate, pg8::StaticOrder, true, true>(ldsl, gm, S, E, wave0); }
            GRID_SYNC();
            T_END(16);
        }
        { pg8::Gemm gm{(const bf16_t*)(ws + WS_M16), (const bf16_t*)(ws + WS_WOUT) + (size_t)layer * 1024 * 1024, TG, 1024, 1024, 1024};
          pg8::StaticOrder S; S.init(TG, 1024, (int)gridDim.x, lbx());
          pg8::EpiRes E{xin + (size_t)(NGRP - 1) * TG * 1024, args.out + (size_t)(NGRP - 1) * TG * 1024};
          pg8::gemm_phase<pg8::EpiRes, pg8::StaticOrder, true, true>(ldsl, gm, S, E, wave0); }
        if (TMASK && layer == 1 && blockIdx.x == 0) { const unsigned long long ts = __builtin_amdgcn_s_memrealtime(); while (__builtin_amdgcn_s_memrealtime() - ts < 4ull * t_acc) __builtin_amdgcn_s_sleep(32); }
        GRID_SYNC();
    }
#undef ws
#undef CTR
    if (PHM & 4096) norm_rows<false>(args.out, args.in[14], nullptr, args.out, wave0);
}

#undef args
extern "C" void kernel_launch(void* const* d_in, const int* in_sizes, int n_in, void* d_out, int out_size, void* d_ws, size_t ws_size, hipStream_t stream) {
    static int grid = 0;
    if (grid == 0) {
        if (n_in != 15 || out_size != MT * DM || ws_size < WS_END) { fprintf(stderr, "kernel_launch: unexpected shapes (n_in %d out %d ws %zu need %zu)\n", n_in, out_size, ws_size, (size_t)WS_END); grid = -1; return; }
        int dev = 0, cus = 0, per_cu = 0;
        hipGetDevice(&dev); hipDeviceGetAttribute(&cus, hipDeviceAttributeMultiprocessorCount, dev);
        if (hipFuncSetAttribute((const void*)hybrid_fwd, hipFuncAttributeMaxDynamicSharedMemorySize, LDS_BYTES) != hipSuccess) { fprintf(stderr, "kernel_launch: hipFuncSetAttribute failed\n"); grid = -1; return; }
        if (hipOccupancyMaxActiveBlocksPerMultiprocessor(&per_cu, (const void*)hybrid_fwd, NTHR, LDS_BYTES) != hipSuccess || per_cu < 1) { fprintf(stderr, "kernel_launch: occupancy query gave %d\n", per_cu); per_cu = 1; }
        (void)hipGetLastError();
        grid = cus * 1;
    }
    if (grid < 0) return;
    Args a{};
    for (int i = 0; i < 15; ++i) a.in[i] = (const float*)d_in[i];
    a.out = (float*)d_out; a.ws = (unsigned char*)d_ws;
    void* kargs[] = {&a};
    hipError_t e = hipLaunchCooperativeKernel((const void*)hybrid_fwd, dim3(grid), dim3(NTHR), kargs, LDS_BYTES, stream);
    if (e != hipSuccess) fprintf(stderr, "kernel_launch: cooperative launch failed: %s (grid %d)\n", hipGetErrorString(e), grid);
}
```

```cpp
#include <hip/hip_runtime.h>
#include <hip/hip_cooperative_groups.h>
#include <cstdio>
#include <cstdint>
#include <cstddef>
#include <cmath>
namespace cg = cooperative_groups;
namespace pg8 {
#define PG8_LAS __attribute__((address_space(3)))
typedef unsigned short bf16_t;
typedef short bf16x8 __attribute__((ext_vector_type(8)));
typedef float f32x4 __attribute__((ext_vector_type(4)));
typedef unsigned u32x4 __attribute__((ext_vector_type(4)));
constexpr int BM = 256, BK = 64, HALF = 128, HTB = HALF * BK * 2  , STAGE_BYTES = 8 * HTB, NXCD = 8, WGM = 8;

__host__ __device__ __forceinline__ int lds_byte(int r, int c) { const int st = (r >> 4) * 2 + (c >> 5), rr = r & 15, cc = c & 31, ob = rr * 64 + cc * 2; return st * 1024 + (ob ^ (((ob >> 9) & 1) << 5)); }
__host__ __device__ __forceinline__ void stage_rc(int b, int& R, int& C) { const int st = b / 1024, sb = b % 1024, swz = sb ^ (((sb >> 9) & 1) << 5); R = (st >> 1) * 16 + swz / 64; C = (st & 1) * 32 + (swz % 64) / 2; }
__host__ __device__ __forceinline__ int perm32(int rho) { const int n = rho >> 4, i = rho & 15; return 8 * (i >> 2) + 4 * n + (i & 3); }

struct Unit { int pm, pn; };
struct Gemm { const bf16_t* A; const bf16_t* Bt; int M, N, K, lda; };

struct StaticOrder {
    int nM, nN, nwg, G, c;
    __host__ __device__ void init(int M, int N, int G_, int c_) { nM = M / BM; nN = N / BM; nwg = nM * nN; G = G_; c = c_; }
    __host__ __device__ bool next(int i, Unit& u) const {
        const long L = (long)i * G + c; if (L >= nwg) return false;
        int wgid = (int)L; { const int q = nwg / NXCD, r = nwg % NXCD, xcd = wgid % NXCD, off = wgid / NXCD; wgid = (xcd < r ? xcd * (q + 1) : r * (q + 1) + (xcd - r) * q) + off; }
        const int nig = WGM * nN, gid = wgid / nig, fm = gid * WGM, gsz = (nM - fm) < WGM ? (nM - fm) : WGM;
        u.pm = fm + ((wgid % nig) % gsz); u.pn = (wgid % nig) / gsz; return true;
    }
    __device__ __forceinline__ void a_ready(const Unit&) const {}
    __device__ __forceinline__ void done(const Unit&) const {}
};

__device__ __forceinline__ unsigned cvt_pk_bf16(float lo, float hi) { unsigned r; asm volatile("v_cvt_pk_bf16_f32 %0, %1, %2" : "=v"(r) : "v"(lo), "v"(hi)); return r; }

typedef unsigned u32x2 __attribute__((ext_vector_type(2)));
constexpr int LDP = 14336;
__device__ __forceinline__ float silu_f(float v) { return v * __builtin_amdgcn_rcpf(1.0f + __expf(-v)); }
__device__ __forceinline__ float sigm_f(float v) { return __builtin_amdgcn_rcpf(1.0f + __expf(-v)); }
__device__ __forceinline__ float bflo(unsigned w) { return __uint_as_float(w << 16); }
__device__ __forceinline__ float bfhi(unsigned w) { return __uint_as_float(w & 0xffff0000u); }

struct EpiProj {
    static constexpr bool PERM = true, AFTER_DRAIN = false;
    bf16_t* P; float* small; const float* sbias;
    __device__ __forceinline__ void operator()(const f32x4 (&acc)[2][2][4][2], const Unit& u, int wr, int wc, int fr, int fq) const {
        asm volatile("" : "+v"(fr));
        const int row0 = u.pm * BM + wr * 64 + fr;
        if (u.pn < 56) {
            const int pn = u.pn;
            const int mode = (pn < 12) ? 0 : (pn < 20) ? 1 : (pn < 40) ? 0 : (pn < 44) ? 1 : 2;
            const int col0 = pn * BM + wc * 32 + 8 * fq;
#pragma unroll
            for (int ai = 0; ai < 2; ++ai)
#pragma unroll
                for (int m = 0; m < 4; ++m) { bf16_t* rowp = P + (size_t)(row0 + ai * HALF + m * 16) * LDP + col0;
#pragma unroll
                    for (int bj = 0; bj < 2; ++bj) { f32x4 v0 = acc[ai][bj][m][0], v1 = acc[ai][bj][m][1];
                        if (mode == 1) {
#pragma unroll
                            for (int i = 0; i < 4; ++i) { v0[i] = silu_f(v0[i]); v1[i] = silu_f(v1[i]); } }
                        else if (mode == 2) {
#pragma unroll
                            for (int i = 0; i < 4; ++i) { v0[i] = sigm_f(v0[i]); v1[i] = sigm_f(v1[i]); } }
                        u32x4 w; w.x = cvt_pk_bf16(v0[0], v0[1]); w.y = cvt_pk_bf16(v0[2], v0[3]); w.z = cvt_pk_bf16(v1[0], v1[1]); w.w = cvt_pk_bf16(v1[2], v1[3]);
                        *(u32x4*)(rowp + bj * HALF) = w; } }
        } else if (wc == 0) {
            const float* sbp = sbias; asm volatile("" : "+s"(sbp));
            f32x4 bb[2]; bb[0] = *(const f32x4*)(sbp + 8 * fq); bb[1] = *(const f32x4*)(sbp + 8 * fq + 4);
#pragma unroll
            for (int ai = 0; ai < 2; ++ai)
#pragma unroll
                for (int m = 0; m < 4; ++m) { const int row = row0 + ai * HALF + m * 16;
#pragma unroll
                    for (int n = 0; n < 2; ++n) { f32x4 o;
#pragma unroll
                        for (int i = 0; i < 4; ++i) { const int c = 8 * fq + 4 * n + i; const float v = acc[ai][0][m][n][i];
                            const float xx = v + bb[n][i];
                            const float sp = __logf(1.0f + __expf(-fabsf(xx)));
                            o[i] = (c < 16) ? (fminf(xx, 0.f) - sp) : (fmaxf(xx, 0.f) + sp); }
                        *(f32x4*)(small + (size_t)row * 32 + 8 * fq + 4 * n) = o; } }
        }
    }
};
struct EpiGate {
    static constexpr bool PERM = false, AFTER_DRAIN = false;
    const bf16_t* gate; float* m32; bf16_t* m16; int nidx;
    __device__ __forceinline__ void operator()(const f32x4 (&acc)[2][2][4][2], const Unit& u, int wr, int wc, int fr, int fq) const {
        asm volatile("" : "+v"(fr));
        const int row0 = u.pm * BM + wr * 64 + fr, col0 = u.pn * BM + wc * 32 + 4 * fq;
        u32x2 gw[2][4]; f32x4 mv[2][4]; u32x2 hv[2][4];
#define EG_LOAD(c_, s_) do { const int row_ = row0 + ((c_) >> 2) * HALF + ((c_) & 3) * 16; \
        _Pragma("unroll") for (int e_ = 0; e_ < 4; ++e_) { const int col_ = col0 + (e_ >> 1) * HALF + (e_ & 1) * 16; \
            gw[s_][e_] = *(const u32x2*)(gate + (size_t)row_ * LDP + col_); \
            if (nidx == 1) { mv[s_][e_] = *(const f32x4*)(m32 + (size_t)row_ * 1024 + col_); hv[s_][e_] = *(const u32x2*)(m16 + (size_t)row_ * 1024 + col_); } } } while (0)
        EG_LOAD(0, 0);
#pragma unroll
        for (int c = 0; c < 8; ++c) {
            if (c + 1 < 8) EG_LOAD(c + 1, (c + 1) & 1);
            const int ai = c >> 2, m = c & 3, row = row0 + ai * HALF + m * 16;
#pragma unroll
            for (int e = 0; e < 4; ++e) { const int bj = e >> 1, n = e & 1, col = col0 + bj * HALF + n * 16;
                const u32x2 g2 = gw[c & 1][e];
                f32x4 v = acc[ai][bj][m][n];
                v[0] *= bflo(g2.x); v[1] *= bfhi(g2.x); v[2] *= bflo(g2.y); v[3] *= bfhi(g2.y);
                if (nidx == 0) *(f32x4*)(m32 + (size_t)row * 1024 + col) = v;
                else { if (nidx == 1) { const u32x2 t2 = hv[c & 1][e]; v += mv[c & 1][e]; v[0] += bflo(t2.x); v[1] += bfhi(t2.x); v[2] += bflo(t2.y); v[3] += bfhi(t2.y); }
                    u32x2 w; w.x = cvt_pk_bf16(v[0], v[1]); w.y = cvt_pk_bf16(v[2], v[3]); *(u32x2*)(m16 + (size_t)row * 1024 + col) = w; } }
        }
#undef EG_LOAD
    }
};
struct EpiRes {
    static constexpr bool PERM = false, AFTER_DRAIN = false;
    const float* xin; float* out;
    __device__ __forceinline__ void operator()(const f32x4 (&acc)[2][2][4][2], const Unit& u, int wr, int wc, int fr, int fq) const {
        asm volatile("" : "+v"(fr));
        const int row0 = u.pm * BM + wr * 64 + fr, col0 = u.pn * BM + wc * 32 + 4 * fq;
        f32x4 bx[2][4];
#define ER_LOAD(c_, s_) do { const size_t off_ = (size_t)(row0 + ((c_) >> 2) * HALF + ((c_) & 3) * 16) * 1024 + col0; \
        _Pragma("unroll") for (int e_ = 0; e_ < 4; ++e_) bx[s_][e_] = *(const f32x4*)(xin + off_ + (e_ >> 1) * HALF + (e_ & 1) * 16); } while (0)
        ER_LOAD(0, 0);
#pragma unroll
        for (int c = 0; c < 8; ++c) {
            if (c + 1 < 8) ER_LOAD(c + 1, (c + 1) & 1);
            const int ai = c >> 2, m = c & 3; const size_t off = (size_t)(row0 + ai * HALF + m * 16) * 1024 + col0;
#pragma unroll
            for (int e = 0; e < 4; ++e) { const int bj = e >> 1, n = e & 1; *(f32x4*)(out + off + bj * HALF + n * 16) = bx[c & 1][e] + acc[ai][bj][m][n]; }
        }
#undef ER_LOAD
    }
};
template <class Epi, class Sched, bool ALIGN_EPI = false, bool SP2 = false>
__device__ __forceinline__ void gemm_phase(PG8_LAS unsigned char* lds, const Gemm g, const Sched& S, const Epi& E, int w0) {
    int lane_; asm volatile("v_mbcnt_lo_u32_b32 %0, -1, 0\n\tv_mbcnt_hi_u32_b32 %0, -1, %0" : "=v"(lane_)); int wid = w0; asm volatile("" : "+s"(wid)); const int tid = wid * 64 + lane_, lane = tid & 63, wr = wid >> 2, wc = wid & 3, fr = lane & 15, fq = lane >> 4;
    const int K = g.K, nt = K / BK;
    unsigned voffA[2], voffB[2];
#pragma unroll
    for (int i = 0; i < 2; ++i) { int R, C; stage_rc(tid * 16 + i * 8192, R, C); const int Rb = Epi::PERM ? ((R & ~31) + perm32(R & 31)) : R;
        voffA[i] = (unsigned)(R * g.lda + C) * 2u; voffB[i] = (unsigned)(Rb * K + C) * 2u; }
    const size_t kstep = (size_t)(BK * 2);
    const size_t hstepA = (size_t)HALF * g.lda * 2, hstepB = (size_t)HALF * K * 2;
    const size_t tstepA = 2 * hstepA, tstepB = 2 * hstepB;
    const unsigned ldsw = (unsigned)wid * 1024u;
    const int aoff = lds_byte(wr * 64 + fr, fq * 8), boff = lds_byte(wc * 32 + fr, fq * 8);
#define PG8_SA(b, h) (((b) * 2 + (h)) * HTB)
#define PG8_SB(b, h) ((4 + (b) * 2 + (h)) * HTB)
#define PG8_STAGE(bufoff, gbase, voff) do { _Pragma("unroll") for (int _i = 0; _i < 2; ++_i) \
        __builtin_amdgcn_global_load_lds((const unsigned*)((const char*)(gbase) + (voff)[_i]), (PG8_LAS unsigned*)(lds + (bufoff) + ldsw + _i * 8192), 16, 0, 0); } while (0)
#define PG8_LDA(dst, b, h) do { _Pragma("unroll") for (int m = 0; m < 4; ++m) _Pragma("unroll") for (int k = 0; k < 2; ++k) dst[m][k] = *(const PG8_LAS bf16x8*)(lds + PG8_SA(b, h) + aoff + m * 2048 + k * 1024); } while (0)
#define PG8_LDB(dst, b, h) do { _Pragma("unroll") for (int n = 0; n < 2; ++n) _Pragma("unroll") for (int k = 0; k < 2; ++k) dst[n][k] = *(const PG8_LAS bf16x8*)(lds + PG8_SB(b, h) + boff + n * 2048 + k * 1024); } while (0)
#define PG8_MMA(ai, bj, At, Bt) do { __builtin_amdgcn_s_setprio(1); _Pragma("unroll") for (int m = 0; m < 4; ++m) _Pragma("unroll") for (int n = 0; n < 2; ++n) _Pragma("unroll") for (int k = 0; k < 2; ++k) \
        acc[ai][bj][m][n] = __builtin_amdgcn_mfma_f32_16x16x32_bf16(Bt[n][k], At[m][k], acc[ai][bj][m][n], 0, 0, 0); __builtin_amdgcn_s_setprio(0); } while (0)
#define PG8_WAIT_V(n) asm volatile("s_waitcnt vmcnt(" #n ")" ::: "memory")
#define PG8_WAIT_L(n) asm volatile("s_waitcnt lgkmcnt(" #n ")" ::: "memory")
#define PG8_BAR __builtin_amdgcn_s_barrier()
#define PG8_SCHED __builtin_amdgcn_sched_barrier(0)
    Unit cur, nxt; int ui = 0;
    if (!S.next(0, cur)) return;
    f32x4 acc[2][2][4][2];
#pragma unroll
    for (int a = 0; a < 2; ++a)
#pragma unroll
        for (int b = 0; b < 2; ++b)
#pragma unroll
            for (int m = 0; m < 4; ++m)
#pragma unroll
                for (int n = 0; n < 2; ++n) acc[a][b][m][n] = (f32x4){0.f, 0.f, 0.f, 0.f};
    bf16x8 At[4][2], B0[2][2], B1[2][2];
    const char* cA = (const char*)g.A + (size_t)cur.pm * tstepA; const char* cB = (const char*)g.Bt + (size_t)cur.pn * tstepB;
    S.a_ready(cur);
    if constexpr (SP2) {
        PG8_STAGE(PG8_SB(0, 0), cB, voffB); PG8_STAGE(PG8_SB(0, 1), cB + hstepB, voffB); PG8_STAGE(PG8_SA(0, 0), cA, voffA); PG8_STAGE(PG8_SA(0, 1), cA + hstepA, voffA);
        if (wr == 1) PG8_BAR;
        PG8_WAIT_V(2); PG8_BAR;
        PG8_STAGE(PG8_SB(1, 0), cB + kstep, voffB); PG8_STAGE(PG8_SA(1, 0), cA + kstep, voffA); PG8_STAGE(PG8_SB(1, 1), cB + hstepB + kstep, voffB);
        PG8_WAIT_V(6); PG8_BAR;
    } else {
        PG8_STAGE(PG8_SB(0, 0), cB, voffB); PG8_STAGE(PG8_SA(0, 0), cA, voffA); PG8_STAGE(PG8_SB(0, 1), cB + hstepB, voffB); PG8_STAGE(PG8_SA(0, 1), cA + hstepA, voffA);
        if (wr == 1) PG8_BAR;
        PG8_WAIT_V(4); PG8_BAR;
        PG8_STAGE(PG8_SB(1, 0), cB + kstep, voffB); PG8_STAGE(PG8_SA(1, 0), cA + kstep, voffA); PG8_STAGE(PG8_SB(1, 1), cB + hstepB + kstep, voffB);
        PG8_WAIT_V(6); PG8_BAR;
    }
    for (;;) {
        const bool has_next = S.next(ui + 1, nxt);
        const char* nA = has_next ? (const char*)g.A + (size_t)nxt.pm * tstepA : cA; const char* nB = has_next ? (const char*)g.Bt + (size_t)nxt.pn * tstepB : cB;
        for (int t = 0; t < nt; t += 2) {
            const bool last = (t == nt - 2);
            const char* a1 = cA + (size_t)(t + 1) * kstep;
            const char* a2 = last ? nA : cA + (size_t)(t + 2) * kstep; const char* b2 = last ? nB : cB + (size_t)(t + 2) * kstep;
            const char* a3 = a2 + kstep; const char* b3 = b2 + kstep;
            if (last && has_next) S.a_ready(nxt);
            if constexpr (SP2) {
            PG8_LDB(B0, 0, 0); PG8_LDB(B1, 0, 1); PG8_SCHED; PG8_LDA(At, 0, 0); PG8_STAGE(PG8_SA(1, 1), a1 + hstepA, voffA);
            PG8_WAIT_V(8); PG8_WAIT_L(0); PG8_BAR; PG8_MMA(0, 0, At, B0); PG8_MMA(0, 1, At, B1); PG8_BAR; PG8_SCHED;
            PG8_LDA(At, 0, 1); PG8_STAGE(PG8_SB(0, 0), b2, voffB); PG8_STAGE(PG8_SB(0, 1), b2 + hstepB, voffB); PG8_STAGE(PG8_SA(0, 0), a2, voffA);
            PG8_WAIT_V(8); PG8_WAIT_L(0); PG8_BAR; PG8_MMA(1, 0, At, B0); PG8_MMA(1, 1, At, B1); PG8_BAR; PG8_SCHED;
            PG8_LDB(B0, 1, 0); PG8_LDB(B1, 1, 1); PG8_SCHED; PG8_LDA(At, 1, 0); PG8_STAGE(PG8_SA(0, 1), a2 + hstepA, voffA);
            PG8_WAIT_V(8); PG8_WAIT_L(0); PG8_BAR; PG8_MMA(0, 0, At, B0); PG8_MMA(0, 1, At, B1); PG8_BAR; PG8_SCHED;
            PG8_LDA(At, 1, 1); PG8_STAGE(PG8_SB(1, 0), b3, voffB); PG8_STAGE(PG8_SB(1, 1), b3 + hstepB, voffB); PG8_STAGE(PG8_SA(1, 0), a3, voffA);
            PG8_WAIT_V(8); PG8_WAIT_L(0); PG8_BAR; PG8_MMA(1, 0, At, B0); PG8_MMA(1, 1, At, B1); PG8_BAR; PG8_SCHED;
            } else {
            PG8_LDB(B0, 0, 0); PG8_SCHED; PG8_LDA(At, 0, 0); PG8_STAGE(PG8_SA(1, 1), a1 + hstepA, voffA);
            PG8_WAIT_L(8); PG8_BAR; PG8_WAIT_L(0); PG8_MMA(0, 0, At, B0); PG8_BAR; PG8_SCHED;
            PG8_LDB(B1, 0, 1); PG8_STAGE(PG8_SB(0, 0), b2, voffB);
            PG8_BAR; PG8_WAIT_L(0); PG8_MMA(0, 1, At, B1); PG8_BAR;
            PG8_LDA(At, 0, 1); PG8_STAGE(PG8_SA(0, 0), a2, voffA);
            PG8_BAR; PG8_WAIT_L(0); PG8_MMA(1, 0, At, B0); PG8_BAR; PG8_SCHED;
            PG8_STAGE(PG8_SB(0, 1), b2 + hstepB, voffB);
            PG8_WAIT_V(6); PG8_BAR; PG8_MMA(1, 1, At, B1); PG8_BAR;
            PG8_LDB(B0, 1, 0); PG8_SCHED; PG8_LDA(At, 1, 0); PG8_STAGE(PG8_SA(0, 1), a2 + hstepA, voffA);
            PG8_WAIT_L(8); PG8_BAR; PG8_WAIT_L(0); PG8_MMA(0, 0, At, B0); PG8_BAR; PG8_SCHED;
            PG8_LDB(B1, 1, 1); PG8_STAGE(PG8_SB(1, 0), b3, voffB);
            PG8_BAR; PG8_WAIT_L(0); PG8_MMA(0, 1, At, B1); PG8_BAR;
            PG8_LDA(At, 1, 1); PG8_STAGE(PG8_SA(1, 0), a3, voffA);
            PG8_BAR; PG8_WAIT_L(0); PG8_MMA(1, 0, At, B0); PG8_BAR; PG8_SCHED;
            PG8_STAGE(PG8_SB(1, 1), b3 + hstepB, voffB);
            PG8_WAIT_V(6); PG8_BAR; PG8_MMA(1, 1, At, B1); PG8_BAR;
            }
        }
        if constexpr (ALIGN_EPI) { if (wr == 0) PG8_BAR; }
        if constexpr (!Epi::AFTER_DRAIN) { E(acc, cur, wr, wc, fr, fq); S.done(cur); }
        if (!has_next) break;
#pragma unroll
        for (int a = 0; a < 2; ++a)
#pragma unroll
            for (int b = 0; b < 2; ++b)
#pragma unroll
                for (int m = 0; m < 4; ++m)
#pragma unroll
                    for (int n = 0; n < 2; ++n) acc[a][b][m][n] = (f32x4){0.f, 0.f, 0.f, 0.f};
        cur = nxt; cA = nA; cB = nB; ++ui;
        if constexpr (ALIGN_EPI) { if (wr == 1) PG8_BAR; }
    }
    PG8_WAIT_V(0);
    if constexpr (!ALIGN_EPI) { if (wr == 0) PG8_BAR; }
    PG8_BAR;
    if constexpr (Epi::AFTER_DRAIN) { E.fused(acc, cur, wr, wc, fr, fq, lds, wid, lane); S.done(cur); }
#undef PG8_SA
#undef PG8_SB
#undef PG8_STAGE
#undef PG8_LDA
#undef PG8_LDB
#undef PG8_MMA
#undef PG8_WAIT_V
#undef PG8_WAIT_L
#undef PG8_BAR
#undef PG8_SCHED
}
}

#define LAS __attribute__((address_space(3)))
typedef unsigned short bf16_t;
typedef short bf16x8 __attribute__((ext_vector_type(8)));
typedef short v4i16_t __attribute__((ext_vector_type(4)));
typedef float f32x4 __attribute__((ext_vector_type(4)));
typedef float f32x16 __attribute__((ext_vector_type(16)));
typedef unsigned u32x4 __attribute__((ext_vector_type(4)));
typedef unsigned u32x2 __attribute__((ext_vector_type(2)));
typedef float f32x2 __attribute__((ext_vector_type(2)));

constexpr int DM = 1024, SEQ = 2048, NBATCH = 16, MT = NBATCH * SEQ;
constexpr int GB = 4, TG = GB * SEQ, NGRP = NBATCH / GB;
constexpr int LDP = pg8::LDP, NP = 14592, NIN = 14368;
constexpr int C_FQ = 0, C_FK = 1024, C_FV = 2048, C_FG = 3072, C_SZ = 4096, C_XBC = 5120, C_DQ = 7168, C_DK = 8192, C_DV = 9216, C_DG = 10240, C_MG = 11264;
constexpr float EPS = 1e-6f, LOG2E = 1.4426950408889634f, C2 = 0.125f * 1.4426950408889634f;
constexpr int NTHR = 512, NWAVES = 8;
constexpr int LDS_BYTES = 147456, LDS_MISC = 131072 + 8192;

constexpr size_t WS_CTR = 0, WS_BAR = 32768, WS_ROPE = 65536, WS_LAM = WS_ROPE + 131072, WS_WIN = 1u << 20;
constexpr size_t WS_WBR = WS_WIN + (size_t)2 * NP * 1024 * 2;
constexpr size_t WS_WOUT = WS_WBR + (size_t)6 * 1024 * 1024 * 2;
constexpr size_t WS_H = WS_WOUT + (size_t)2 * 1024 * 1024 * 2;
constexpr size_t WS_PROJ = WS_H + (size_t)MT * 1024 * 2;
constexpr size_t WS_SMALL = WS_PROJ + (size_t)TG * LDP * 2;
constexpr size_t WS_F2 = WS_SMALL + (size_t)TG * 32 * 4;
constexpr size_t WS_CD = WS_F2 + (size_t)GB * 16 * SEQ * 4;
constexpr size_t WS_M32 = WS_CD + 65536;
constexpr size_t WS_M16 = WS_M32 + (size_t)TG * 1024 * 4;
constexpr size_t WS_ST = WS_M16 + (size_t)TG * 1024 * 2;
constexpr size_t WS_PREV = WS_ST + (size_t)GB * 32 * 16 * 8192 * 2;
constexpr size_t WS_END = WS_ST + (size_t)GB * 32 * 16 * 8192 * 4;

struct Args { const float* in[15]; float* out; unsigned char* ws; };

__device__ __forceinline__ unsigned f2bf(float f) { unsigned u = __builtin_bit_cast(unsigned, f); return (u + 0x7fffu + ((u >> 16) & 1u)) >> 16; }
__device__ __forceinline__ unsigned pk2(float lo, float hi) { return pg8::cvt_pk_bf16(lo, hi); }
typedef __bf16 bf16x2_t __attribute__((ext_vector_type(2)));
__device__ __forceinline__ unsigned pk2m(float lo, float hi) { const f32x2 v = {lo, hi}; return __builtin_bit_cast(unsigned, __builtin_convertvector(v, bf16x2_t)); }
__device__ __forceinline__ float bflo(unsigned w) { return __uint_as_float(w << 16); }
__device__ __forceinline__ float bfhi(unsigned w) { return __uint_as_float(w & 0xffff0000u); }
__device__ __forceinline__ float bf1(bf16_t b) { return __uint_as_float(((unsigned)b) << 16); }
__device__ __forceinline__ float lx_xor(float v, int mask, int lane) { return __int_as_float(__builtin_amdgcn_ds_bpermute((lane ^ mask) << 2, __float_as_int(v))); }
__device__ __forceinline__ float lx_up(float v, int d, int lane) { return __int_as_float(__builtin_amdgcn_ds_bpermute((lane - d) << 2, __float_as_int(v))); }
__device__ __forceinline__ float wave_sum(float v, int lane) {
#pragma unroll
    for (int o = 1; o < 64; o <<= 1) v += lx_xor(v, o, lane);
    return v;
}
__device__ __forceinline__ int crow(int r, int hi) { return (r & 3) + 8 * (r >> 2) + 4 * hi; }
#define LDS_WAIT() asm volatile("s_waitcnt lgkmcnt(0)" ::: "memory")
#define THREAD_IDS() int lane; asm volatile("v_mbcnt_lo_u32_b32 %0, -1, 0\n\tv_mbcnt_hi_u32_b32 %0, -1, %0" : "=v"(lane)); int wave = w0; asm volatile("" : "+s"(wave)); const int tid = wave * 64 + lane; (void)tid
#define MFMA32(a, b, c) __builtin_amdgcn_mfma_f32_32x32x16_bf16((a), (b), (c), 0, 0, 0)
#define MFMA16(a, b, c) __builtin_amdgcn_mfma_f32_16x16x32_bf16((a), (b), (c), 0, 0, 0)

__device__ __forceinline__ int lbx() { int b = (int)blockIdx.x; asm volatile("" : "+s"(b)); return b; }
#define GAS __attribute__((address_space(1)))
__device__ __forceinline__ unsigned char* wsl(unsigned char* p) { GAS unsigned char* q = (GAS unsigned char*)p; asm volatile("" : "+s"(q)); return (unsigned char*)q; }
__device__ __forceinline__ int q_draw(unsigned* ctr, int w0) { int v = 0; if (w0 == 0) { int lane; asm volatile("v_mbcnt_lo_u32_b32 %0, -1, 0\n\tv_mbcnt_hi_u32_b32 %0, -1, %0" : "=v"(lane)); if (lane == 0) v = (int)atomicAdd(ctr, 1u); } return v; }
__device__ __forceinline__ int q_pub(int drawn, unsigned char* lds, int w0) {
    volatile int* slot = (volatile int*)(lds + LDS_MISC);
    __syncthreads();
    if (w0 == 0) { int lane; asm volatile("v_mbcnt_lo_u32_b32 %0, -1, 0\n\tv_mbcnt_hi_u32_b32 %0, -1, %0" : "=v"(lane)); if (lane == 0) *slot = drawn; }
    __syncthreads();
    return *slot;
}
#define UNIT_LOOP(ctr_, total_, body_) do { unsigned* c__ = (ctr_); \
    for (;;) { const int d__ = q_draw(c__, wave0); const int u = q_pub(d__, lds, wave0); if (u >= (total_)) break; body_ } } while (0)

__device__ __forceinline__ int win_src_col(int n) {
    if (n < 3072) return n;
    if (n < 7168) return n + 16;
    if (n < 14336) return n + 32;
    if (n < 14352) return 3072 + (n - 14336);
    if (n < 14368) return 7184 + (n - 14352);
    return -1;
}
template <bool MAP> __device__ __forceinline__ void transpose_item(const float* W, int K, int Nsrc, bf16_t* WT, float* scr, int kb, int nb, int lane) {
    const int k0 = 64 * kb, n0 = 32 * nb;
    const int nn = n0 + (lane & 31); const int src = MAP ? win_src_col(nn) : nn;
#pragma unroll
    for (int i = 0; i < 32; ++i) { const int kk = 2 * i + (lane >> 5); scr[kk * 33 + (lane & 31)] = (src >= 0) ? W[(size_t)(k0 + kk) * Nsrc + src] : 0.f; }
    LDS_WAIT();
    const int c = lane & 7;
#pragma unroll
    for (int j = 0; j < 4; ++j) { const int n = (lane >> 3) + 8 * j; const float* s = scr + (8 * c) * 33 + n;
        u32x4 o; o.x = pk2(s[0 * 33], s[1 * 33]); o.y = pk2(s[2 * 33], s[3 * 33]); o.z = pk2(s[4 * 33], s[5 * 33]); o.w = pk2(s[6 * 33], s[7 * 33]);
        *(u32x4*)(WT + (size_t)(n0 + n) * K + k0 + 8 * c) = o; }
    LDS_WAIT();
}
__device__ __forceinline__ void p0_prologue(const Args& a, unsigned char* lds, int w0) {
    THREAD_IDS();
    unsigned char* ws = wsl(a.ws);
    float* scr = (float*)(lds + wave * 8448);
    const int gw = blockIdx.x * NWAVES + wave, NGW = gridDim.x * NWAVES;
    constexpr int I_IN = 16 * (NP / 32), I_SQ = 16 * 32;
    constexpr int NITEMS = 2 * I_IN + 8 * I_SQ;
    for (int it = gw; it < NITEMS; it += NGW) {
        int r = it;
        if (r < 2 * I_IN) { const int layer = r / I_IN; r -= layer * I_IN;
            transpose_item<true>(a.in[2] + (size_t)layer * 1024 * NIN, 1024, NIN, (bf16_t*)(ws + WS_WIN) + (size_t)layer * NP * 1024, scr, r / (NP / 32), r % (NP / 32), lane); continue; }
        r -= 2 * I_IN;
        if (r < 6 * I_SQ) { const int mi = r / I_SQ; r -= mi * I_SQ;
            transpose_item<false>(a.in[12] + (size_t)mi * 1024 * 1024, 1024, 1024, (bf16_t*)(ws + WS_WBR) + (size_t)mi * 1024 * 1024, scr, r / 32, r % 32, lane); continue; }
        r -= 6 * I_SQ;
        { const int mi = r / I_SQ; r -= mi * I_SQ;
            transpose_item<false>(a.in[13] + (size_t)mi * 1024 * 1024, 1024, 1024, (bf16_t*)(ws + WS_WOUT) + (size_t)mi * 1024 * 1024, scr, r / 32, r % 32, lane); }
    }
    for (int idx = blockIdx.x * NTHR + tid; idx < SEQ * 8; idx += gridDim.x * NTHR) {
        const int pos = idx >> 3, i = idx & 7;
        const float inv = powf(500000.0f, -(float)(2 * i) / 16.0f);
        const float ang = (float)pos * inv;
        ((f32x2*)(ws + WS_ROPE))[idx] = (f32x2){cosf(ang), sinf(ang)};
    }
    if (blockIdx.x == 0) {
        if (tid < 128) ((unsigned*)(ws + WS_CTR))[tid * 64] = 0u;
        if (tid >= 128 && tid < 192) { const int k = tid - 128, layer = k >> 5, c = k & 31;
            ((float*)(ws + WS_LAM))[16 + k] = (c < 16) ? a.in[3][layer * 16 + c] : a.in[6][layer * 16 + c - 16]; }
        if (tid >= 64 && tid < 66) { const int layer = tid - 64; const float* lp = a.in[10] + layer * 256;
            float s1 = 0.f, s2 = 0.f;
            for (int d = 0; d < 64; ++d) { s1 += lp[d] * lp[64 + d]; s2 += lp[128 + d] * lp[192 + d]; }
            const float li = 0.8f - 0.6f * expf(-0.3f * (float)layer);
            ((float*)(ws + WS_LAM))[layer * 2] = expf(s1) - expf(s2) + li; ((float*)(ws + WS_LAM))[layer * 2 + 1] = li; }
    }
}
template <bool TOBF> __device__ __forceinline__ void norm_rows(const float* X, const float* w, bf16_t* ob, float* of, int w0) {
    THREAD_IDS();
    const int gw = blockIdx.x * NWAVES + wave, NGW = gridDim.x * NWAVES;
    f32x4 wv[4];
#pragma unroll
    for (int j = 0; j < 4; ++j) wv[j] = ((const f32x4*)w)[64 * j + lane];
    for (int m = gw; m < MT; m += 2 * NGW) {
        const int m2 = m + NGW;
        const f32x4* xr = (const f32x4*)(X + (size_t)m * DM) + lane; const f32x4* xr2 = (const f32x4*)(X + (size_t)m2 * DM) + lane;
        f32x4 v[4], v2[4]; float s = 0.f, s2 = 0.f;
#pragma unroll
        for (int j = 0; j < 4; ++j) { v[j] = xr[64 * j]; v2[j] = xr2[64 * j]; }
#pragma unroll
        for (int j = 0; j < 4; ++j) { s += (v[j].x * v[j].x + v[j].y * v[j].y) + (v[j].z * v[j].z + v[j].w * v[j].w); s2 += (v2[j].x * v2[j].x + v2[j].y * v2[j].y) + (v2[j].z * v2[j].z + v2[j].w * v2[j].w); }
        const float rs = rsqrtf(wave_sum(s, lane) * (1.0f / DM) + EPS), rs2 = rsqrtf(wave_sum(s2, lane) * (1.0f / DM) + EPS);
#pragma unroll
        for (int j = 0; j < 4; ++j) { const f32x4 o = v[j] * rs * wv[j], o2 = v2[j] * rs2 * wv[j];
            if (TOBF) { u32x2 p; p.x = pk2(o.x, o.y); p.y = pk2(o.z, o.w); ((u32x2*)(ob + (size_t)m * DM))[64 * j + lane] = p;
                        u32x2 q; q.x = pk2(o2.x, o2.y); q.y = pk2(o2.z, o2.w); ((u32x2*)(ob + (size_t)m2 * DM))[64 * j + lane] = q; }
            else { ((f32x4*)(of + (size_t)m * DM))[64 * j + lane] = o; ((f32x4*)(of + (size_t)m2 * DM))[64 * j + lane] = o2; } }
    }
}

constexpr int SL_ACS = 0, SL_DT = 1024, SL_PART = 2048, SL_XT = 4096, SL_B = SL_XT + 256 * 144, SL_C = SL_B + 18432;
constexpr int XTP = 144, BNP = 272;

__device__ __forceinline__ void ssd_acs(unsigned char* lds, const float* small, size_t row0, int g, const float* a_log, int wave, int lane) {
    if (wave < 4) {
        const int h = 4 * g + wave;
        const float dt = small[(row0 + lane) * 32 + 16 + h];
        float v = -expf(a_log[h]) * dt;
#pragma unroll
        for (int o = 1; o < 64; o <<= 1) { const float t = lx_up(v, o, lane); if (lane >= o) v += t; }
        ((float*)(lds + SL_ACS))[wave * 64 + lane] = v;
        ((float*)(lds + SL_DT))[wave * 64 + lane] = dt;
    }
}
__device__ __forceinline__ void conv8x8(float (&out)[8][8], const bf16_t* xb, int pg, int c, const float* cw, const float* cb) {
    u32x4 raw[11];
#pragma unroll
    for (int i = 0; i < 11; ++i) { const int rr = pg * 8 - 3 + i;
        if (rr >= 0 || c > 0) raw[i] = *(const u32x4*)(xb + (ptrdiff_t)rr * LDP); else raw[i] = (u32x4){0u, 0u, 0u, 0u}; }
    float w[4][8], bias[8];
#pragma unroll
    for (int k = 0; k < 4; ++k) { const f32x4 a = *(const f32x4*)(cw + k * 2048), b = *(const f32x4*)(cw + k * 2048 + 4);
        w[k][0] = a.x; w[k][1] = a.y; w[k][2] = a.z; w[k][3] = a.w; w[k][4] = b.x; w[k][5] = b.y; w[k][6] = b.z; w[k][7] = b.w; }
    { const f32x4 a = *(const f32x4*)cb, b = *(const f32x4*)(cb + 4); bias[0] = a.x; bias[1] = a.y; bias[2] = a.z; bias[3] = a.w; bias[4] = b.x; bias[5] = b.y; bias[6] = b.z; bias[7] = b.w; }
#pragma unroll
    for (int p = 0; p < 8; ++p) {
#pragma unroll
        for (int ch = 0; ch < 8; ++ch) { float s = bias[ch];
#pragma unroll
            for (int k = 0; k < 4; ++k) { const unsigned wd = raw[p + k][ch >> 1]; const float u = (ch & 1) ? bfhi(wd) : bflo(wd); s += w[k][ch] * u; }
            out[p][ch] = pg8::silu_f(s); }
    }
}
__device__ __forceinline__ void put_T(unsigned char* img, int chrow0, int s0, const float (&v)[8][8]) {
#pragma unroll
    for (int ch = 0; ch < 8; ++ch) { u32x4 o; o.x = pk2(v[0][ch], v[1][ch]); o.y = pk2(v[2][ch], v[3][ch]); o.z = pk2(v[4][ch], v[5][ch]); o.w = pk2(v[6][ch], v[7][ch]);
        *(u32x4*)(img + (chrow0 + ch) * XTP + s0 * 2) = o; }
}
__device__ __forceinline__ void put_N(unsigned char* img, int n0, int s0, const float (&v)[8][8]) {
#pragma unroll
    for (int p = 0; p < 8; ++p) { u32x4 o; o.x = pk2(v[p][0], v[p][1]); o.y = pk2(v[p][2], v[p][3]); o.z = pk2(v[p][4], v[p][5]); o.w = pk2(v[p][6], v[p][7]);
        *(u32x4*)(img + (s0 + p) * BNP + n0 * 2) = o; }
}

__device__ __forceinline__ void ssd_states_unit(const Args& a, int layer, int u, unsigned char* lds, int w0) {
    THREAD_IDS();
    const int g = u & 3, c = (u >> 2) & 31, bl = u >> 7;
    unsigned char* ws = wsl(a.ws);
    const bf16_t* PROJ = (const bf16_t*)(ws + WS_PROJ);
    const size_t row0 = (size_t)bl * SEQ + c * 64;
    ssd_acs(lds, (const float*)(ws + WS_SMALL), row0, g, a.in[7] + layer * 16, wave, lane);
    __syncthreads();
    const float* ACS = (const float*)(lds + SL_ACS); const float* DTL = (const float*)(lds + SL_DT);
    const int cgi = tid & 63, pg = tid >> 6;
    if (cgi < 48) {
        const int chx = (cgi < 32) ? (g * 256 + cgi * 8) : (1024 + g * 128 + (cgi - 32) * 8);
        float v[8][8];
        conv8x8(v, PROJ + row0 * LDP + C_XBC + chx, pg, c, a.in[4] + (size_t)layer * 4 * 2048 + chx, a.in[5] + layer * 2048 + chx);
        if (cgi < 32) { const int hh = cgi >> 3; const float al = ACS[hh * 64 + 63];
#pragma unroll
            for (int p = 0; p < 8; ++p) { const int s = pg * 8 + p; const float sc = __expf(al - ACS[hh * 64 + s]) * DTL[hh * 64 + s];
#pragma unroll
                for (int ch = 0; ch < 8; ++ch) v[p][ch] *= sc; }
            put_T(lds + SL_XT, cgi * 8, pg * 8, v);
        } else put_T(lds + SL_B, (cgi - 32) * 8, pg * 8, v);
    }
    __syncthreads();
    const int fr = lane & 15, fq = lane >> 4, hh = wave >> 1, nh = wave & 1;
    f32x4 acc[4][4];
#pragma unroll
    for (int i = 0; i < 4; ++i)
#pragma unroll
        for (int j = 0; j < 4; ++j) acc[i][j] = (f32x4){0.f, 0.f, 0.f, 0.f};
    {   bf16x8 af[2][4], bf[2][4];
#pragma unroll
        for (int ks = 0; ks < 2; ++ks) {
#pragma unroll
            for (int i = 0; i < 4; ++i) af[ks][i] = *(const bf16x8*)(lds + SL_B + (64 * nh + 16 * i + fr) * XTP + (32 * ks + 8 * fq) * 2);
#pragma unroll
            for (int j = 0; j < 4; ++j) bf[ks][j] = *(const bf16x8*)(lds + SL_XT + (hh * 64 + 16 * j + fr) * XTP + (32 * ks + 8 * fq) * 2); }
        __builtin_amdgcn_sched_barrier(0);
#pragma unroll
        for (int ks = 0; ks < 2; ++ks)
#pragma unroll
            for (int i = 0; i < 4; ++i)
#pragma unroll
                for (int j = 0; j < 4; ++j) acc[i][j] = MFMA16(af[ks][i], bf[ks][j], acc[i][j]);
    }
    const int h = 4 * g + hh;
    bf16_t* ST = (bf16_t*)(ws + WS_ST) + ((size_t)(bl * 32 + c) * 16 + h) * 8192;
#pragma unroll
    for (int i = 0; i < 4; ++i)
#pragma unroll
        for (int j = 0; j < 4; ++j) { u32x2 w; w.x = pk2m(acc[i][j][0], acc[i][j][1]); w.y = pk2m(acc[i][j][2], acc[i][j][3]);
            *(u32x2*)(ST + (16 * j + fr) * 128 + 64 * nh + 16 * i + 4 * fq) = w; }
    if (tid < 4) ((float*)(ws + WS_CD))[(bl * 32 + c) * 16 + 4 * g + tid] = __expf(ACS[tid * 64 + 63]);
}

__device__ __forceinline__ void ssd_scan_unit(const Args& a, int u, int w0) {
    THREAD_IDS();
    const int qt = u & 3, h = (u >> 2) & 15, bl = u >> 6;
    const bf16_t* ST = (const bf16_t*)(wsl(a.ws) + WS_ST); bf16_t* PV = (bf16_t*)(wsl(a.ws) + WS_PREV); const float* CD = (const float*)(wsl(a.ws) + WS_CD);
    const int e = qt * 2048 + tid * 4;
    float z0 = 0.f; asm volatile("" : "+v"(z0));
    f32x4 hc = (f32x4){z0, z0, z0, z0};
#pragma unroll 1
    for (int c0 = 0; c0 < 32; c0 += 16) {
        u32x2 sv[16]; float dcv[16];
#pragma unroll
        for (int c = 0; c < 16; ++c) { sv[c] = *(const u32x2*)(ST + ((size_t)(bl * 32 + c0 + c) * 16 + h) * 8192 + e); dcv[c] = CD[(bl * 32 + c0 + c) * 16 + h]; }
#pragma unroll
        for (int c = 0; c < 16; ++c) { const float dec = dcv[c];
            u32x2 w; w.x = pk2(hc[0], hc[1]); w.y = pk2(hc[2], hc[3]);
            *(u32x2*)(PV + ((size_t)(bl * 32 + c0 + c) * 16 + h) * 8192 + e) = w;
            hc = hc * dec + (f32x4){bflo(sv[c].x), bfhi(sv[c].x), bflo(sv[c].y), bfhi(sv[c].y)}; }
    }
}

__device__ __forceinline__ void ssd_out_unit(const Args& a, int layer, int u, unsigned char* lds, int w0, bool dry = false) {
    THREAD_IDS();
    const int g = u & 3, c = (u >> 2) & 31, bl = u >> 7;
    unsigned char* ws = wsl(a.ws);
    bf16_t* PROJ = (bf16_t*)(ws + WS_PROJ);
    const size_t row0 = (size_t)bl * SEQ + c * 64;
    ssd_acs(lds, (const float*)(ws + WS_SMALL), row0, g, a.in[7] + layer * 16, wave, lane);
    const int cgi = tid & 63, pg = tid >> 6;
    {
        const int chx = (cgi < 32) ? (g * 256 + cgi * 8) : (cgi < 48) ? (1024 + g * 128 + (cgi - 32) * 8) : (1536 + g * 128 + (cgi - 48) * 8);
        float v[8][8];
        conv8x8(v, PROJ + row0 * LDP + C_XBC + chx, pg, c, a.in[4] + (size_t)layer * 4 * 2048 + chx, a.in[5] + layer * 2048 + chx);
        if (cgi < 32) put_T(lds + SL_XT, cgi * 8, pg * 8, v);
        else if (cgi < 48) put_N(lds + SL_B, (cgi - 32) * 8, pg * 8, v);
        else put_N(lds + SL_C, (cgi - 48) * 8, pg * 8, v);
    }
    const int fr = lane & 15, fq = lane >> 4, hh = wave >> 1, lh = wave & 1, h = 4 * g + hh;
    const bf16_t* PV = (const bf16_t*)(ws + WS_PREV) + ((size_t)(bl * 32 + c) * 16 + h) * 8192;
    u32x2 zws[2][4]; f32x4 nwv[4];
#pragma unroll
    for (int lt = 0; lt < 2; ++lt)
#pragma unroll
        for (int pt = 0; pt < 4; ++pt) zws[lt][pt] = *(const u32x2*)(PROJ + (row0 + 32 * lh + 16 * lt + fr) * LDP + C_SZ + h * 64 + 16 * pt + 4 * fq);
#pragma unroll
    for (int pt = 0; pt < 4; ++pt) nwv[pt] = *(const f32x4*)(a.in[9] + layer * 1024 + h * 64 + 16 * pt + 4 * fq);
    bf16x8 pa[4][4];
#pragma unroll
    for (int ks = 0; ks < 4; ++ks)
#pragma unroll
        for (int pt = 0; pt < 4; ++pt) pa[ks][pt] = *(const bf16x8*)(PV + (16 * pt + fr) * 128 + 32 * ks + 8 * fq);
    __syncthreads();
    const float* ACS = (const float*)(lds + SL_ACS); const float* DTL = (const float*)(lds + SL_DT);
    f32x4 acc[4][2], dd[4][2];
#pragma unroll
    for (int i = 0; i < 4; ++i)
#pragma unroll
        for (int j = 0; j < 2; ++j) { acc[i][j] = (f32x4){0.f, 0.f, 0.f, 0.f}; dd[i][j] = (f32x4){0.f, 0.f, 0.f, 0.f}; }
    bf16x8 cf[4][2];
#pragma unroll
    for (int ks = 0; ks < 4; ++ks)
#pragma unroll
        for (int lt = 0; lt < 2; ++lt) cf[ks][lt] = *(const bf16x8*)(lds + SL_C + (32 * lh + 16 * lt + fr) * BNP + (32 * ks + 8 * fq) * 2);
    __builtin_amdgcn_sched_barrier(0);
#pragma unroll
    for (int ks = 0; ks < 4; ++ks)
#pragma unroll
        for (int pt = 0; pt < 4; ++pt)
#pragma unroll
            for (int lt = 0; lt < 2; ++lt) acc[pt][lt] = MFMA16(pa[ks][pt], cf[ks][lt], acc[pt][lt]);
    __builtin_amdgcn_sched_barrier(0);
    {   bf16x8 bq[4][4];
#pragma unroll
        for (int ks = 0; ks < 4; ++ks)
#pragma unroll
            for (int st = 0; st < 4; ++st) if (st < 2 || lh) bq[ks][st] = *(const bf16x8*)(lds + SL_B + (16 * st + fr) * BNP + (32 * ks + 8 * fq) * 2);
        __builtin_amdgcn_sched_barrier(0);
#pragma unroll
        for (int ks = 0; ks < 4; ++ks)
#pragma unroll
            for (int st = 0; st < 4; ++st) if (st < 2 || lh) {
#pragma unroll
                for (int lt = 0; lt < 2; ++lt) dd[st][lt] = MFMA16(bq[ks][st], cf[ks][lt], dd[st][lt]); }
    }
    float acl[2];
#pragma unroll
    for (int lt = 0; lt < 2; ++lt) { acl[lt] = ACS[hh * 64 + 32 * lh + 16 * lt + fr]; const float e = __expf(acl[lt]);
#pragma unroll
        for (int pt = 0; pt < 4; ++pt) acc[pt][lt] *= e; }
#pragma unroll
    for (int st = 0; st < 4; ++st) if (st < 2 || lh) {
#pragma unroll
        for (int r = 0; r < 4; ++r) { const int s = 16 * st + 4 * fq + r; const float as = ACS[hh * 64 + s], ds = DTL[hh * 64 + s];
#pragma unroll
            for (int lt = 0; lt < 2; ++lt) { const int l = 32 * lh + 16 * lt + fr; dd[st][lt][r] = (s <= l) ? dd[st][lt][r] * __expf(acl[lt] - as) * ds : 0.f; } }
    }
#pragma unroll
    for (int kk = 0; kk < 2; ++kk) if (kk == 0 || lh) {
        bf16x8 mb[2];
#pragma unroll
        for (int lt = 0; lt < 2; ++lt) { u32x4 w; w.x = pk2(dd[2 * kk][lt][0], dd[2 * kk][lt][1]); w.y = pk2(dd[2 * kk][lt][2], dd[2 * kk][lt][3]);
            w.z = pk2(dd[2 * kk + 1][lt][0], dd[2 * kk + 1][lt][1]); w.w = pk2(dd[2 * kk + 1][lt][2], dd[2 * kk + 1][lt][3]); mb[lt] = __builtin_bit_cast(bf16x8, w); }
#pragma unroll
        for (int pt = 0; pt < 4; ++pt) { const unsigned char* xr = lds + SL_XT + (hh * 64 + 16 * pt + fr) * XTP + (32 * kk + 4 * fq) * 2;
            const u32x2 lo = *(const u32x2*)xr, hi2 = *(const u32x2*)(xr + 32);
            const bf16x8 af = __builtin_bit_cast(bf16x8, (u32x4){lo.x, lo.y, hi2.x, hi2.y});
#pragma unroll
            for (int lt = 0; lt < 2; ++lt) acc[pt][lt] = MFMA16(af, mb[lt], acc[pt][lt]); }
    }
    const float dsk = a.in[8][layer * 16 + h];
    float ss[2] = {0.f, 0.f};
#pragma unroll
    for (int lt = 0; lt < 2; ++lt) { const int l = 32 * lh + 16 * lt + fr;
#pragma unroll
        for (int pt = 0; pt < 4; ++pt) { const int p4 = 16 * pt + 4 * fq;
            const u32x2 zw = zws[lt][pt];
            const float zz[4] = {bflo(zw.x), bfhi(zw.x), bflo(zw.y), bfhi(zw.y)};
#pragma unroll
            for (int r = 0; r < 4; ++r) { const float xv = bf1(*(const bf16_t*)(lds + SL_XT + (hh * 64 + p4 + r) * XTP + l * 2));
                const float y = (acc[pt][lt][r] + xv * dsk) * zz[r]; acc[pt][lt][r] = y; ss[lt] += y * y; } } }
#pragma unroll
    for (int lt = 0; lt < 2; ++lt) { ss[lt] += lx_xor(ss[lt], 16, lane); ss[lt] += lx_xor(ss[lt], 32, lane);
        if (fq == 0) ((float*)(lds + SL_PART))[hh * 64 + 32 * lh + 16 * lt + fr] = ss[lt]; }
    __syncthreads();
    const float* nw = a.in[9] + layer * 1024 + h * 64;
#pragma unroll
    for (int lt = 0; lt < 2; ++lt) { const int l = 32 * lh + 16 * lt + fr; const float* pr = (const float*)(lds + SL_PART);
        const float tot = (pr[l] + pr[64 + l]) + (pr[128 + l] + pr[192 + l]);
        const float rs = rsqrtf(tot * (1.0f / 256.0f) + EPS);
#pragma unroll
        for (int pt = 0; pt < 4; ++pt) { const int p4 = 16 * pt + 4 * fq; const f32x4 wv = nwv[pt];
            u32x2 o; o.x = pk2(acc[pt][lt][0] * rs * wv.x, acc[pt][lt][1] * rs * wv.y); o.y = pk2(acc[pt][lt][2] * rs * wv.z, acc[pt][lt][3] * rs * wv.w);
            if (dry) *(u32x2*)((bf16_t*)(ws + WS_M16) + (row0 + l) * 1024 + h * 64 + p4) = o; else *(u32x2*)(PROJ + (row0 + l) * LDP + C_SZ + h * 64 + p4) = o; } }
}

__device__ __forceinline__ void fcum_unit(const Args& a, int fu, int w0) {
    THREAD_IDS();
    const int task = fu * 8 + wave, bl = task >> 4, h = task & 15;
    const float* sm = (const float*)(wsl(a.ws) + WS_SMALL) + ((size_t)bl * SEQ + lane * 32) * 32 + h;
    float v[32]; float run = 0.f;
#pragma unroll
    for (int i = 0; i < 32; ++i) { run += sm[i * 32]; v[i] = run; }
    float sc = run;
#pragma unroll
    for (int o = 1; o < 64; o <<= 1) { const float t = lx_up(sc, o, lane); if (lane >= o) sc += t; }
    const float off = sc - run;
    float* F = (float*)(wsl(a.ws) + WS_F2) + (size_t)task * SEQ + lane * 32;
#pragma unroll
    for (int i = 0; i < 32; i += 4) *(f32x4*)(F + i) = (f32x4){(off + v[i]) * LOG2E, (off + v[i + 1]) * LOG2E, (off + v[i + 2]) * LOG2E, (off + v[i + 3]) * LOG2E};
}
__device__ __forceinline__ void rope_unit(const Args& a, int ru, int w0) {
    THREAD_IDS();
    const int row = ru * 64 + (tid >> 3), j = tid & 7, pos = row & (SEQ - 1);
    bf16_t* PROJ = (bf16_t*)(wsl(a.ws) + WS_PROJ);
    const f32x2* cs = (const f32x2*)(wsl(a.ws) + WS_ROPE) + pos * 8;
    f32x2 t[8];
#pragma unroll
    for (int i = 0; i < 8; ++i) t[i] = cs[i];
#pragma unroll
    for (int k = 0; k < 4; ++k) { const int hc = 4 * j + k; const int col = (hc < 16) ? (C_DQ + hc * 64) : (C_DK + (hc - 16) * 64);
        u32x4* p = (u32x4*)(PROJ + (size_t)row * LDP + col);
        const u32x4 a1 = p[0], a2 = p[1]; u32x4 o1, o2;
#pragma unroll
        for (int w = 0; w < 4; ++w) {
            const float x1l = bflo(a1[w]), x1h = bfhi(a1[w]), x2l = bflo(a2[w]), x2h = bfhi(a2[w]);
            const f32x2 c0 = t[2 * w], c1 = t[2 * w + 1];
            o1[w] = pk2(x1l * c0.x - x2l * c0.y, x1h * c1.x - x2h * c1.y);
            o2[w] = pk2(x2l * c0.x + x1l * c0.y, x2h * c1.x + x1h * c1.y); }
        p[0] = o1; p[1] = o2; }
}

__device__ __forceinline__ v4i16_t vtr(const unsigned char* p) { return __builtin_amdgcn_ds_read_tr16_b64_v4i16((LAS v4i16_t*)(LAS unsigned char*)p); }
__device__ __forceinline__ float max3f(float a, float b, float c) { float r; asm("v_max3_f32 %0, %1, %2, %3" : "=v"(r) : "v"(a), "v"(b), "v"(c)); return r; }
template <int DV, bool FOX>
__device__ __forceinline__ void attn_pass(f32x16 (&o)[DV / 32], float& l_out, const bf16_t* Qw, const bf16_t* Kb, const bf16_t* Vb, const float* F2,
                                          int q0, unsigned char* lds, int w0) {
    THREAD_IDS(); const int wid = wave;
    constexpr int KP = 144, VP = DV * 2 + 64, OFF_K = 0, OFF_V = 64 * KP, OFF_F = OFF_V + 64 * VP, STAGE = OFF_F + 256, NV = DV / 64;
    const int r32 = lane & 31, hi = lane >> 5;
    const int NT = (q0 + 256) / 64, my_nt = (q0 + 32 * wid) / 64 + 1;
    bf16x8 qf[4];
#pragma unroll
    for (int d0 = 0; d0 < 4; ++d0) qf[d0] = *(const bf16x8*)(Qw + (size_t)r32 * LDP + d0 * 16 + hi * 8);
    float m = -INFINITY, l = 0.f;
#pragma unroll
    for (int i = 0; i < DV / 32; ++i)
#pragma unroll
        for (int r = 0; r < 16; ++r) o[i][r] = 0.f;
    u32x4 kreg, vreg[NV]; float freg = 0.f;
    const int krow = tid >> 3, kch = tid & 7;
#define ATT_LOAD(t) do { kreg = *(const u32x4*)(Kb + (size_t)(64 * (t) + krow) * LDP + kch * 8); \
        _Pragma("unroll") for (int i_ = 0; i_ < NV; ++i_) { const int idx_ = tid + 512 * i_; const int vr_ = (DV == 64) ? (idx_ >> 3) : (idx_ >> 4), vc_ = (DV == 64) ? (idx_ & 7) : (idx_ & 15); \
            vreg[i_] = *(const u32x4*)(Vb + (size_t)(64 * (t) + vr_) * LDP + vc_ * 8); } \
        if (FOX && tid < 64) freg = -F2[64 * (t) + tid]; } while (0)
#define ATT_STORE(sb_) do { *(u32x4*)((sb_) + OFF_K + krow * KP + kch * 16) = kreg; \
        _Pragma("unroll") for (int i_ = 0; i_ < NV; ++i_) { const int idx_ = tid + 512 * i_; const int vr_ = (DV == 64) ? (idx_ >> 3) : (idx_ >> 4), vc_ = (DV == 64) ? (idx_ & 7) : (idx_ & 15); \
            *(u32x4*)((sb_) + OFF_V + vr_ * VP + vc_ * 16) = vreg[i_]; } \
        if (FOX && tid < 64) ((float*)((sb_) + OFF_F))[tid] = freg; } while (0)
    __syncthreads();
    ATT_LOAD(0); ATT_STORE(lds);
    if (NT > 1) ATT_LOAD(1);
    __syncthreads();
    for (int t = 0; t < NT; ++t) {
        const unsigned char* sb = lds + (t & 1) * STAGE;
        if (t < my_nt) {
            bf16x8 kf[8];
#pragma unroll
            for (int d0 = 0; d0 < 4; ++d0) { kf[2 * d0] = *(const bf16x8*)(sb + OFF_K + r32 * KP + d0 * 32 + hi * 16);
                kf[2 * d0 + 1] = *(const bf16x8*)(sb + OFF_K + (32 + r32) * KP + d0 * 32 + hi * 16); }
            const unsigned char* vb = sb + OFF_V + (4 * hi + ((lane & 15) >> 2)) * VP + (16 * ((lane >> 4) & 1) + 4 * (lane & 3)) * 2;
            f32x4 fka[4], fkb[4];
            if (FOX) { const float* fk = (const float*)(sb + OFF_F);
#pragma unroll
                for (int g4 = 0; g4 < 4; ++g4) { fka[g4] = *(const f32x4*)(fk + 8 * g4 + 4 * hi); fkb[g4] = *(const f32x4*)(fk + 32 + 8 * g4 + 4 * hi); } }
            v4i16_t vs[2][DV / 32][2];
#pragma unroll
            for (int dvt = 0; dvt < DV / 32; ++dvt) { vs[0][dvt][0] = vtr(vb + dvt * 64); vs[0][dvt][1] = vtr(vb + 8 * VP + dvt * 64); }
            __builtin_amdgcn_sched_barrier(0);
            f32x16 p0, p1;
#pragma unroll
            for (int r = 0; r < 16; ++r) { p0[r] = 0.f; p1[r] = 0.f; }
#pragma unroll
            for (int d0 = 0; d0 < 4; ++d0) { p0 = MFMA32(kf[2 * d0], qf[d0], p0); p1 = MFMA32(kf[2 * d0 + 1], qf[d0], p1); }
            if (FOX) {
#pragma unroll
                for (int g4 = 0; g4 < 4; ++g4) { const f32x4 fa = fka[g4], fb = fkb[g4];
#pragma unroll
                    for (int i = 0; i < 4; ++i) { p0[4 * g4 + i] = p0[4 * g4 + i] * C2 + fa[i]; p1[4 * g4 + i] = p1[4 * g4 + i] * C2 + fb[i]; } }
                if (t == my_nt - 1) { const int qpos = q0 + 32 * wid + r32;
#pragma unroll
                    for (int r = 0; r < 16; ++r) { const int kp = 64 * t + crow(r, hi); if (kp > qpos) p0[r] = -INFINITY; if (kp + 32 > qpos) p1[r] = -INFINITY; } }
            } else {
                asm volatile("s_nop 15\n\ts_nop 7" : "+v"(p0), "+v"(p1));
            }
            float ma = max3f(p0[0], p0[1], p1[0]), mb = max3f(p0[2], p0[3], p1[1]);
            ma = max3f(ma, p1[2], p1[3]);
#pragma unroll
            for (int r = 4; r < 16; r += 4) { ma = max3f(ma, p0[r], p0[r + 1]); mb = max3f(mb, p0[r + 2], p0[r + 3]); ma = max3f(ma, p1[r], p1[r + 1]); mb = max3f(mb, p1[r + 2], p1[r + 3]); }
            float mx = max3f(ma, mb, ma);
            if (!FOX) mx *= C2;
            mx = max3f(mx, lx_xor(mx, 32, lane), mx);
            if (__any(mx > m)) {
                const float mn = max3f(m, mx, mx), alpha = __builtin_amdgcn_exp2f(m - mn);
                m = mn; l *= alpha;
#pragma unroll
                for (int i = 0; i < DV / 32; ++i)
#pragma unroll
                    for (int r = 0; r < 16; ++r) o[i][r] *= alpha;
            }
            float rsa = 0.f, rsb = 0.f;
#pragma unroll
            for (int r = 0; r < 16; r += 2) {
                f32x2 a = {p0[r], p0[r + 1]}, b = {p1[r], p1[r + 1]};
                if (FOX) { a = a - (f32x2){m, m}; b = b - (f32x2){m, m}; }
                else { a = a * (f32x2){C2, C2} - (f32x2){m, m}; b = b * (f32x2){C2, C2} - (f32x2){m, m}; }
                p0[r] = __builtin_amdgcn_exp2f(a.x); p0[r + 1] = __builtin_amdgcn_exp2f(a.y); p1[r] = __builtin_amdgcn_exp2f(b.x); p1[r + 1] = __builtin_amdgcn_exp2f(b.y);
                rsa += p0[r] + p0[r + 1]; rsb += p1[r] + p1[r + 1]; }
            l += rsa + rsb;
            bf16x8 pf[4];
            { u32x4 w;
              w.x = pk2(p0[0], p0[1]); w.y = pk2(p0[2], p0[3]); w.z = pk2(p0[4], p0[5]); w.w = pk2(p0[6], p0[7]); pf[0] = __builtin_bit_cast(bf16x8, w);
              w.x = pk2(p0[8], p0[9]); w.y = pk2(p0[10], p0[11]); w.z = pk2(p0[12], p0[13]); w.w = pk2(p0[14], p0[15]); pf[1] = __builtin_bit_cast(bf16x8, w);
              w.x = pk2(p1[0], p1[1]); w.y = pk2(p1[2], p1[3]); w.z = pk2(p1[4], p1[5]); w.w = pk2(p1[6], p1[7]); pf[2] = __builtin_bit_cast(bf16x8, w);
              w.x = pk2(p1[8], p1[9]); w.y = pk2(p1[10], p1[11]); w.z = pk2(p1[12], p1[13]); w.w = pk2(p1[14], p1[15]); pf[3] = __builtin_bit_cast(bf16x8, w); }
            __builtin_amdgcn_sched_barrier(0);
#pragma unroll
            for (int ks = 0; ks < 4; ++ks) {
                if (ks + 1 < 4) {
#pragma unroll
                    for (int dvt = 0; dvt < DV / 32; ++dvt) { vs[(ks + 1) & 1][dvt][0] = vtr(vb + 16 * (ks + 1) * VP + dvt * 64); vs[(ks + 1) & 1][dvt][1] = vtr(vb + (16 * (ks + 1) + 8) * VP + dvt * 64); }
                    __builtin_amdgcn_sched_barrier(0);
                }
#pragma unroll
                for (int dvt = 0; dvt < DV / 32; ++dvt) {
                    const v4i16_t lo = vs[ks & 1][dvt][0], h8 = vs[ks & 1][dvt][1];
                    const bf16x8 vf = (bf16x8){lo[0], lo[1], lo[2], lo[3], h8[0], h8[1], h8[2], h8[3]};
                    o[dvt] = MFMA32(vf, pf[ks], o[dvt]);
                }
                __builtin_amdgcn_sched_barrier(0);
            }
        }
        if (t + 1 < NT) { ATT_STORE(lds + ((t + 1) & 1) * STAGE); if (t + 2 < NT) ATT_LOAD(t + 2); }
        __syncthreads();
    }
#undef ATT_LOAD
#undef ATT_STORE
    l_out = l + lx_xor(l, 32, lane);
}

__device__ __forceinline__ void fox_unit(const Args& a, int bh, int qb, unsigned char* lds, int w0, bool dry = false) {
    THREAD_IDS(); const int wid = wave;
    const int bl = bh >> 4, h = bh & 15, q0 = qb * 256, r32 = lane & 31, hi = lane >> 5;
    bf16_t* PROJ = (bf16_t*)(wsl(a.ws) + WS_PROJ);
    const size_t rowb = (size_t)bl * SEQ;
    f32x16 o[2]; float l;
    bf16_t* orow = PROJ + (rowb + q0 + 32 * wid + r32) * LDP;
    u32x2 gws[8];
#pragma unroll
    for (int k = 0; k < 8; ++k) gws[k] = *(const u32x2*)(orow + C_FG + h * 64 + 32 * (k >> 2) + 8 * (k & 3) + 4 * hi);
    attn_pass<64, true>(o, l, PROJ + (rowb + q0 + 32 * wid) * LDP + C_FQ + h * 64, PROJ + rowb * LDP + C_FK + h * 64, PROJ + rowb * LDP + C_FV + h * 64,
                        (const float*)(wsl(a.ws) + WS_F2) + (size_t)bh * SEQ, q0, lds, w0);
    const float inv = 1.0f / l;
    bf16_t* owr = dry ? (bf16_t*)(wsl(a.ws) + WS_M16) + (rowb + q0 + 32 * wid + r32) * 1024 : orow + C_FQ;
#pragma unroll
    for (int dvt = 0; dvt < 2; ++dvt)
#pragma unroll
        for (int g4 = 0; g4 < 4; ++g4) { const int dv = 32 * dvt + 8 * g4 + 4 * hi;
            const u32x2 gw = gws[dvt * 4 + g4];
            u32x2 w; w.x = pk2(o[dvt][4 * g4] * inv * bflo(gw.x), o[dvt][4 * g4 + 1] * inv * bfhi(gw.x)); w.y = pk2(o[dvt][4 * g4 + 2] * inv * bflo(gw.y), o[dvt][4 * g4 + 3] * inv * bfhi(gw.y));
            *(u32x2*)(owr + h * 64 + dv) = w; }
}
__device__ __forceinline__ void diff_unit(const Args& a, int layer, int bh, int qb, unsigned char* lds, int w0, bool dry = false) {
    THREAD_IDS(); const int wid = wave;
    const int bl = bh >> 3, h = bh & 7, q0 = qb * 256, r32 = lane & 31, hi = lane >> 5;
    bf16_t* PROJ = (bf16_t*)(wsl(a.ws) + WS_PROJ);
    const size_t rowb = (size_t)bl * SEQ;
    const float lam = ((const float*)(wsl(a.ws) + WS_LAM))[layer * 2], lami = ((const float*)(wsl(a.ws) + WS_LAM))[layer * 2 + 1];
    f32x16 o1[4]; float l1, l2;
    float* scr = (float*)(wsl(a.ws) + WS_M32) + ((size_t)((bh * 8 + qb) * 8 + wid) * 64 + lane) * 64;
    attn_pass<128, false>(o1, l1, PROJ + (rowb + q0 + 32 * wid) * LDP + C_DQ + h * 128, PROJ + rowb * LDP + C_DK + h * 128, PROJ + rowb * LDP + C_DV + h * 128, nullptr, q0, lds, w0);
    { const float inv = 1.0f / l1;
#pragma unroll
      for (int i = 0; i < 4; ++i)
#pragma unroll
          for (int r = 0; r < 16; r += 4) *(f32x4*)(scr + i * 16 + r) = (f32x4){o1[i][r] * inv, o1[i][r + 1] * inv, o1[i][r + 2] * inv, o1[i][r + 3] * inv}; }
    attn_pass<128, false>(o1, l2, PROJ + (rowb + q0 + 32 * wid) * LDP + C_DQ + h * 128 + 64, PROJ + rowb * LDP + C_DK + h * 128 + 64, PROJ + rowb * LDP + C_DV + h * 128, nullptr, q0, lds, w0);
    const float sc2 = lam / l2; float ss = 0.f;
    {   f32x4 c1[16];
#pragma unroll
        for (int k = 0; k < 16; ++k) c1[k] = *(const f32x4*)(scr + 4 * k);
#pragma unroll
        for (int k = 0; k < 16; ++k)
#pragma unroll
            for (int e = 0; e < 4; ++e) { const int i = k >> 2, r = 4 * (k & 3) + e; const float v = c1[k][e] - sc2 * o1[i][r]; o1[i][r] = v; ss += v * v; }
    }
    ss += lx_xor(ss, 32, lane);
    const float rs = rsqrtf(ss * (1.0f / 128.0f) + EPS) * (1.0f - lami);
    bf16_t* orow = PROJ + (rowb + q0 + 32 * wid + r32) * LDP;
    const float* sw = a.in[11] + layer * 128;
    bf16_t* owr = dry ? (bf16_t*)(wsl(a.ws) + WS_M16) + (rowb + q0 + 32 * wid + r32) * 1024 : orow + C_DQ;
#pragma unroll
    for (int half = 0; half < 2; ++half) {
        u32x2 gwv[8]; f32x4 wvv[8];
#pragma unroll
        for (int k = 0; k < 8; ++k) { const int dvt = 2 * half + (k >> 2), g4 = k & 3, dv = 32 * dvt + 8 * g4 + 4 * hi;
            gwv[k] = *(const u32x2*)(orow + C_DG + h * 128 + dv); wvv[k] = *(const f32x4*)(sw + dv); }
#pragma unroll
        for (int k = 0; k < 8; ++k) { const int dvt = 2 * half + (k >> 2), g4 = k & 3, dv = 32 * dvt + 8 * g4 + 4 * hi;
            const u32x2 gw = gwv[k]; const f32x4 wv = wvv[k];
            u32x2 w; w.x = pk2(o1[dvt][4 * g4] * rs * wv.x * bflo(gw.x), o1[dvt][4 * g4 + 1] * rs * wv.y * bfhi(gw.x));
            w.y = pk2(o1[dvt][4 * g4 + 2] * rs * wv.z * bflo(gw.y), o1[dvt][4 * g4 + 3] * rs * wv.w * bfhi(gw.y));
            *(u32x2*)(owr + h * 128 + dv) = w; }
    }
}

#define XB_TMO      128
#define XB_XCNT(j)  (256  + 64 * (j))
#define XB_XSUB(j)  (1280 + 64 * (j))
#define XB_XGEN(j)  (2304 + 64 * (j))
#define XB_TOP      3328
#define XB_TOPGEN   3392
#define XCD_BAR_WORDS 3456
#define XB_SPIN_CAP (1u << 18)

__device__ __forceinline__ unsigned xb_ld(unsigned* p)              { return __hip_atomic_load(p, __ATOMIC_RELAXED, __HIP_MEMORY_SCOPE_AGENT); }
__device__ __forceinline__ unsigned xb_add(unsigned* p, unsigned v) { return __hip_atomic_fetch_add(p, v, __ATOMIC_RELAXED, __HIP_MEMORY_SCOPE_AGENT); }
__device__ __forceinline__ unsigned xb_xcc_id() { return (unsigned)__builtin_amdgcn_s_getreg((3 << 11) | 20) & 0xFu; }
#define XB_SPIN(cond, bar) do { unsigned _sp = 0; while (cond) { __builtin_amdgcn_s_sleep(1); \
    if ((++_sp & 255u) == 0u) { if (xb_ld(&(bar)[XB_TMO])) break; if (_sp > XB_SPIN_CAP) { atomicAdd(&(bar)[XB_TMO], 1u); break; } } } } while (0)

struct XcdBarrier {
    unsigned* bar; unsigned x;
    volatile LAS unsigned* st;
};

__device__ __forceinline__ XcdBarrier xcd_barrier_post(unsigned* bar, volatile LAS unsigned* st) {
    XcdBarrier b; b.bar = bar; b.x = xb_xcc_id(); b.st = st;
    if (threadIdx.x == 0) (void)xb_add(&bar[XB_XCNT(b.x)], 1u);
    return b;
}
__device__ __forceinline__ void xcd_barrier_complete(unsigned* bar, unsigned x, unsigned& nloc, unsigned& nx) {
    const unsigned G = gridDim.x * gridDim.y * gridDim.z;
    unsigned sum, cnt, mine, sp = 0u;
    for (;;) {
        sum = 0u; cnt = 0u; mine = 0u;
#pragma unroll
        for (unsigned j = 0; j < 16; ++j) { const unsigned c = xb_ld(&bar[XB_XCNT(j)]); sum += c; cnt += (c > 0u) ? 1u : 0u; mine = (j == x) ? c : mine; }
        if (sum == G) break;
        __builtin_amdgcn_s_sleep(1);
        if ((++sp & 255u) == 0u) { if (xb_ld(&bar[XB_TMO])) break; if (sp > XB_SPIN_CAP) { atomicAdd(&bar[XB_TMO], 1u); break; } }
    }
    nloc = mine > 0u ? mine : 1u; nx = cnt > 0u ? cnt : 1u;
}

__device__ __forceinline__ bool is_thread0(int w0) { int lane; asm volatile("v_mbcnt_lo_u32_b32 %0, -1, 0\n\tv_mbcnt_hi_u32_b32 %0, -1, %0" : "=v"(lane)); return w0 == 0 && lane == 0; }
__device__ __forceinline__ void xcd_barrier(const XcdBarrier& b, int w0) {
    asm volatile("s_waitcnt vmcnt(0)" ::: "memory");
    __syncthreads();
    if (is_thread0(w0)) {
        unsigned* bar = b.bar;
        __builtin_amdgcn_s_waitcnt(0);
        unsigned nloc = b.st[0], nx = b.st[1];
        if (nloc == 0u) { xcd_barrier_complete(bar, b.x, nloc, nx); b.st[0] = nloc; b.st[1] = nx; }
        const unsigned old = xb_add(&bar[XB_XSUB(b.x)], 1u);
        const unsigned gen = old / nloc;
        if (old + 1u == (gen + 1u) * nloc) {
            __builtin_amdgcn_fence(__ATOMIC_RELEASE, "agent");
            asm volatile("s_waitcnt vmcnt(0)" ::: "memory");
            const unsigned og = xb_add(&bar[XB_TOP], 1u);
            const unsigned tg = og / nx;
            if (og + 1u == (tg + 1u) * nx) xb_add(&bar[XB_TOPGEN], 1u);
            else XB_SPIN(xb_ld(&bar[XB_TOPGEN]) == tg, bar);
            __builtin_amdgcn_fence(__ATOMIC_ACQUIRE, "agent");
            xb_add(&bar[XB_XGEN(b.x)], 1u);
            asm volatile("s_waitcnt vmcnt(0)" ::: "memory");
        } else {
            XB_SPIN(xb_ld(&bar[XB_XGEN(b.x)]) == gen, bar);
            __builtin_amdgcn_fence(__ATOMIC_ACQUIRE, "agent");
            asm volatile("s_waitcnt vmcnt(0)" ::: "memory");
        }
    }
    __syncthreads();
}

__global__ void __launch_bounds__(NTHR, 2) hybrid_fwd(Args args) {
    extern __shared__ __attribute__((aligned(16))) unsigned char lds[];
    cg::grid_group grid = cg::this_grid();
    const int wave0 = __builtin_amdgcn_readfirstlane((int)threadIdx.x >> 6);
    Args A2;
#pragma unroll
    for (int i = 0; i < 15; ++i) A2.in[i] = (const float*)(GAS const float*)args.in[i];
    A2.out = (float*)(GAS float*)args.out; A2.ws = (unsigned char*)(GAS unsigned char*)args.ws;
#define args A2
#define ws (wsl(args.ws))
#define CTR ((unsigned*)(ws + WS_CTR))
    LAS unsigned char* ldsl = (LAS unsigned char*)lds;

#ifndef PHM
#define PHM 0xffff
#endif
    { volatile LAS unsigned* st0 = (volatile LAS unsigned*)(ldsl + LDS_MISC + 64); if (threadIdx.x < 2) st0[threadIdx.x] = 0u; }
    if (blockIdx.x == 0) { unsigned* bw = (unsigned*)(ws + WS_BAR); for (int i = threadIdx.x; i < XCD_BAR_WORDS; i += NTHR) bw[i] = 0u; }
    __syncthreads();
    p0_prologue(args, lds, wave0);
    grid.sync();
    const XcdBarrier xbar = xcd_barrier_post((unsigned*)(ws + WS_BAR), (volatile LAS unsigned*)(ldsl + LDS_MISC + 64));
#define GRID_SYNC() xcd_barrier(xbar, wave0)
#ifndef TMASK
#define TMASK 0
#endif
    unsigned long long t_acc = 0ull, t_0 = 0ull;
#define T_BEGIN(bit) do { if (TMASK & (bit)) t_0 = __builtin_amdgcn_s_memrealtime(); } while (0)
#define T_END(bit) do { if (TMASK & (bit)) t_acc += __builtin_amdgcn_s_memrealtime() - t_0; } while (0)
    for (int layer = 0; layer < 2; ++layer) {
        const float* xin = (layer == 0) ? args.in[0] : args.out;
        if (PHM & 2) norm_rows<true>(xin, args.in[1] + layer * 1024, (bf16_t*)(ws + WS_H), nullptr, wave0);
        GRID_SYNC();
        for (int g = 0; g < NGRP; ++g) {
            const int pass = layer * NGRP + g;
            T_BEGIN(1);
            if (PHM & 4) { pg8::Gemm gm{(const bf16_t*)(ws + WS_H) + (size_t)g * TG * 1024, (const bf16_t*)(ws + WS_WIN) + (size_t)layer * NP * 1024, TG, NP, 1024, 1024};
              pg8::StaticOrder S; S.init(TG, NP, (int)gridDim.x, lbx());
              pg8::EpiProj E{(bf16_t*)(ws + WS_PROJ), (float*)(ws + WS_SMALL), (const float*)(ws + WS_LAM) + 16 + layer * 32};
              pg8::gemm_phase<pg8::EpiProj, pg8::StaticOrder, true, true>(ldsl, gm, S, E, wave0); }
            if (g > 0 && lbx() >= 128) {
              pg8::Gemm gm{(const bf16_t*)(ws + WS_M16), (const bf16_t*)(ws + WS_WOUT) + (size_t)layer * 1024 * 1024, TG, 1024, 1024, 1024};
              pg8::StaticOrder S; S.init(TG, 1024, (int)gridDim.x, lbx() - 128);
              pg8::EpiRes E{xin + (size_t)(g - 1) * TG * 1024, args.out + (size_t)(g - 1) * TG * 1024};
              pg8::gemm_phase<pg8::EpiRes, pg8::StaticOrder, true, true>(ldsl, gm, S, E, wave0); }
            GRID_SYNC();
            T_END(1); T_BEGIN(2);
#ifndef EXPER
#define EXPER 0
#endif
            if (EXPER == 2) { pg8::Gemm gm{(const bf16_t*)(ws + WS_H) + (size_t)g * TG * 1024, (const bf16_t*)(ws + WS_WIN) + (size_t)layer * NP * 1024, TG, NP, 1024, 1024};
              pg8::StaticOrder S; S.init(TG, NP, (int)gridDim.x, lbx());
              pg8::EpiProj E{(bf16_t*)(ws + WS_PROJ), (float*)(ws + WS_SMALL), (const float*)(ws + WS_LAM) + 16 + layer * 32};
              pg8::gemm_phase<pg8::EpiProj, pg8::StaticOrder, true, true>(ldsl, gm, S, E, wave0); GRID_SYNC(); }
            if (EXPER == 5) { for (int q = 0; q < 10; ++q) GRID_SYNC(); }
            UNIT_LOOP(CTR + (pass * 3 + 0) * 64, 648,
                  if (u < 8) fcum_unit(args, u, wave0);
                  else if (u < 136) rope_unit(args, u - 8, wave0);
                  else ssd_states_unit(args, layer, u - 136, lds, wave0););
            GRID_SYNC();
            T_END(2); T_BEGIN(4);
            UNIT_LOOP(CTR + (pass * 3 + 1) * 64, 1024,
                  if (u < 256) diff_unit(args, layer, u & 31, 7 - (u >> 5), lds, wave0);
                  else if (u < 512) ssd_scan_unit(args, u - 256, wave0);
                  else { const int j = u - 512; fox_unit(args, j & 63, 7 - (j >> 6), lds, wave0); });
            GRID_SYNC();
            T_END(4); T_BEGIN(8);
            { const int n = (lbx() < 128) ? 0 : 2;
              const int ycol = (n == 0) ? C_FQ : C_DQ;
              pg8::Gemm gm{(const bf16_t*)(ws + WS_PROJ) + ycol, (const bf16_t*)(ws + WS_WBR) + (size_t)(layer * 3 + n) * 1024 * 1024, TG, 1024, 1024, LDP};
              pg8::StaticOrder S; S.init(TG, 1024, (int)gridDim.x, lbx() & 127);
              pg8::EpiGate E{(const bf16_t*)(ws + WS_PROJ) + C_MG + n * 1024, (float*)(ws + WS_M32), (bf16_t*)(ws + WS_M16), n};
              pg8::gemm_phase<pg8::EpiGate, pg8::StaticOrder, true, true>(ldsl, gm, S, E, wave0); }
            UNIT_LOOP(CTR + (pass * 3 + 2) * 64, 512, ssd_out_unit(args, layer, u, lds, wave0););
            GRID_SYNC();
            T_END(8); T_BEGIN(16);
            { pg8::Gemm gm{(const bf16_t*)(ws + WS_PROJ) + C_SZ, (const bf16_t*)(ws + WS_WBR) + (size_t)(layer * 3 + 1) * 1024 * 1024, TG, 1024, 1024, LDP};
              pg8::StaticOrder S; S.init(TG, 1024, (int)gridDim.x, lbx());
              pg8::EpiGate E{(const bf16_t*)(ws + WS_PROJ) + C_MG + 1024, (float*)(ws + WS_M32), (bf16_t*)(ws + WS_M16), 1};
              pg8::gemm_phase<pg8::EpiGate, pg8::StaticOrder, true, true>(ldsl, gm, S, E, wave0); }
            GRID_SYNC();
            T_END(16);
        }
        { pg8::Gemm gm{(const bf16_t*)(ws + WS_M16), (const bf16_t*)(ws + WS_WOUT) + (size_t)layer * 1024 * 1024, TG, 1024, 1024, 1024};
          pg8::StaticOrder S; S.init(TG, 1024, (int)gridDim.x, lbx());
          pg8::EpiRes E{xin + (size_t)(NGRP - 1) * TG * 1024, args.out + (size_t)(NGRP - 1) * TG * 1024};
          pg8::gemm_phase<pg8::EpiRes, pg8::StaticOrder, true, true>(ldsl, gm, S, E, wave0); }
        if (TMASK && layer == 1 && blockIdx.x == 0) { const unsigned long long ts = __builtin_amdgcn_s_memrealtime(); while (__builtin_amdgcn_s_memrealtime() - ts < 4ull * t_acc) __builtin_amdgcn_s_sleep(32); }
        GRID_SYNC();
    }
#undef ws
#undef CTR
    if (PHM & 4096) norm_rows<false>(args.out, args.in[14], nullptr, args.out, wave0);
}

#undef args
extern "C" void kernel_launch(void* const* d_in, const int* in_sizes, int n_in, void* d_out, int out_size, void* d_ws, size_t ws_size, hipStream_t stream) {
    static int grid = 0;
    if (grid == 0) {
        if (n_in != 15 || out_size != MT * DM || ws_size < WS_END) { fprintf(stderr, "kernel_launch: unexpected shapes (n_in %d out %d ws %zu need %zu)\n", n_in, out_size, ws_size, (size_t)WS_END); grid = -1; return; }
        int dev = 0, cus = 0, per_cu = 0;
        hipGetDevice(&dev); hipDeviceGetAttribute(&cus, hipDeviceAttributeMultiprocessorCount, dev);
        if (hipFuncSetAttribute((const void*)hybrid_fwd, hipFuncAttributeMaxDynamicSharedMemorySize, LDS_BYTES) != hipSuccess) { fprintf(stderr, "kernel_launch: hipFuncSetAttribute failed\n"); grid = -1; return; }
        if (hipOccupancyMaxActiveBlocksPerMultiprocessor(&per_cu, (const void*)hybrid_fwd, NTHR, LDS_BYTES) != hipSuccess || per_cu < 1) { fprintf(stderr, "kernel_launch: occupancy query gave %d\n", per_cu); per_cu = 1; }
        (void)hipGetLastError();
        grid = cus * 1;
    }
    if (grid < 0) return;
    Args a{};
    for (int i = 0; i < 15; ++i) a.in[i] = (const float*)d_in[i];
    a.out = (float*)d_out; a.ws = (unsigned char*)d_ws;
    void* kargs[] = {&a};
    hipError_t e = hipLaunchCooperativeKernel((const void*)hybrid_fwd, dim3(grid), dim3(NTHR), kargs, LDS_BYTES, stream);
    if (e != hipSuccess) fprintf(stderr, "kernel_launch: cooperative launch failed: %s (grid %d)\n", hipGetErrorString(e), grid);
}
```

```cpp
#include <hip/hip_runtime.h>
#include <hip/hip_cooperative_groups.h>
#include <cstdio>
#include <cstdint>
#include <cstddef>
#include <cmath>
namespace cg = cooperative_groups;
namespace pg8 {
#define PG8_LAS __attribute__((address_space(3)))
typedef unsigned short bf16_t;
typedef short bf16x8 __attribute__((ext_vector_type(8)));
typedef float f32x4 __attribute__((ext_vector_type(4)));
typedef unsigned u32x4 __attribute__((ext_vector_type(4)));
constexpr int BM = 256, BK = 64, HALF = 128, HTB = HALF * BK * 2  , STAGE_BYTES = 8 * HTB, NXCD = 8, WGM = 8;

__host__ __device__ __forceinline__ int lds_byte(int r, int c) { const int st = (r >> 4) * 2 + (c >> 5), rr = r & 15, cc = c & 31, ob = rr * 64 + cc * 2; return st * 1024 + (ob ^ (((ob >> 9) & 1) << 5)); }
__host__ __device__ __forceinline__ void stage_rc(int b, int& R, int& C) { const int st = b / 1024, sb = b % 1024, swz = sb ^ (((sb >> 9) & 1) << 5); R = (st >> 1) * 16 + swz / 64; C = (st & 1) * 32 + (swz % 64) / 2; }
__host__ __device__ __forceinline__ int perm32(int rho) { const int n = rho >> 4, i = rho & 15; return 8 * (i >> 2) + 4 * n + (i & 3); }

struct Unit { int pm, pn; };
struct Gemm { const bf16_t* A; const bf16_t* Bt; int M, N, K, lda; };

struct StaticOrder {
    int nM, nN, nwg, G, c;
    __host__ __device__ void init(int M, int N, int G_, int c_) { nM = M / BM; nN = N / BM; nwg = nM * nN; G = G_; c = c_; }
    __host__ __device__ bool next(int i, Unit& u) const {
        const long L = (long)i * G + c; if (L >= nwg) return false;
        int wgid = (int)L; { const int q = nwg / NXCD, r = nwg % NXCD, xcd = wgid % NXCD, off = wgid / NXCD; wgid = (xcd < r ? xcd * (q + 1) : r * (q + 1) + (xcd - r) * q) + off; }
        const int nig = WGM * nN, gid = wgid / nig, fm = gid * WGM, gsz = (nM - fm) < WGM ? (nM - fm) : WGM;
        u.pm = fm + ((wgid % nig) % gsz); u.pn = (wgid % nig) / gsz; return true;
    }
    __device__ __forceinline__ void a_ready(const Unit&) const {}
    __device__ __forceinline__ void done(const Unit&) const {}
};

__device__ __forceinline__ unsigned cvt_pk_bf16(float lo, float hi) { unsigned r; asm volatile("v_cvt_pk_bf16_f32 %0, %1, %2" : "=v"(r) : "v"(lo), "v"(hi)); return r; }

typedef unsigned u32x2 __attribute__((ext_vector_type(2)));
constexpr int LDP = 14336;
__device__ __forceinline__ float silu_f(float v) { return v * __builtin_amdgcn_rcpf(1.0f + __expf(-v)); }
__device__ __forceinline__ float sigm_f(float v) { return __builtin_amdgcn_rcpf(1.0f + __expf(-v)); }
__device__ __forceinline__ float bflo(unsigned w) { return __uint_as_float(w << 16); }
__device__ __forceinline__ float bfhi(unsigned w) { return __uint_as_float(w & 0xffff0000u); }

struct EpiProj {
    static constexpr bool PERM = true, AFTER_DRAIN = false;
    bf16_t* P; float* small; const float* sbias;
    __device__ __forceinline__ void operator()(const f32x4 (&acc)[2][2][4][2], const Unit& u, int wr, int wc, int fr, int fq) const {
        asm volatile("" : "+v"(fr));
        const int row0 = u.pm * BM + wr * 64 + fr;
        if (u.pn < 56) {
            const int pn = u.pn;
            const int mode = (pn < 12) ? 0 : (pn < 20) ? 1 : (pn < 40) ? 0 : (pn < 44) ? 1 : 2;
            const int col0 = pn * BM + wc * 32 + 8 * fq;
#pragma unroll
            for (int ai = 0; ai < 2; ++ai)
#pragma unroll
                for (int m = 0; m < 4; ++m) { bf16_t* rowp = P + (size_t)(row0 + ai * HALF + m * 16) * LDP + col0;
#pragma unroll
                    for (int bj = 0; bj < 2; ++bj) { f32x4 v0 = acc[ai][bj][m][0], v1 = acc[ai][bj][m][1];
                        if (mode == 1) {
#pragma unroll
                            for (int i = 0; i < 4; ++i) { v0[i] = silu_f(v0[i]); v1[i] = silu_f(v1[i]); } }
                        else if (mode == 2) {
#pragma unroll
                            for (int i = 0; i < 4; ++i) { v0[i] = sigm_f(v0[i]); v1[i] = sigm_f(v1[i]); } }
                        u32x4 w; w.x = cvt_pk_bf16(v0[0], v0[1]); w.y = cvt_pk_bf16(v0[2], v0[3]); w.z = cvt_pk_bf16(v1[0], v1[1]); w.w = cvt_pk_bf16(v1[2], v1[3]);
                        *(u32x4*)(rowp + bj * HALF) = w; } }
        } else if (wc == 0) {
            const float* sbp = sbias; asm volatile("" : "+s"(sbp));
            f32x4 bb[2]; bb[0] = *(const f32x4*)(sbp + 8 * fq); bb[1] = *(const f32x4*)(sbp + 8 * fq + 4);
#pragma unroll
            for (int ai = 0; ai < 2; ++ai)
#pragma unroll
                for (int m = 0; m < 4; ++m) { const int row = row0 + ai * HALF + m * 16;
#pragma unroll
                    for (int n = 0; n < 2; ++n) { f32x4 o;
#pragma unroll
                        for (int i = 0; i < 4; ++i) { const int c = 8 * fq + 4 * n + i; const float v = acc[ai][0][m][n][i];
                            const float xx = v + bb[n][i];
                            const float sp = __logf(1.0f + __expf(-fabsf(xx)));
                            o[i] = (c < 16) ? (fminf(xx, 0.f) - sp) : (fmaxf(xx, 0.f) + sp); }
                        *(f32x4*)(small + (size_t)row * 32 + 8 * fq + 4 * n) = o; } }
        }
    }
};
struct EpiGate {
    static constexpr bool PERM = false, AFTER_DRAIN = false;
    const bf16_t* gate; float* m32; bf16_t* m16; int nidx;
    __device__ __forceinline__ void operator()(const f32x4 (&acc)[2][2][4][2], const Unit& u, int wr, int wc, int fr, int fq) const {
        asm volatile("" : "+v"(fr));
        const int row0 = u.pm * BM + wr * 64 + fr, col0 = u.pn * BM + wc * 32 + 4 * fq;
        u32x2 gw[2][4]; f32x4 mv[2][4]; u32x2 hv[2][4];
#define EG_LOAD(c_, s_) do { const int row_ = row0 + ((c_) >> 2) * HALF + ((c_) & 3) * 16; \
        _Pragma("unroll") for (int e_ = 0; e_ < 4; ++e_) { const int col_ = col0 + (e_ >> 1) * HALF + (e_ & 1) * 16; \
            gw[s_][e_] = *(const u32x2*)(gate + (size_t)row_ * LDP + col_); \
            if (nidx == 1) { mv[s_][e_] = *(const f32x4*)(m32 + (size_t)row_ * 1024 + col_); hv[s_][e_] = *(const u32x2*)(m16 + (size_t)row_ * 1024 + col_); } } } while (0)
        EG_LOAD(0, 0);
#pragma unroll
        for (int c = 0; c < 8; ++c) {
            if (c + 1 < 8) EG_LOAD(c + 1, (c + 1) & 1);
            const int ai = c >> 2, m = c & 3, row = row0 + ai * HALF + m * 16;
#pragma unroll
            for (int e = 0; e < 4; ++e) { const int bj = e >> 1, n = e & 1, col = col0 + bj * HALF + n * 16;
                const u32x2 g2 = gw[c & 1][e];
                f32x4 v = acc[ai][bj][m][n];
                v[0] *= bflo(g2.x); v[1] *= bfhi(g2.x); v[2] *= bflo(g2.y); v[3] *= bfhi(g2.y);
                if (nidx == 0) *(f32x4*)(m32 + (size_t)row * 1024 + col) = v;
                else { if (nidx == 1) { const u32x2 t2 = hv[c & 1][e]; v += mv[c & 1][e]; v[0] += bflo(t2.x); v[1] += bfhi(t2.x); v[2] += bflo(t2.y); v[3] += bfhi(t2.y); }
                    u32x2 w; w.x = cvt_pk_bf16(v[0], v[1]); w.y = cvt_pk_bf16(v[2], v[3]); *(u32x2*)(m16 + (size_t)row * 1024 + col) = w; } }
        }
#undef EG_LOAD
    }
};
struct EpiRes {
    static constexpr bool PERM = false, AFTER_DRAIN = false;
    const float* xin; float* out;
    __device__ __forceinline__ void operator()(const f32x4 (&acc)[2][2][4][2], const Unit& u, int wr, int wc, int fr, int fq) const {
        asm volatile("" : "+v"(fr));
        const int row0 = u.pm * BM + wr * 64 + fr, col0 = u.pn * BM + wc * 32 + 4 * fq;
        f32x4 bx[2][4];
#define ER_LOAD(c_, s_) do { const size_t off_ = (size_t)(row0 + ((c_) >> 2) * HALF + ((c_) & 3) * 16) * 1024 + col0; \
        _Pragma("unroll") for (int e_ = 0; e_ < 4; ++e_) bx[s_][e_] = *(const f32x4*)(xin + off_ + (e_ >> 1) * HALF + (e_ & 1) * 16); } while (0)
        ER_LOAD(0, 0);
#pragma unroll
        for (int c = 0; c < 8; ++c) {
            if (c + 1 < 8) ER_LOAD(c + 1, (c + 1) & 1);
            const int ai = c >> 2, m = c & 3; const size_t off = (size_t)(row0 + ai * HALF + m * 16) * 1024 + col0;
#pragma unroll
            for (int e = 0; e < 4; ++e) { const int bj = e >> 1, n = e & 1; *(f32x4*)(out + off + bj * HALF + n * 16) = bx[c & 1][e] + acc[ai][bj][m][n]; }
        }
#undef ER_LOAD
    }
};
template <class Epi, class Sched, bool ALIGN_EPI = false, bool SP2 = false>
__device__ __forceinline__ void gemm_phase(PG8_LAS unsigned char* lds, const Gemm g, const Sched& S, const Epi& E, int w0) {
    int lane_; asm volatile("v_mbcnt_lo_u32_b32 %0, -1, 0\n\tv_mbcnt_hi_u32_b32 %0, -1, %0" : "=v"(lane_)); int wid = w0; asm volatile("" : "+s"(wid)); const int tid = wid * 64 + lane_, lane = tid & 63, wr = wid >> 2, wc = wid & 3, fr = lane & 15, fq = lane >> 4;
    const int K = g.K, nt = K / BK;
    unsigned voffA[2], voffB[2];
#pragma unroll
    for (int i = 0; i < 2; ++i) { int R, C; stage_rc(tid * 16 + i * 8192, R, C); const int Rb = Epi::PERM ? ((R & ~31) + perm32(R & 31)) : R;
        voffA[i] = (unsigned)(R * g.lda + C) * 2u; voffB[i] = (unsigned)(Rb * K + C) * 2u; }
    const size_t kstep = (size_t)(BK * 2);
    const size_t hstepA = (size_t)HALF * g.lda * 2, hstepB = (size_t)HALF * K * 2;
    const size_t tstepA = 2 * hstepA, tstepB = 2 * hstepB;
    const unsigned ldsw = (unsigned)wid * 1024u;
    const int aoff = lds_byte(wr * 64 + fr, fq * 8), boff = lds_byte(wc * 32 + fr, fq * 8);
#define PG8_SA(b, h) (((b) * 2 + (h)) * HTB)
#define PG8_SB(b, h) ((4 + (b) * 2 + (h)) * HTB)
#define PG8_STAGE(bufoff, gbase, voff) do { _Pragma("unroll") for (int _i = 0; _i < 2; ++_i) \
        __builtin_amdgcn_global_load_lds((const unsigned*)((const char*)(gbase) + (voff)[_i]), (PG8_LAS unsigned*)(lds + (bufoff) + ldsw + _i * 8192), 16, 0, 0); } while (0)
#define PG8_LDA(dst, b, h) do { _Pragma("unroll") for (int m = 0; m < 4; ++m) _Pragma("unroll") for (int k = 0; k < 2; ++k) dst[m][k] = *(const PG8_LAS bf16x8*)(lds + PG8_SA(b, h) + aoff + m * 2048 + k * 1024); } while (0)
#define PG8_LDB(dst, b, h) do { _Pragma("unroll") for (int n = 0; n < 2; ++n) _Pragma("unroll") for (int k = 0; k < 2; ++k) dst[n][k] = *(const PG8_LAS bf16x8*)(lds + PG8_SB(b, h) + boff + n * 2048 + k * 1024); } while (0)
#define PG8_MMA(ai, bj, At, Bt) do { __builtin_amdgcn_s_setprio(1); _Pragma("unroll") for (int m = 0; m < 4; ++m) _Pragma("unroll") for (int n = 0; n < 2; ++n) _Pragma("unroll") for (int k = 0; k < 2; ++k) \
        acc[ai][bj][m][n] = __builtin_amdgcn_mfma_f32_16x16x32_bf16(Bt[n][k], At[m][k], acc[ai][bj][m][n], 0, 0, 0); __builtin_amdgcn_s_setprio(0); } while (0)
#define PG8_WAIT_V(n) asm volatile("s_waitcnt vmcnt(" #n ")" ::: "memory")
#define PG8_WAIT_L(n) asm volatile("s_waitcnt lgkmcnt(" #n ")" ::: "memory")
#define PG8_BAR __builtin_amdgcn_s_barrier()
#define PG8_SCHED __builtin_amdgcn_sched_barrier(0)
    Unit cur, nxt; int ui = 0;
    if (!S.next(0, cur)) return;
    f32x4 acc[2][2][4][2];
#pragma unroll
    for (int a = 0; a < 2; ++a)
#pragma unroll
        for (int b = 0; b < 2; ++b)
#pragma unroll
            for (int m = 0; m < 4; ++m)
#pragma unroll
                for (int n = 0; n < 2; ++n) acc[a][b][m][n] = (f32x4){0.f, 0.f, 0.f, 0.f};
    bf16x8 At[4][2], B0[2][2], B1[2][2];
    const char* cA = (const char*)g.A + (size_t)cur.pm * tstepA; const char* cB = (const char*)g.Bt + (size_t)cur.pn * tstepB;
    S.a_ready(cur);
    if constexpr (SP2) {
        PG8_STAGE(PG8_SB(0, 0), cB, voffB); PG8_STAGE(PG8_SB(0, 1), cB + hstepB, voffB); PG8_STAGE(PG8_SA(0, 0), cA, voffA); PG8_STAGE(PG8_SA(0, 1), cA + hstepA, voffA);
        if (wr == 1) PG8_BAR;
        PG8_WAIT_V(2); PG8_BAR;
        PG8_STAGE(PG8_SB(1, 0), cB + kstep, voffB); PG8_STAGE(PG8_SA(1, 0), cA + kstep, voffA); PG8_STAGE(PG8_SB(1, 1), cB + hstepB + kstep, voffB);
        PG8_WAIT_V(6); PG8_BAR;
    } else {
        PG8_STAGE(PG8_SB(0, 0), cB, voffB); PG8_STAGE(PG8_SA(0, 0), cA, voffA); PG8_STAGE(PG8_SB(0, 1), cB + hstepB, voffB); PG8_STAGE(PG8_SA(0, 1), cA + hstepA, voffA);
        if (wr == 1) PG8_BAR;
        PG8_WAIT_V(4); PG8_BAR;
        PG8_STAGE(PG8_SB(1, 0), cB + kstep, voffB); PG8_STAGE(PG8_SA(1, 0), cA + kstep, voffA); PG8_STAGE(PG8_SB(1, 1), cB + hstepB + kstep, voffB);
        PG8_WAIT_V(6); PG8_BAR;
    }
    for (;;) {
        const bool has_next = S.next(ui + 1, nxt);
        const char* nA = has_next ? (const char*)g.A + (size_t)nxt.pm * tstepA : cA; const char* nB = has_next ? (const char*)g.Bt + (size_t)nxt.pn * tstepB : cB;
        for (int t = 0; t < nt; t += 2) {
            const bool last = (t == nt - 2);
            const char* a1 = cA + (size_t)(t + 1) * kstep;
            const char* a2 = last ? nA : cA + (size_t)(t + 2) * kstep; const char* b2 = last ? nB : cB + (size_t)(t + 2) * kstep;
            const char* a3 = a2 + kstep; const char* b3 = b2 + kstep;
            if (last && has_next) S.a_ready(nxt);
            if constexpr (SP2) {
            PG8_LDB(B0, 0, 0); PG8_LDB(B1, 0, 1); PG8_SCHED; PG8_LDA(At, 0, 0); PG8_STAGE(PG8_SA(1, 1), a1 + hstepA, voffA);
            PG8_WAIT_V(8); PG8_WAIT_L(0); PG8_BAR; PG8_MMA(0, 0, At, B0); PG8_MMA(0, 1, At, B1); PG8_BAR; PG8_SCHED;
            PG8_LDA(At, 0, 1); PG8_STAGE(PG8_SB(0, 0), b2, voffB); PG8_STAGE(PG8_SB(0, 1), b2 + hstepB, voffB); PG8_STAGE(PG8_SA(0, 0), a2, voffA);
            PG8_WAIT_V(8); PG8_WAIT_L(0); PG8_BAR; PG8_MMA(1, 0, At, B0); PG8_MMA(1, 1, At, B1); PG8_BAR; PG8_SCHED;
            PG8_LDB(B0, 1, 0); PG8_LDB(B1, 1, 1); PG8_SCHED; PG8_LDA(At, 1, 0); PG8_STAGE(PG8_SA(0, 1), a2 + hstepA, voffA);
            PG8_WAIT_V(8); PG8_WAIT_L(0); PG8_BAR; PG8_MMA(0, 0, At, B0); PG8_MMA(0, 1, At, B1); PG8_BAR; PG8_SCHED;
            PG8_LDA(At, 1, 1); PG8_STAGE(PG8_SB(1, 0), b3, voffB); PG8_STAGE(PG8_SB(1, 1), b3 + hstepB, voffB); PG8_STAGE(PG8_SA(1, 0), a3, voffA);
            PG8_WAIT_V(8); PG8_WAIT_L(0); PG8_BAR; PG8_MMA(1, 0, At, B0); PG8_MMA(1, 1, At, B1); PG8_BAR; PG8_SCHED;
            } else {
            PG8_LDB(B0, 0, 0); PG8_SCHED; PG8_LDA(At, 0, 0); PG8_STAGE(PG8_SA(1, 1), a1 + hstepA, voffA);
            PG8_WAIT_L(8); PG8_BAR; PG8_WAIT_L(0); PG8_MMA(0, 0, At, B0); PG8_BAR; PG8_SCHED;
            PG8_LDB(B1, 0, 1); PG8_STAGE(PG8_SB(0, 0), b2, voffB);
            PG8_BAR; PG8_WAIT_L(0); PG8_MMA(0, 1, At, B1); PG8_BAR;
            PG8_LDA(At, 0, 1); PG8_STAGE(PG8_SA(0, 0), a2, voffA);
            PG8_BAR; PG8_WAIT_L(0); PG8_MMA(1, 0, At, B0); PG8_BAR; PG8_SCHED;
            PG8_STAGE(PG8_SB(0, 1), b2 + hstepB, voffB);
            PG8_WAIT_V(6); PG8_BAR; PG8_MMA(1, 1, At, B1); PG8_BAR;
            PG8_LDB(B0, 1, 0); PG8_SCHED; PG8_LDA(At, 1, 0); PG8_STAGE(PG8_SA(0, 1), a2 + hstepA, voffA);
            PG8_WAIT_L(8); PG8_BAR; PG8_WAIT_L(0); PG8_MMA(0, 0, At, B0); PG8_BAR; PG8_SCHED;
            PG8_LDB(B1, 1, 1); PG8_STAGE(PG8_SB(1, 0), b3, voffB);
            PG8_BAR; PG8_WAIT_L(0); PG8_MMA(0, 1, At, B1); PG8_BAR;
            PG8_LDA(At, 1, 1); PG8_STAGE(PG8_SA(1, 0), a3, voffA);
            PG8_BAR; PG8_WAIT_L(0); PG8_MMA(1, 0, At, B0); PG8_BAR; PG8_SCHED;
            PG8_STAGE(PG8_SB(1, 1), b3 + hstepB, voffB);
            PG8_WAIT_V(6); PG8_BAR; PG8_MMA(1, 1, At, B1); PG8_BAR;
            }
        }
        if constexpr (ALIGN_EPI) { if (wr == 0) PG8_BAR; }
        if constexpr (!Epi::AFTER_DRAIN) { E(acc, cur, wr, wc, fr, fq); S.done(cur); }
        if (!has_next) break;
#pragma unroll
        for (int a = 0; a < 2; ++a)
#pragma unroll
            for (int b = 0; b < 2; ++b)
#pragma unroll
                for (int m = 0; m < 4; ++m)
#pragma unroll
                    for (int n = 0; n < 2; ++n) acc[a][b][m][n] = (f32x4){0.f, 0.f, 0.f, 0.f};
        cur = nxt; cA = nA; cB = nB; ++ui;
        if constexpr (ALIGN_EPI) { if (wr == 1) PG8_BAR; }
    }
    PG8_WAIT_V(0);
    if constexpr (!ALIGN_EPI) { if (wr == 0) PG8_BAR; }
    PG8_BAR;
    if constexpr (Epi::AFTER_DRAIN) { E.fused(acc, cur, wr, wc, fr, fq, lds, wid, lane); S.done(cur); }
#undef PG8_SA
#undef PG8_SB
#undef PG8_STAGE
#undef PG8_LDA
#undef PG8_LDB
#undef PG8_MMA
#undef PG8_WAIT_V
#undef PG8_WAIT_L
#undef PG8_BAR
#undef PG8_SCHED
}
}

#define LAS __attribute__((address_space(3)))
typedef unsigned short bf16_t;
typedef short bf16x8 __attribute__((ext_vector_type(8)));
typedef short v4i16_t __attribute__((ext_vector_type(4)));
typedef float f32x4 __attribute__((ext_vector_type(4)));
typedef float f32x16 __attribute__((ext_vector_type(16)));
typedef unsigned u32x4 __attribute__((ext_vector_type(4)));
typedef unsigned u32x2 __attribute__((ext_vector_type(2)));
typedef float f32x2 __attribute__((ext_vector_type(2)));

constexpr int DM = 1024, SEQ = 2048, NBATCH = 16, MT = NBATCH * SEQ;
constexpr int GB = 4, TG = GB * SEQ, NGRP = NBATCH / GB;
constexpr int LDP = pg8::LDP, NP = 14592, NIN = 14368;
constexpr int C_FQ = 0, C_FK = 1024, C_FV = 2048, C_FG = 3072, C_SZ = 4096, C_XBC = 5120, C_DQ = 7168, C_DK = 8192, C_DV = 9216, C_DG = 10240, C_MG = 11264;
constexpr float EPS = 1e-6f, LOG2E = 1.4426950408889634f, C2 = 0.125f * 1.4426950408889634f;
constexpr int NTHR = 512, NWAVES = 8;
constexpr int LDS_BYTES = 147456, LDS_MISC = 131072 + 8192;

constexpr size_t WS_CTR = 0, WS_BAR = 32768, WS_ROPE = 65536, WS_LAM = WS_ROPE + 131072, WS_WIN = 1u << 20;
constexpr size_t WS_WBR = WS_WIN + (size_t)2 * NP * 1024 * 2;
constexpr size_t WS_WOUT = WS_WBR + (size_t)6 * 1024 * 1024 * 2;
constexpr size_t WS_H = WS_WOUT + (size_t)2 * 1024 * 1024 * 2;
constexpr size_t WS_PROJ = WS_H + (size_t)MT * 1024 * 2;
constexpr size_t WS_SMALL = WS_PROJ + (size_t)TG * LDP * 2;
constexpr size_t WS_F2 = WS_SMALL + (size_t)TG * 32 * 4;
constexpr size_t WS_CD = WS_F2 + (size_t)GB * 16 * SEQ * 4;
constexpr size_t WS_M32 = WS_CD + 65536;
constexpr size_t WS_M16 = WS_M32 + (size_t)TG * 1024 * 4;
constexpr size_t WS_ST = WS_M16 + (size_t)TG * 1024 * 2;
constexpr size_t WS_PREV = WS_ST + (size_t)GB * 32 * 16 * 8192 * 2;
constexpr size_t WS_END = WS_ST + (size_t)GB * 32 * 16 * 8192 * 4;

struct Args { const float* in[15]; float* out; unsigned char* ws; };

__device__ __forceinline__ unsigned f2bf(float f) { unsigned u = __builtin_bit_cast(unsigned, f); return (u + 0x7fffu + ((u >> 16) & 1u)) >> 16; }
__device__ __forceinline__ unsigned pk2(float lo, float hi) { return pg8::cvt_pk_bf16(lo, hi); }
typedef __bf16 bf16x2_t __attribute__((ext_vector_type(2)));
__device__ __forceinline__ unsigned pk2m(float lo, float hi) { const f32x2 v = {lo, hi}; return __builtin_bit_cast(unsigned, __builtin_convertvector(v, bf16x2_t)); }
__device__ __forceinline__ float bflo(unsigned w) { return __uint_as_float(w << 16); }
__device__ __forceinline__ float bfhi(unsigned w) { return __uint_as_float(w & 0xffff0000u); }
__device__ __forceinline__ float bf1(bf16_t b) { return __uint_as_float(((unsigned)b) << 16); }
__device__ __forceinline__ float lx_xor(float v, int mask, int lane) { return __int_as_float(__builtin_amdgcn_ds_bpermute((lane ^ mask) << 2, __float_as_int(v))); }
__device__ __forceinline__ float lx_up(float v, int d, int lane) { return __int_as_float(__builtin_amdgcn_ds_bpermute((lane - d) << 2, __float_as_int(v))); }
__device__ __forceinline__ float wave_sum(float v, int lane) {
#pragma unroll
    for (int o = 1; o < 64; o <<= 1) v += lx_xor(v, o, lane);
    return v;
}
__device__ __forceinline__ int crow(int r, int hi) { return (r & 3) + 8 * (r >> 2) + 4 * hi; }
#define LDS_WAIT() asm volatile("s_waitcnt lgkmcnt(0)" ::: "memory")
#define THREAD_IDS() int lane; asm volatile("v_mbcnt_lo_u32_b32 %0, -1, 0\n\tv_mbcnt_hi_u32_b32 %0, -1, %0" : "=v"(lane)); int wave = w0; asm volatile("" : "+s"(wave)); const int tid = wave * 64 + lane; (void)tid
#define MFMA32(a, b, c) __builtin_amdgcn_mfma_f32_32x32x16_bf16((a), (b), (c), 0, 0, 0)
#define MFMA16(a, b, c) __builtin_amdgcn_mfma_f32_16x16x32_bf16((a), (b), (c), 0, 0, 0)

__device__ __forceinline__ int lbx() { int b = (int)blockIdx.x; asm volatile("" : "+s"(b)); return b; }
#define GAS __attribute__((address_space(1)))
__device__ __forceinline__ unsigned char* wsl(unsigned char* p) { GAS unsigned char* q = (GAS unsigned char*)p; asm volatile("" : "+s"(q)); return (unsigned char*)q; }
__device__ __forceinline__ int q_draw(unsigned* ctr, int w0) { int v = 0; if (w0 == 0) { int lane; asm volatile("v_mbcnt_lo_u32_b32 %0, -1, 0\n\tv_mbcnt_hi_u32_b32 %0, -1, %0" : "=v"(lane)); if (lane == 0) v = (int)atomicAdd(ctr, 1u); } return v; }
__device__ __forceinline__ int q_pub(int drawn, unsigned char* lds, int w0) {
    volatile int* slot = (volatile int*)(lds + LDS_MISC);
    __syncthreads();
    if (w0 == 0) { int lane; asm volatile("v_mbcnt_lo_u32_b32 %0, -1, 0\n\tv_mbcnt_hi_u32_b32 %0, -1, %0" : "=v"(lane)); if (lane == 0) *slot = drawn; }
    __syncthreads();
    return *slot;
}
#define UNIT_LOOP(ctr_, total_, body_) do { unsigned* c__ = (ctr_); \
    for (;;) { const int d__ = q_draw(c__, wave0); const int u = q_pub(d__, lds, wave0); if (u >= (total_)) break; body_ } } while (0)

__device__ __forceinline__ int win_src_col(int n) {
    if (n < 3072) return n;
    if (n < 7168) return n + 16;
    if (n < 14336) return n + 32;
    if (n < 14352) return 3072 + (n - 14336);
    if (n < 14368) return 7184 + (n - 14352);
    return -1;
}
template <bool MAP> __device__ __forceinline__ void transpose_item(const float* W, int K, int Nsrc, bf16_t* WT, float* scr, int kb, int nb, int lane) {
    const int k0 = 64 * kb, n0 = 32 * nb;
    const int nn = n0 + (lane & 31); const int src = MAP ? win_src_col(nn) : nn;
#pragma unroll
    for (int i = 0; i < 32; ++i) { const int kk = 2 * i + (lane >> 5); scr[kk * 33 + (lane & 31)] = (src >= 0) ? W[(size_t)(k0 + kk) * Nsrc + src] : 0.f; }
    LDS_WAIT();
    const int c = lane & 7;
#pragma unroll
    for (int j = 0; j < 4; ++j) { const int n = (lane >> 3) + 8 * j; const float* s = scr + (8 * c) * 33 + n;
        u32x4 o; o.x = pk2(s[0 * 33], s[1 * 33]); o.y = pk2(s[2 * 33], s[3 * 33]); o.z = pk2(s[4 * 33], s[5 * 33]); o.w = pk2(s[6 * 33], s[7 * 33]);
        *(u32x4*)(WT + (size_t)(n0 + n) * K + k0 + 8 * c) = o; }
    LDS_WAIT();
}
__device__ __forceinline__ void p0_prologue(const Args& a, unsigned char* lds, int w0) {
    THREAD_IDS();
    unsigned char* ws = wsl(a.ws);
    float* scr = (float*)(lds + wave * 8448);
    const int gw = blockIdx.x * NWAVES + wave, NGW = gridDim.x * NWAVES;
    constexpr int I_IN = 16 * (NP / 32), I_SQ = 16 * 32;
    constexpr int NITEMS = 2 * I_IN + 8 * I_SQ;
    for (int it = gw; it < NITEMS; it += NGW) {
        int r = it;
        if (r < 2 * I_IN) { const int layer = r / I_IN; r -= layer * I_IN;
            transpose_item<true>(a.in[2] + (size_t)layer * 1024 * NIN, 1024, NIN, (bf16_t*)(ws + WS_WIN) + (size_t)layer * NP * 1024, scr, r / (NP / 32), r % (NP / 32), lane); continue; }
        r -= 2 * I_IN;
        if (r < 6 * I_SQ) { const int mi = r / I_SQ; r -= mi * I_SQ;
            transpose_item<false>(a.in[12] + (size_t)mi * 1024 * 1024, 1024, 1024, (bf16_t*)(ws + WS_WBR) + (size_t)mi * 1024 * 1024, scr, r / 32, r % 32, lane); continue; }
        r -= 6 * I_SQ;
        { const int mi = r / I_SQ; r -= mi * I_SQ;
            transpose_item<false>(a.in[13] + (size_t)mi * 1024 * 1024, 1024, 1024, (bf16_t*)(ws + WS_WOUT) + (size_t)mi * 1024 * 1024, scr, r / 32, r % 32, lane); }
    }
    for (int idx = blockIdx.x * NTHR + tid; idx < SEQ * 8; idx += gridDim.x * NTHR) {
        const int pos = idx >> 3, i = idx & 7;
        const float inv = powf(500000.0f, -(float)(2 * i) / 16.0f);
        const float ang = (float)pos * inv;
        ((f32x2*)(ws + WS_ROPE))[idx] = (f32x2){cosf(ang), sinf(ang)};
    }
    if (blockIdx.x == 0) {
        if (tid < 128) ((unsigned*)(ws + WS_CTR))[tid * 64] = 0u;
        if (tid >= 128 && tid < 192) { const int k = tid - 128, layer = k >> 5, c = k & 31;
            ((float*)(ws + WS_LAM))[16 + k] = (c < 16) ? a.in[3][layer * 16 + c] : a.in[6][layer * 16 + c - 16]; }
        if (tid >= 64 && tid < 66) { const int layer = tid - 64; const float* lp = a.in[10] + layer * 256;
            float s1 = 0.f, s2 = 0.f;
            for (int d = 0; d < 64; ++d) { s1 += lp[d] * lp[64 + d]; s2 += lp[128 + d] * lp[192 + d]; }
            const float li = 0.8f - 0.6f * expf(-0.3f * (float)layer);
            ((float*)(ws + WS_LAM))[layer * 2] = expf(s1) - expf(s2) + li; ((float*)(ws + WS_LAM))[layer * 2 + 1] = li; }
    }
}
template <bool TOBF> __device__ __forceinline__ void norm_rows(const float* X, const float* w, bf16_t* ob, float* of, int w0, int r0 = 0, int r1 = MT, int vb = -1, int nvb = 0) {
    THREAD_IDS();
    if (vb < 0) { vb = (int)blockIdx.x; nvb = (int)gridDim.x; }
    const int gw = vb * NWAVES + wave, NGW = nvb * NWAVES;
    f32x4 wv[4];
#pragma unroll
    for (int j = 0; j < 4; ++j) wv[j] = ((const f32x4*)w)[64 * j + lane];
    for (int m = r0 + gw; m < r1; m += 2 * NGW) {
        const int m2 = m + NGW;
        const f32x4* xr = (const f32x4*)(X + (size_t)m * DM) + lane; const f32x4* xr2 = (const f32x4*)(X + (size_t)m2 * DM) + lane;
        f32x4 v[4], v2[4]; float s = 0.f, s2 = 0.f;
#pragma unroll
        for (int j = 0; j < 4; ++j) { v[j] = xr[64 * j]; v2[j] = xr2[64 * j]; }
#pragma unroll
        for (int j = 0; j < 4; ++j) { s += (v[j].x * v[j].x + v[j].y * v[j].y) + (v[j].z * v[j].z + v[j].w * v[j].w); s2 += (v2[j].x * v2[j].x + v2[j].y * v2[j].y) + (v2[j].z * v2[j].z + v2[j].w * v2[j].w); }
        const float rs = rsqrtf(wave_sum(s, lane) * (1.0f / DM) + EPS), rs2 = rsqrtf(wave_sum(s2, lane) * (1.0f / DM) + EPS);
#pragma unroll
        for (int j = 0; j < 4; ++j) { const f32x4 o = v[j] * rs * wv[j], o2 = v2[j] * rs2 * wv[j];
            if (TOBF) { u32x2 p; p.x = pk2(o.x, o.y); p.y = pk2(o.z, o.w); ((u32x2*)(ob + (size_t)m * DM))[64 * j + lane] = p;
                        u32x2 q; q.x = pk2(o2.x, o2.y); q.y = pk2(o2.z, o2.w); ((u32x2*)(ob + (size_t)m2 * DM))[64 * j + lane] = q; }
            else { ((f32x4*)(of + (size_t)m * DM))[64 * j + lane] = o; ((f32x4*)(of + (size_t)m2 * DM))[64 * j + lane] = o2; } }
    }
}

constexpr int SL_ACS = 0, SL_DT = 1024, SL_PART = 2048, SL_XT = 4096, SL_B = SL_XT + 256 * 144, SL_C = SL_B + 18432;
constexpr int XTP = 144, BNP = 272;

__device__ __forceinline__ void ssd_acs(unsigned char* lds, const float* small, size_t row0, int g, const float* a_log, int wave, int lane) {
    if (wave < 4) {
        const int h = 4 * g + wave;
        const float dt = small[(row0 + lane) * 32 + 16 + h];
        float v = -expf(a_log[h]) * dt;
#pragma unroll
        for (int o = 1; o < 64; o <<= 1) { const float t = lx_up(v, o, lane); if (lane >= o) v += t; }
        ((float*)(lds + SL_ACS))[wave * 64 + lane] = v;
        ((float*)(lds + SL_DT))[wave * 64 + lane] = dt;
    }
}
__device__ __forceinline__ void conv8x8(float (&out)[8][8], const bf16_t* xb, int pg, int c, const float* cw, const float* cb) {
    u32x4 raw[11];
#pragma unroll
    for (int i = 0; i < 11; ++i) { const int rr = pg * 8 - 3 + i;
        if (rr >= 0 || c > 0) raw[i] = *(const u32x4*)(xb + (ptrdiff_t)rr * LDP); else raw[i] = (u32x4){0u, 0u, 0u, 0u}; }
    float w[4][8], bias[8];
#pragma unroll
    for (int k = 0; k < 4; ++k) { const f32x4 a = *(const f32x4*)(cw + k * 2048), b = *(const f32x4*)(cw + k * 2048 + 4);
        w[k][0] = a.x; w[k][1] = a.y; w[k][2] = a.z; w[k][3] = a.w; w[k][4] = b.x; w[k][5] = b.y; w[k][6] = b.z; w[k][7] = b.w; }
    { const f32x4 a = *(const f32x4*)cb, b = *(const f32x4*)(cb + 4); bias[0] = a.x; bias[1] = a.y; bias[2] = a.z; bias[3] = a.w; bias[4] = b.x; bias[5] = b.y; bias[6] = b.z; bias[7] = b.w; }
#pragma unroll
    for (int p = 0; p < 8; ++p) {
#pragma unroll
        for (int ch = 0; ch < 8; ++ch) { float s = bias[ch];
#pragma unroll
            for (int k = 0; k < 4; ++k) { const unsigned wd = raw[p + k][ch >> 1]; const float u = (ch & 1) ? bfhi(wd) : bflo(wd); s += w[k][ch] * u; }
            out[p][ch] = pg8::silu_f(s); }
    }
}
__device__ __forceinline__ void put_T(unsigned char* img, int chrow0, int s0, const float (&v)[8][8]) {
#pragma unroll
    for (int ch = 0; ch < 8; ++ch) { u32x4 o; o.x = pk2(v[0][ch], v[1][ch]); o.y = pk2(v[2][ch], v[3][ch]); o.z = pk2(v[4][ch], v[5][ch]); o.w = pk2(v[6][ch], v[7][ch]);
        *(u32x4*)(img + (chrow0 + ch) * XTP + s0 * 2) = o; }
}
__device__ __forceinline__ void put_N(unsigned char* img, int n0, int s0, const float (&v)[8][8]) {
#pragma unroll
    for (int p = 0; p < 8; ++p) { u32x4 o; o.x = pk2(v[p][0], v[p][1]); o.y = pk2(v[p][2], v[p][3]); o.z = pk2(v[p][4], v[p][5]); o.w = pk2(v[p][6], v[p][7]);
        *(u32x4*)(img + (s0 + p) * BNP + n0 * 2) = o; }
}

__device__ __forceinline__ void ssd_states_unit(const Args& a, int layer, int u, unsigned char* lds, int w0) {
    THREAD_IDS();
    const int g = u & 3, c = (u >> 2) & 31, bl = u >> 7;
    unsigned char* ws = wsl(a.ws);
    const bf16_t* PROJ = (const bf16_t*)(ws + WS_PROJ);
    const size_t row0 = (size_t)bl * SEQ + c * 64;
    ssd_acs(lds, (const float*)(ws + WS_SMALL), row0, g, a.in[7] + layer * 16, wave, lane);
    __syncthreads();
    const float* ACS = (const float*)(lds + SL_ACS); const float* DTL = (const float*)(lds + SL_DT);
    const int cgi = tid & 63, pg = tid >> 6;
    if (cgi < 48) {
        const int chx = (cgi < 32) ? (g * 256 + cgi * 8) : (1024 + g * 128 + (cgi - 32) * 8);
        float v[8][8];
        conv8x8(v, PROJ + row0 * LDP + C_XBC + chx, pg, c, a.in[4] + (size_t)layer * 4 * 2048 + chx, a.in[5] + layer * 2048 + chx);
        if (cgi < 32) { const int hh = cgi >> 3; const float al = ACS[hh * 64 + 63];
#pragma unroll
            for (int p = 0; p < 8; ++p) { const int s = pg * 8 + p; const float sc = __expf(al - ACS[hh * 64 + s]) * DTL[hh * 64 + s];
#pragma unroll
                for (int ch = 0; ch < 8; ++ch) v[p][ch] *= sc; }
            put_T(lds + SL_XT, cgi * 8, pg * 8, v);
        } else put_T(lds + SL_B, (cgi - 32) * 8, pg * 8, v);
    }
    __syncthreads();
    const int fr = lane & 15, fq = lane >> 4, hh = wave >> 1, nh = wave & 1;
    f32x4 acc[4][4];
#pragma unroll
    for (int i = 0; i < 4; ++i)
#pragma unroll
        for (int j = 0; j < 4; ++j) acc[i][j] = (f32x4){0.f, 0.f, 0.f, 0.f};
    {   bf16x8 af[2][4], bf[2][4];
#pragma unroll
        for (int ks = 0; ks < 2; ++ks) {
#pragma unroll
            for (int i = 0; i < 4; ++i) af[ks][i] = *(const bf16x8*)(lds + SL_B + (64 * nh + 16 * i + fr) * XTP + (32 * ks + 8 * fq) * 2);
#pragma unroll
            for (int j = 0; j < 4; ++j) bf[ks][j] = *(const bf16x8*)(lds + SL_XT + (hh * 64 + 16 * j + fr) * XTP + (32 * ks + 8 * fq) * 2); }
        __builtin_amdgcn_sched_barrier(0);
#pragma unroll
        for (int ks = 0; ks < 2; ++ks)
#pragma unroll
            for (int i = 0; i < 4; ++i)
#pragma unroll
                for (int j = 0; j < 4; ++j) acc[i][j] = MFMA16(af[ks][i], bf[ks][j], acc[i][j]);
    }
    const int h = 4 * g + hh;
    bf16_t* ST = (bf16_t*)(ws + WS_ST) + ((size_t)(bl * 32 + c) * 16 + h) * 8192;
#pragma unroll
    for (int i = 0; i < 4; ++i)
#pragma unroll
        for (int j = 0; j < 4; ++j) { u32x2 w; w.x = pk2m(acc[i][j][0], acc[i][j][1]); w.y = pk2m(acc[i][j][2], acc[i][j][3]);
            *(u32x2*)(ST + (16 * j + fr) * 128 + 64 * nh + 16 * i + 4 * fq) = w; }
    if (tid < 4) ((float*)(ws + WS_CD))[(bl * 32 + c) * 16 + 4 * g + tid] = __expf(ACS[tid * 64 + 63]);
}

__device__ __forceinline__ void ssd_scan_unit(const Args& a, int u, int w0) {
    THREAD_IDS();
    const int qt = u & 3, h = (u >> 2) & 15, bl = u >> 6;
    const bf16_t* ST = (const bf16_t*)(wsl(a.ws) + WS_ST); bf16_t* PV = (bf16_t*)(wsl(a.ws) + WS_PREV); const float* CD = (const float*)(wsl(a.ws) + WS_CD);
    const int e = qt * 2048 + tid * 4;
    float z0 = 0.f; asm volatile("" : "+v"(z0));
    f32x4 hc = (f32x4){z0, z0, z0, z0};
#pragma unroll 1
    for (int c0 = 0; c0 < 32; c0 += 16) {
        u32x2 sv[16]; float dcv[16];
#pragma unroll
        for (int c = 0; c < 16; ++c) { sv[c] = *(const u32x2*)(ST + ((size_t)(bl * 32 + c0 + c) * 16 + h) * 8192 + e); dcv[c] = CD[(bl * 32 + c0 + c) * 16 + h]; }
#pragma unroll
        for (int c = 0; c < 16; ++c) { const float dec = dcv[c];
            u32x2 w; w.x = pk2(hc[0], hc[1]); w.y = pk2(hc[2], hc[3]);
            *(u32x2*)(PV + ((size_t)(bl * 32 + c0 + c) * 16 + h) * 8192 + e) = w;
            hc = hc * dec + (f32x4){bflo(sv[c].x), bfhi(sv[c].x), bflo(sv[c].y), bfhi(sv[c].y)}; }
    }
}

__device__ __forceinline__ void ssd_out_unit(const Args& a, int layer, int u, unsigned char* lds, int w0, bool dry = false) {
    THREAD_IDS();
    const int g = u & 3, c = (u >> 2) & 31, bl = u >> 7;
    unsigned char* ws = wsl(a.ws);
    bf16_t* PROJ = (bf16_t*)(ws + WS_PROJ);
    const size_t row0 = (size_t)bl * SEQ + c * 64;
    ssd_acs(lds, (const float*)(ws + WS_SMALL), row0, g, a.in[7] + layer * 16, wave, lane);
    const int cgi = tid & 63, pg = tid >> 6;
    {
        const int chx = (cgi < 32) ? (g * 256 + cgi * 8) : (cgi < 48) ? (1024 + g * 128 + (cgi - 32) * 8) : (1536 + g * 128 + (cgi - 48) * 8);
        float v[8][8];
        conv8x8(v, PROJ + row0 * LDP + C_XBC + chx, pg, c, a.in[4] + (size_t)layer * 4 * 2048 + chx, a.in[5] + layer * 2048 + chx);
        if (cgi < 32) put_T(lds + SL_XT, cgi * 8, pg * 8, v);
        else if (cgi < 48) put_N(lds + SL_B, (cgi - 32) * 8, pg * 8, v);
        else put_N(lds + SL_C, (cgi - 48) * 8, pg * 8, v);
    }
    const int fr = lane & 15, fq = lane >> 4, hh = wave >> 1, lh = wave & 1, h = 4 * g + hh;
    const bf16_t* PV = (const bf16_t*)(ws + WS_PREV) + ((size_t)(bl * 32 + c) * 16 + h) * 8192;
    u32x2 zws[2][4]; f32x4 nwv[4];
#pragma unroll
    for (int lt = 0; lt < 2; ++lt)
#pragma unroll
        for (int pt = 0; pt < 4; ++pt) zws[lt][pt] = *(const u32x2*)(PROJ + (row0 + 32 * lh + 16 * lt + fr) * LDP + C_SZ + h * 64 + 16 * pt + 4 * fq);
#pragma unroll
    for (int pt = 0; pt < 4; ++pt) nwv[pt] = *(const f32x4*)(a.in[9] + layer * 1024 + h * 64 + 16 * pt + 4 * fq);
    bf16x8 pa[4][4];
#pragma unroll
    for (int ks = 0; ks < 4; ++ks)
#pragma unroll
        for (int pt = 0; pt < 4; ++pt) pa[ks][pt] = *(const bf16x8*)(PV + (16 * pt + fr) * 128 + 32 * ks + 8 * fq);
    __syncthreads();
    const float* ACS = (const float*)(lds + SL_ACS); const float* DTL = (const float*)(lds + SL_DT);
    f32x4 acc[4][2], dd[4][2];
#pragma unroll
    for (int i = 0; i < 4; ++i)
#pragma unroll
        for (int j = 0; j < 2; ++j) { acc[i][j] = (f32x4){0.f, 0.f, 0.f, 0.f}; dd[i][j] = (f32x4){0.f, 0.f, 0.f, 0.f}; }
    bf16x8 cf[4][2];
#pragma unroll
    for (int ks = 0; ks < 4; ++ks)
#pragma unroll
        for (int lt = 0; lt < 2; ++lt) cf[ks][lt] = *(const bf16x8*)(lds + SL_C + (32 * lh + 16 * lt + fr) * BNP + (32 * ks + 8 * fq) * 2);
    __builtin_amdgcn_sched_barrier(0);
#pragma unroll
    for (int ks = 0; ks < 4; ++ks)
#pragma unroll
        for (int pt = 0; pt < 4; ++pt)
#pragma unroll
            for (int lt = 0; lt < 2; ++lt) acc[pt][lt] = MFMA16(pa[ks][pt], cf[ks][lt], acc[pt][lt]);
    __builtin_amdgcn_sched_barrier(0);
    {   bf16x8 bq[4][4];
#pragma unroll
        for (int ks = 0; ks < 4; ++ks)
#pragma unroll
            for (int st = 0; st < 4; ++st) if (st < 2 || lh) bq[ks][st] = *(const bf16x8*)(lds + SL_B + (16 * st + fr) * BNP + (32 * ks + 8 * fq) * 2);
        __builtin_amdgcn_sched_barrier(0);
#pragma unroll
        for (int ks = 0; ks < 4; ++ks)
#pragma unroll
            for (int st = 0; st < 4; ++st) if (st < 2 || lh) {
#pragma unroll
                for (int lt = 0; lt < 2; ++lt) dd[st][lt] = MFMA16(bq[ks][st], cf[ks][lt], dd[st][lt]); }
    }
    float acl[2];
#pragma unroll
    for (int lt = 0; lt < 2; ++lt) { acl[lt] = ACS[hh * 64 + 32 * lh + 16 * lt + fr]; const float e = __expf(acl[lt]);
#pragma unroll
        for (int pt = 0; pt < 4; ++pt) acc[pt][lt] *= e; }
#pragma unroll
    for (int st = 0; st < 4; ++st) if (st < 2 || lh) {
#pragma unroll
        for (int r = 0; r < 4; ++r) { const int s = 16 * st + 4 * fq + r; const float as = ACS[hh * 64 + s], ds = DTL[hh * 64 + s];
#pragma unroll
            for (int lt = 0; lt < 2; ++lt) { const int l = 32 * lh + 16 * lt + fr; dd[st][lt][r] = (s <= l) ? dd[st][lt][r] * __expf(acl[lt] - as) * ds : 0.f; } }
    }
#pragma unroll
    for (int kk = 0; kk < 2; ++kk) if (kk == 0 || lh) {
        bf16x8 mb[2];
#pragma unroll
        for (int lt = 0; lt < 2; ++lt) { u32x4 w; w.x = pk2(dd[2 * kk][lt][0], dd[2 * kk][lt][1]); w.y = pk2(dd[2 * kk][lt][2], dd[2 * kk][lt][3]);
            w.z = pk2(dd[2 * kk + 1][lt][0], dd[2 * kk + 1][lt][1]); w.w = pk2(dd[2 * kk + 1][lt][2], dd[2 * kk + 1][lt][3]); mb[lt] = __builtin_bit_cast(bf16x8, w); }
#pragma unroll
        for (int pt = 0; pt < 4; ++pt) { const unsigned char* xr = lds + SL_XT + (hh * 64 + 16 * pt + fr) * XTP + (32 * kk + 4 * fq) * 2;
            const u32x2 lo = *(const u32x2*)xr, hi2 = *(const u32x2*)(xr + 32);
            const bf16x8 af = __builtin_bit_cast(bf16x8, (u32x4){lo.x, lo.y, hi2.x, hi2.y});
#pragma unroll
            for (int lt = 0; lt < 2; ++lt) acc[pt][lt] = MFMA16(af, mb[lt], acc[pt][lt]); }
    }
    const float dsk = a.in[8][layer * 16 + h];
    float ss[2] = {0.f, 0.f};
#pragma unroll
    for (int lt = 0; lt < 2; ++lt) { const int l = 32 * lh + 16 * lt + fr;
#pragma unroll
        for (int pt = 0; pt < 4; ++pt) { const int p4 = 16 * pt + 4 * fq;
            const u32x2 zw = zws[lt][pt];
            const float zz[4] = {bflo(zw.x), bfhi(zw.x), bflo(zw.y), bfhi(zw.y)};
#pragma unroll
            for (int r = 0; r < 4; ++r) { const float xv = bf1(*(const bf16_t*)(lds + SL_XT + (hh * 64 + p4 + r) * XTP + l * 2));
                const float y = (acc[pt][lt][r] + xv * dsk) * zz[r]; acc[pt][lt][r] = y; ss[lt] += y * y; } } }
#pragma unroll
    for (int lt = 0; lt < 2; ++lt) { ss[lt] += lx_xor(ss[lt], 16, lane); ss[lt] += lx_xor(ss[lt], 32, lane);
        if (fq == 0) ((float*)(lds + SL_PART))[hh * 64 + 32 * lh + 16 * lt + fr] = ss[lt]; }
    __syncthreads();
    const float* nw = a.in[9] + layer * 1024 + h * 64;
#pragma unroll
    for (int lt = 0; lt < 2; ++lt) { const int l = 32 * lh + 16 * lt + fr; const float* pr = (const float*)(lds + SL_PART);
        const float tot = (pr[l] + pr[64 + l]) + (pr[128 + l] + pr[192 + l]);
        const float rs = rsqrtf(tot * (1.0f / 256.0f) + EPS);
#pragma unroll
        for (int pt = 0; pt < 4; ++pt) { const int p4 = 16 * pt + 4 * fq; const f32x4 wv = nwv[pt];
            u32x2 o; o.x = pk2(acc[pt][lt][0] * rs * wv.x, acc[pt][lt][1] * rs * wv.y); o.y = pk2(acc[pt][lt][2] * rs * wv.z, acc[pt][lt][3] * rs * wv.w);
            if (dry) *(u32x2*)((bf16_t*)(ws + WS_M16) + (row0 + l) * 1024 + h * 64 + p4) = o; else *(u32x2*)(PROJ + (row0 + l) * LDP + C_SZ + h * 64 + p4) = o; } }
}

__device__ __forceinline__ void fcum_unit(const Args& a, int fu, int w0) {
    THREAD_IDS();
    const int task = fu * 8 + wave, bl = task >> 4, h = task & 15;
    const float* sm = (const float*)(wsl(a.ws) + WS_SMALL) + ((size_t)bl * SEQ + lane * 32) * 32 + h;
    float v[32]; float run = 0.f;
#pragma unroll
    for (int i = 0; i < 32; ++i) { run += sm[i * 32]; v[i] = run; }
    float sc = run;
#pragma unroll
    for (int o = 1; o < 64; o <<= 1) { const float t = lx_up(sc, o, lane); if (lane >= o) sc += t; }
    const float off = sc - run;
    float* F = (float*)(wsl(a.ws) + WS_F2) + (size_t)task * SEQ + lane * 32;
#pragma unroll
    for (int i = 0; i < 32; i += 4) *(f32x4*)(F + i) = (f32x4){(off + v[i]) * LOG2E, (off + v[i + 1]) * LOG2E, (off + v[i + 2]) * LOG2E, (off + v[i + 3]) * LOG2E};
}
__device__ __forceinline__ void rope_unit(const Args& a, int ru, int w0) {
    THREAD_IDS();
    const int row = ru * 64 + (tid >> 3), j = tid & 7, pos = row & (SEQ - 1);
    bf16_t* PROJ = (bf16_t*)(wsl(a.ws) + WS_PROJ);
    const f32x2* cs = (const f32x2*)(wsl(a.ws) + WS_ROPE) + pos * 8;
    f32x2 t[8];
#pragma unroll
    for (int i = 0; i < 8; ++i) t[i] = cs[i];
#pragma unroll
    for (int k = 0; k < 4; ++k) { const int hc = 4 * j + k; const int col = (hc < 16) ? (C_DQ + hc * 64) : (C_DK + (hc - 16) * 64);
        u32x4* p = (u32x4*)(PROJ + (size_t)row * LDP + col);
        const u32x4 a1 = p[0], a2 = p[1]; u32x4 o1, o2;
#pragma unroll
        for (int w = 0; w < 4; ++w) {
            const float x1l = bflo(a1[w]), x1h = bfhi(a1[w]), x2l = bflo(a2[w]), x2h = bfhi(a2[w]);
            const f32x2 c0 = t[2 * w], c1 = t[2 * w + 1];
            o1[w] = pk2(x1l * c0.x - x2l * c0.y, x1h * c1.x - x2h * c1.y);
            o2[w] = pk2(x2l * c0.x + x1l * c0.y, x2h * c1.x + x1h * c1.y); }
        p[0] = o1; p[1] = o2; }
}

__device__ __forceinline__ v4i16_t vtr(const unsigned char* p) { return __builtin_amdgcn_ds_read_tr16_b64_v4i16((LAS v4i16_t*)(LAS unsigned char*)p); }
__device__ __forceinline__ float max3f(float a, float b, float c) { float r; asm("v_max3_f32 %0, %1, %2, %3" : "=v"(r) : "v"(a), "v"(b), "v"(c)); return r; }
template <int DV, bool FOX>
__device__ __forceinline__ void attn_pass(f32x16 (&o)[DV / 32], float& l_out, const bf16_t* Qw, const bf16_t* Kb, const bf16_t* Vb, const float* F2,
                                          int q0, unsigned char* lds, int w0) {
    THREAD_IDS(); const int wid = wave;
    constexpr int KP = 144, VP = DV * 2 + 64, OFF_K = 0, OFF_V = 64 * KP, OFF_F = OFF_V + 64 * VP, STAGE = OFF_F + 256, NV = DV / 64;
    const int r32 = lane & 31, hi = lane >> 5;
    const int NT = (q0 + 256) / 64, my_nt = (q0 + 32 * wid) / 64 + 1;
    bf16x8 qf[4];
#pragma unroll
    for (int d0 = 0; d0 < 4; ++d0) qf[d0] = *(const bf16x8*)(Qw + (size_t)r32 * LDP + d0 * 16 + hi * 8);
    float m = -INFINITY, l = 0.f;
#pragma unroll
    for (int i = 0; i < DV / 32; ++i)
#pragma unroll
        for (int r = 0; r < 16; ++r) o[i][r] = 0.f;
    u32x4 kreg, vreg[NV]; float freg = 0.f;
    const int krow = tid >> 3, kch = tid & 7;
#define ATT_LOAD(t) do { kreg = *(const u32x4*)(Kb + (size_t)(64 * (t) + krow) * LDP + kch * 8); \
        _Pragma("unroll") for (int i_ = 0; i_ < NV; ++i_) { const int idx_ = tid + 512 * i_; const int vr_ = (DV == 64) ? (idx_ >> 3) : (idx_ >> 4), vc_ = (DV == 64) ? (idx_ & 7) : (idx_ & 15); \
            vreg[i_] = *(const u32x4*)(Vb + (size_t)(64 * (t) + vr_) * LDP + vc_ * 8); } \
        if (FOX && tid < 64) freg = -F2[64 * (t) + tid]; } while (0)
#define ATT_STORE(sb_) do { *(u32x4*)((sb_) + OFF_K + krow * KP + kch * 16) = kreg; \
        _Pragma("unroll") for (int i_ = 0; i_ < NV; ++i_) { const int idx_ = tid + 512 * i_; const int vr_ = (DV == 64) ? (idx_ >> 3) : (idx_ >> 4), vc_ = (DV == 64) ? (idx_ & 7) : (idx_ & 15); \
            *(u32x4*)((sb_) + OFF_V + vr_ * VP + vc_ * 16) = vreg[i_]; } \
        if (FOX && tid < 64) ((float*)((sb_) + OFF_F))[tid] = freg; } while (0)
    __syncthreads();
    ATT_LOAD(0); ATT_STORE(lds);
    if (NT > 1) ATT_LOAD(1);
    __syncthreads();
    for (int t = 0; t < NT; ++t) {
        const unsigned char* sb = lds + (t & 1) * STAGE;
        if (t < my_nt) {
            bf16x8 kf[8];
#pragma unroll
            for (int d0 = 0; d0 < 4; ++d0) { kf[2 * d0] = *(const bf16x8*)(sb + OFF_K + r32 * KP + d0 * 32 + hi * 16);
                kf[2 * d0 + 1] = *(const bf16x8*)(sb + OFF_K + (32 + r32) * KP + d0 * 32 + hi * 16); }
            const unsigned char* vb = sb + OFF_V + (4 * hi + ((lane & 15) >> 2)) * VP + (16 * ((lane >> 4) & 1) + 4 * (lane & 3)) * 2;
            f32x4 fka[4], fkb[4];
            if (FOX) { const float* fk = (const float*)(sb + OFF_F);
#pragma unroll
                for (int g4 = 0; g4 < 4; ++g4) { fka[g4] = *(const f32x4*)(fk + 8 * g4 + 4 * hi); fkb[g4] = *(const f32x4*)(fk + 32 + 8 * g4 + 4 * hi); } }
            v4i16_t vs[2][DV / 32][2];
#pragma unroll
            for (int dvt = 0; dvt < DV / 32; ++dvt) { vs[0][dvt][0] = vtr(vb + dvt * 64); vs[0][dvt][1] = vtr(vb + 8 * VP + dvt * 64); }
            __builtin_amdgcn_sched_barrier(0);
            f32x16 p0, p1;
#pragma unroll
            for (int r = 0; r < 16; ++r) { p0[r] = 0.f; p1[r] = 0.f; }
#pragma unroll
            for (int d0 = 0; d0 < 4; ++d0) { p0 = MFMA32(kf[2 * d0], qf[d0], p0); p1 = MFMA32(kf[2 * d0 + 1], qf[d0], p1); }
            if (FOX) {
#pragma unroll
                for (int g4 = 0; g4 < 4; ++g4) { const f32x4 fa = fka[g4], fb = fkb[g4];
#pragma unroll
                    for (int i = 0; i < 4; ++i) { p0[4 * g4 + i] = p0[4 * g4 + i] * C2 + fa[i]; p1[4 * g4 + i] = p1[4 * g4 + i] * C2 + fb[i]; } }
                if (t == my_nt - 1) { const int qpos = q0 + 32 * wid + r32;
#pragma unroll
                    for (int r = 0; r < 16; ++r) { const int kp = 64 * t + crow(r, hi); if (kp > qpos) p0[r] = -INFINITY; if (kp + 32 > qpos) p1[r] = -INFINITY; } }
            } else {
                asm volatile("s_nop 15\n\ts_nop 7" : "+v"(p0), "+v"(p1));
            }
            float ma = max3f(p0[0], p0[1], p1[0]), mb = max3f(p0[2], p0[3], p1[1]);
            ma = max3f(ma, p1[2], p1[3]);
#pragma unroll
            for (int r = 4; r < 16; r += 4) { ma = max3f(ma, p0[r], p0[r + 1]); mb = max3f(mb, p0[r + 2], p0[r + 3]); ma = max3f(ma, p1[r], p1[r + 1]); mb = max3f(mb, p1[r + 2], p1[r + 3]); }
            float mx = max3f(ma, mb, ma);
            if (!FOX) mx *= C2;
            mx = max3f(mx, lx_xor(mx, 32, lane), mx);
            if (__any(mx > m)) {
                const float mn = max3f(m, mx, mx), alpha = __builtin_amdgcn_exp2f(m - mn);
                m = mn; l *= alpha;
#pragma unroll
                for (int i = 0; i < DV / 32; ++i)
#pragma unroll
                    for (int r = 0; r < 16; ++r) o[i][r] *= alpha;
            }
            float rsa = 0.f, rsb = 0.f;
#pragma unroll
            for (int r = 0; r < 16; r += 2) {
                f32x2 a = {p0[r], p0[r + 1]}, b = {p1[r], p1[r + 1]};
                if (FOX) { a = a - (f32x2){m, m}; b = b - (f32x2){m, m}; }
                else { a = a * (f32x2){C2, C2} - (f32x2){m, m}; b = b * (f32x2){C2, C2} - (f32x2){m, m}; }
                p0[r] = __builtin_amdgcn_exp2f(a.x); p0[r + 1] = __builtin_amdgcn_exp2f(a.y); p1[r] = __builtin_amdgcn_exp2f(b.x); p1[r + 1] = __builtin_amdgcn_exp2f(b.y);
                rsa += p0[r] + p0[r + 1]; rsb += p1[r] + p1[r + 1]; }
            l += rsa + rsb;
            bf16x8 pf[4];
            { u32x4 w;
              w.x = pk2(p0[0], p0[1]); w.y = pk2(p0[2], p0[3]); w.z = pk2(p0[4], p0[5]); w.w = pk2(p0[6], p0[7]); pf[0] = __builtin_bit_cast(bf16x8, w);
              w.x = pk2(p0[8], p0[9]); w.y = pk2(p0[10], p0[11]); w.z = pk2(p0[12], p0[13]); w.w = pk2(p0[14], p0[15]); pf[1] = __builtin_bit_cast(bf16x8, w);
              w.x = pk2(p1[0], p1[1]); w.y = pk2(p1[2], p1[3]); w.z = pk2(p1[4], p1[5]); w.w = pk2(p1[6], p1[7]); pf[2] = __builtin_bit_cast(bf16x8, w);
              w.x = pk2(p1[8], p1[9]); w.y = pk2(p1[10], p1[11]); w.z = pk2(p1[12], p1[13]); w.w = pk2(p1[14], p1[15]); pf[3] = __builtin_bit_cast(bf16x8, w); }
            __builtin_amdgcn_sched_barrier(0);
#pragma unroll
            for (int ks = 0; ks < 4; ++ks) {
                if (ks + 1 < 4) {
#pragma unroll
                    for (int dvt = 0; dvt < DV / 32; ++dvt) { vs[(ks + 1) & 1][dvt][0] = vtr(vb + 16 * (ks + 1) * VP + dvt * 64); vs[(ks + 1) & 1][dvt][1] = vtr(vb + (16 * (ks + 1) + 8) * VP + dvt * 64); }
                    __builtin_amdgcn_sched_barrier(0);
                }
#pragma unroll
                for (int dvt = 0; dvt < DV / 32; ++dvt) {
                    const v4i16_t lo = vs[ks & 1][dvt][0], h8 = vs[ks & 1][dvt][1];
                    const bf16x8 vf = (bf16x8){lo[0], lo[1], lo[2], lo[3], h8[0], h8[1], h8[2], h8[3]};
                    o[dvt] = MFMA32(vf, pf[ks], o[dvt]);
                }
                __builtin_amdgcn_sched_barrier(0);
            }
        }
        if (t + 1 < NT) { ATT_STORE(lds + ((t + 1) & 1) * STAGE); if (t + 2 < NT) ATT_LOAD(t + 2); }
        __syncthreads();
    }
#undef ATT_LOAD
#undef ATT_STORE
    l_out = l + lx_xor(l, 32, lane);
}

__device__ __forceinline__ void fox_unit(const Args& a, int bh, int qb, unsigned char* lds, int w0, bool dry = false) {
    THREAD_IDS(); const int wid = wave;
    const int bl = bh >> 4, h = bh & 15, q0 = qb * 256, r32 = lane & 31, hi = lane >> 5;
    bf16_t* PROJ = (bf16_t*)(wsl(a.ws) + WS_PROJ);
    const size_t rowb = (size_t)bl * SEQ;
    f32x16 o[2]; float l;
    bf16_t* orow = PROJ + (rowb + q0 + 32 * wid + r32) * LDP;
    u32x2 gws[8];
#pragma unroll
    for (int k = 0; k < 8; ++k) gws[k] = *(const u32x2*)(orow + C_FG + h * 64 + 32 * (k >> 2) + 8 * (k & 3) + 4 * hi);
    attn_pass<64, true>(o, l, PROJ + (rowb + q0 + 32 * wid) * LDP + C_FQ + h * 64, PROJ + rowb * LDP + C_FK + h * 64, PROJ + rowb * LDP + C_FV + h * 64,
                        (const float*)(wsl(a.ws) + WS_F2) + (size_t)bh * SEQ, q0, lds, w0);
    const float inv = 1.0f / l;
    bf16_t* owr = dry ? (bf16_t*)(wsl(a.ws) + WS_M16) + (rowb + q0 + 32 * wid + r32) * 1024 : orow + C_FQ;
#pragma unroll
    for (int dvt = 0; dvt < 2; ++dvt)
#pragma unroll
        for (int g4 = 0; g4 < 4; ++g4) { const int dv = 32 * dvt + 8 * g4 + 4 * hi;
            const u32x2 gw = gws[dvt * 4 + g4];
            u32x2 w; w.x = pk2(o[dvt][4 * g4] * inv * bflo(gw.x), o[dvt][4 * g4 + 1] * inv * bfhi(gw.x)); w.y = pk2(o[dvt][4 * g4 + 2] * inv * bflo(gw.y), o[dvt][4 * g4 + 3] * inv * bfhi(gw.y));
            *(u32x2*)(owr + h * 64 + dv) = w; }
}
__device__ __forceinline__ void diff_unit(const Args& a, int layer, int bh, int qb, unsigned char* lds, int w0, bool dry = false) {
    THREAD_IDS(); const int wid = wave;
    const int bl = bh >> 3, h = bh & 7, q0 = qb * 256, r32 = lane & 31, hi = lane >> 5;
    bf16_t* PROJ = (bf16_t*)(wsl(a.ws) + WS_PROJ);
    const size_t rowb = (size_t)bl * SEQ;
    const float lam = ((const float*)(wsl(a.ws) + WS_LAM))[layer * 2], lami = ((const float*)(wsl(a.ws) + WS_LAM))[layer * 2 + 1];
    f32x16 o1[4]; float l1, l2;
    float* scr = (float*)(wsl(a.ws) + WS_M32) + ((size_t)((bh * 8 + qb) * 8 + wid) * 64 + lane) * 64;
    attn_pass<128, false>(o1, l1, PROJ + (rowb + q0 + 32 * wid) * LDP + C_DQ + h * 128, PROJ + rowb * LDP + C_DK + h * 128, PROJ + rowb * LDP + C_DV + h * 128, nullptr, q0, lds, w0);
    { const float inv = 1.0f / l1;
#pragma unroll
      for (int i = 0; i < 4; ++i)
#pragma unroll
          for (int r = 0; r < 16; r += 4) *(f32x4*)(scr + i * 16 + r) = (f32x4){o1[i][r] * inv, o1[i][r + 1] * inv, o1[i][r + 2] * inv, o1[i][r + 3] * inv}; }
    attn_pass<128, false>(o1, l2, PROJ + (rowb + q0 + 32 * wid) * LDP + C_DQ + h * 128 + 64, PROJ + rowb * LDP + C_DK + h * 128 + 64, PROJ + rowb * LDP + C_DV + h * 128, nullptr, q0, lds, w0);
    const float sc2 = lam / l2; float ss = 0.f;
    {   f32x4 c1[16];
#pragma unroll
        for (int k = 0; k < 16; ++k) c1[k] = *(const f32x4*)(scr + 4 * k);
#pragma unroll
        for (int k = 0; k < 16; ++k)
#pragma unroll
            for (int e = 0; e < 4; ++e) { const int i = k >> 2, r = 4 * (k & 3) + e; const float v = c1[k][e] - sc2 * o1[i][r]; o1[i][r] = v; ss += v * v; }
    }
    ss += lx_xor(ss, 32, lane);
    const float rs = rsqrtf(ss * (1.0f / 128.0f) + EPS) * (1.0f - lami);
    bf16_t* orow = PROJ + (rowb + q0 + 32 * wid + r32) * LDP;
    const float* sw = a.in[11] + layer * 128;
    bf16_t* owr = dry ? (bf16_t*)(wsl(a.ws) + WS_M16) + (rowb + q0 + 32 * wid + r32) * 1024 : orow + C_DQ;
#pragma unroll
    for (int half = 0; half < 2; ++half) {
        u32x2 gwv[8]; f32x4 wvv[8];
#pragma unroll
        for (int k = 0; k < 8; ++k) { const int dvt = 2 * half + (k >> 2), g4 = k & 3, dv = 32 * dvt + 8 * g4 + 4 * hi;
            gwv[k] = *(const u32x2*)(orow + C_DG + h * 128 + dv); wvv[k] = *(const f32x4*)(sw + dv); }
#pragma unroll
        for (int k = 0; k < 8; ++k) { const int dvt = 2 * half + (k >> 2), g4 = k & 3, dv = 32 * dvt + 8 * g4 + 4 * hi;
            const u32x2 gw = gwv[k]; const f32x4 wv = wvv[k];
            u32x2 w; w.x = pk2(o1[dvt][4 * g4] * rs * wv.x * bflo(gw.x), o1[dvt][4 * g4 + 1] * rs * wv.y * bfhi(gw.x));
            w.y = pk2(o1[dvt][4 * g4 + 2] * rs * wv.z * bflo(gw.y), o1[dvt][4 * g4 + 3] * rs * wv.w * bfhi(gw.y));
            *(u32x2*)(owr + h * 128 + dv) = w; }
    }
}

#define XB_TMO      128
#define XB_XCNT(j)  (256  + 64 * (j))
#define XB_XSUB(j)  (1280 + 64 * (j))
#define XB_XGEN(j)  (2304 + 64 * (j))
#define XB_TOP      3328
#define XB_TOPGEN   3392
#define XCD_BAR_WORDS 3456
#define XB_SPIN_CAP (1u << 18)

__device__ __forceinline__ unsigned xb_ld(unsigned* p)              { return __hip_atomic_load(p, __ATOMIC_RELAXED, __HIP_MEMORY_SCOPE_AGENT); }
__device__ __forceinline__ unsigned xb_add(unsigned* p, unsigned v) { return __hip_atomic_fetch_add(p, v, __ATOMIC_RELAXED, __HIP_MEMORY_SCOPE_AGENT); }
__device__ __forceinline__ unsigned xb_xcc_id() { return (unsigned)__builtin_amdgcn_s_getreg((3 << 11) | 20) & 0xFu; }
#define XB_SPIN(cond, bar) do { unsigned _sp = 0; while (cond) { __builtin_amdgcn_s_sleep(1); \
    if ((++_sp & 255u) == 0u) { if (xb_ld(&(bar)[XB_TMO])) break; if (_sp > XB_SPIN_CAP) { atomicAdd(&(bar)[XB_TMO], 1u); break; } } } } while (0)

struct XcdBarrier {
    unsigned* bar; unsigned x;
    volatile LAS unsigned* st;
};

__device__ __forceinline__ XcdBarrier xcd_barrier_post(unsigned* bar, volatile LAS unsigned* st) {
    XcdBarrier b; b.bar = bar; b.x = xb_xcc_id(); b.st = st;
    if (threadIdx.x == 0) (void)xb_add(&bar[XB_XCNT(b.x)], 1u);
    return b;
}
__device__ __forceinline__ void xcd_barrier_complete(unsigned* bar, unsigned x, unsigned& nloc, unsigned& nx) {
    const unsigned G = gridDim.x * gridDim.y * gridDim.z;
    unsigned sum, cnt, mine, sp = 0u;
    for (;;) {
        sum = 0u; cnt = 0u; mine = 0u;
#pragma unroll
        for (unsigned j = 0; j < 16; ++j) { const unsigned c = xb_ld(&bar[XB_XCNT(j)]); sum += c; cnt += (c > 0u) ? 1u : 0u; mine = (j == x) ? c : mine; }
        if (sum == G) break;
        __builtin_amdgcn_s_sleep(1);
        if ((++sp & 255u) == 0u) { if (xb_ld(&bar[XB_TMO])) break; if (sp > XB_SPIN_CAP) { atomicAdd(&bar[XB_TMO], 1u); break; } }
    }
    nloc = mine > 0u ? mine : 1u; nx = cnt > 0u ? cnt : 1u;
}

__device__ __forceinline__ bool is_thread0(int w0) { int lane; asm volatile("v_mbcnt_lo_u32_b32 %0, -1, 0\n\tv_mbcnt_hi_u32_b32 %0, -1, %0" : "=v"(lane)); return w0 == 0 && lane == 0; }
__device__ __forceinline__ void xcd_barrier(const XcdBarrier& b, int w0) {
    asm volatile("s_waitcnt vmcnt(0)" ::: "memory");
    __syncthreads();
    if (is_thread0(w0)) {
        unsigned* bar = b.bar;
        __builtin_amdgcn_s_waitcnt(0);
        unsigned nloc = b.st[0], nx = b.st[1];
        if (nloc == 0u) { xcd_barrier_complete(bar, b.x, nloc, nx); b.st[0] = nloc; b.st[1] = nx; }
        const unsigned old = xb_add(&bar[XB_XSUB(b.x)], 1u);
        const unsigned gen = old / nloc;
        if (old + 1u == (gen + 1u) * nloc) {
            __builtin_amdgcn_fence(__ATOMIC_RELEASE, "agent");
            asm volatile("s_waitcnt vmcnt(0)" ::: "memory");
            const unsigned og = xb_add(&bar[XB_TOP], 1u);
            const unsigned tg = og / nx;
            if (og + 1u == (tg + 1u) * nx) xb_add(&bar[XB_TOPGEN], 1u);
            else XB_SPIN(xb_ld(&bar[XB_TOPGEN]) == tg, bar);
            __builtin_amdgcn_fence(__ATOMIC_ACQUIRE, "agent");
            xb_add(&bar[XB_XGEN(b.x)], 1u);
            asm volatile("s_waitcnt vmcnt(0)" ::: "memory");
        } else {
            XB_SPIN(xb_ld(&bar[XB_XGEN(b.x)]) == gen, bar);
            __builtin_amdgcn_fence(__ATOMIC_ACQUIRE, "agent");
            asm volatile("s_waitcnt vmcnt(0)" ::: "memory");
        }
    }
    __syncthreads();
}

__global__ void __launch_bounds__(NTHR, 2) hybrid_fwd(Args args) {
    extern __shared__ __attribute__((aligned(16))) unsigned char lds[];
    cg::grid_group grid = cg::this_grid();
    const int wave0 = __builtin_amdgcn_readfirstlane((int)threadIdx.x >> 6);
    Args A2;
#pragma unroll
    for (int i = 0; i < 15; ++i) A2.in[i] = (const float*)(GAS const float*)args.in[i];
    A2.out = (float*)(GAS float*)args.out; A2.ws = (unsigned char*)(GAS unsigned char*)args.ws;
#define args A2
#define ws (wsl(args.ws))
#define CTR ((unsigned*)(ws + WS_CTR))
    LAS unsigned char* ldsl = (LAS unsigned char*)lds;

#ifndef PHM
#define PHM 0xffff
#endif
    { volatile LAS unsigned* st0 = (volatile LAS unsigned*)(ldsl + LDS_MISC + 64); if (threadIdx.x < 2) st0[threadIdx.x] = 0u; }
    if (blockIdx.x == 0) { unsigned* bw = (unsigned*)(ws + WS_BAR); for (int i = threadIdx.x; i < XCD_BAR_WORDS; i += NTHR) bw[i] = 0u; }
    __syncthreads();
    p0_prologue(args, lds, wave0);
    grid.sync();
    const XcdBarrier xbar = xcd_barrier_post((unsigned*)(ws + WS_BAR), (volatile LAS unsigned*)(ldsl + LDS_MISC + 64));
#define GRID_SYNC() xcd_barrier(xbar, wave0)
#ifndef TMASK
#define TMASK 0
#endif
    unsigned long long t_acc = 0ull, t_0 = 0ull;
#define T_BEGIN(bit) do { if (TMASK & (bit)) t_0 = __builtin_amdgcn_s_memrealtime(); } while (0)
#define T_END(bit) do { if (TMASK & (bit)) t_acc += __builtin_amdgcn_s_memrealtime() - t_0; } while (0)
    for (int layer = 0; layer < 2; ++layer) {
        const float* xin = (layer == 0) ? args.in[0] : args.out;
        if (layer == 0) { norm_rows<true>(xin, args.in[1], (bf16_t*)(ws + WS_H), nullptr, wave0); GRID_SYNC(); }
        for (int g = 0; g < NGRP; ++g) {
            const int pass = layer * NGRP + g;
            T_BEGIN(1);
            if (PHM & 4) { pg8::Gemm gm{(const bf16_t*)(ws + WS_H) + (size_t)g * TG * 1024, (const bf16_t*)(ws + WS_WIN) + (size_t)layer * NP * 1024, TG, NP, 1024, 1024};
              pg8::StaticOrder S; S.init(TG, NP, (int)gridDim.x, lbx());
              pg8::EpiProj E{(bf16_t*)(ws + WS_PROJ), (float*)(ws + WS_SMALL), (const float*)(ws + WS_LAM) + 16 + layer * 32};
              pg8::gemm_phase<pg8::EpiProj, pg8::StaticOrder, true, true>(ldsl, gm, S, E, wave0); }
            if (g > 0 && lbx() >= 128) {
              pg8::Gemm gm{(const bf16_t*)(ws + WS_M16), (const bf16_t*)(ws + WS_WOUT) + (size_t)layer * 1024 * 1024, TG, 1024, 1024, 1024};
              pg8::StaticOrder S; S.init(TG, 1024, (int)gridDim.x, lbx() - 128);
              pg8::EpiRes E{xin + (size_t)(g - 1) * TG * 1024, args.out + (size_t)(g - 1) * TG * 1024};
              pg8::gemm_phase<pg8::EpiRes, pg8::StaticOrder, true, true>(ldsl, gm, S, E, wave0); }
            GRID_SYNC();
            T_END(1); T_BEGIN(2);
#ifndef EXPER
#define EXPER 0
#endif
            if (EXPER == 2) { pg8::Gemm gm{(const bf16_t*)(ws + WS_H) + (size_t)g * TG * 1024, (const bf16_t*)(ws + WS_WIN) + (size_t)layer * NP * 1024, TG, NP, 1024, 1024};
              pg8::StaticOrder S; S.init(TG, NP, (int)gridDim.x, lbx());
              pg8::EpiProj E{(bf16_t*)(ws + WS_PROJ), (float*)(ws + WS_SMALL), (const float*)(ws + WS_LAM) + 16 + layer * 32};
              pg8::gemm_phase<pg8::EpiProj, pg8::StaticOrder, true, true>(ldsl, gm, S, E, wave0); GRID_SYNC(); }
            if (EXPER == 5) { for (int q = 0; q < 10; ++q) GRID_SYNC(); }
            UNIT_LOOP(CTR + (pass * 3 + 0) * 64, 648,
                  if (u < 8) fcum_unit(args, u, wave0);
                  else if (u < 136) rope_unit(args, u - 8, wave0);
                  else ssd_states_unit(args, layer, u - 136, lds, wave0););
            GRID_SYNC();
            T_END(2); T_BEGIN(4);
            UNIT_LOOP(CTR + (pass * 3 + 1) * 64, 1024,
                  if (u < 256) diff_unit(args, layer, u & 31, 7 - (u >> 5), lds, wave0);
                  else if (u < 512) ssd_scan_unit(args, u - 256, wave0);
                  else { const int j = u - 512; fox_unit(args, j & 63, 7 - (j >> 6), lds, wave0); });
            GRID_SYNC();
            T_END(4); T_BEGIN(8);
            { const int n = (lbx() < 128) ? 0 : 2;
              const int ycol = (n == 0) ? C_FQ : C_DQ;
              pg8::Gemm gm{(const bf16_t*)(ws + WS_PROJ) + ycol, (const bf16_t*)(ws + WS_WBR) + (size_t)(layer * 3 + n) * 1024 * 1024, TG, 1024, 1024, LDP};
              pg8::StaticOrder S; S.init(TG, 1024, (int)gridDim.x, lbx() & 127);
              pg8::EpiGate E{(const bf16_t*)(ws + WS_PROJ) + C_MG + n * 1024, (float*)(ws + WS_M32), (bf16_t*)(ws + WS_M16), n};
              pg8::gemm_phase<pg8::EpiGate, pg8::StaticOrder, true, true>(ldsl, gm, S, E, wave0); }
            UNIT_LOOP(CTR + (pass * 3 + 2) * 64, 512, ssd_out_unit(args, layer, u, lds, wave0););
            GRID_SYNC();
            T_END(8); T_BEGIN(16);
            { pg8::Gemm gm{(const bf16_t*)(ws + WS_PROJ) + C_SZ, (const bf16_t*)(ws + WS_WBR) + (size_t)(layer * 3 + 1) * 1024 * 1024, TG, 1024, 1024, LDP};
              pg8::StaticOrder S; S.init(TG, 1024, (int)gridDim.x, lbx());
              pg8::EpiGate E{(const bf16_t*)(ws + WS_PROJ) + C_MG + 1024, (float*)(ws + WS_M32), (bf16_t*)(ws + WS_M16), 1};
              pg8::gemm_phase<pg8::EpiGate, pg8::StaticOrder, true, true>(ldsl, gm, S, E, wave0); }
            GRID_SYNC();
            T_END(16);
        }
        if (lbx() < 128) { pg8::Gemm gm{(const bf16_t*)(ws + WS_M16), (const bf16_t*)(ws + WS_WOUT) + (size_t)layer * 1024 * 1024, TG, 1024, 1024, 1024};
          pg8::StaticOrder S; S.init(TG, 1024, (int)gridDim.x, lbx());
          pg8::EpiRes E{xin + (size_t)(NGRP - 1) * TG * 1024, args.out + (size_t)(NGRP - 1) * TG * 1024};
          pg8::gemm_phase<pg8::EpiRes, pg8::StaticOrder, true, true>(ldsl, gm, S, E, wave0); }
        else { if (layer == 0) norm_rows<true>(args.out, args.in[1] + 1024, (bf16_t*)(ws + WS_H), nullptr, wave0, 0, 3 * TG, lbx() - 128, 128);
               else norm_rows<false>(args.out, args.in[14], nullptr, args.out, wave0, 0, 3 * TG, lbx() - 128, 128); }
        if (TMASK && layer == 1 && blockIdx.x == 0) { const unsigned long long ts = __builtin_amdgcn_s_memrealtime(); while (__builtin_amdgcn_s_memrealtime() - ts < 4ull * t_acc) __builtin_amdgcn_s_sleep(32); }
        GRID_SYNC();
        if (layer == 0) { norm_rows<true>(args.out, args.in[1] + 1024, (bf16_t*)(ws + WS_H), nullptr, wave0, 3 * TG, MT, lbx(), (int)gridDim.x); GRID_SYNC(); }
        else norm_rows<false>(args.out, args.in[14], nullptr, args.out, wave0, 3 * TG, MT, lbx(), (int)gridDim.x);
    }
#undef ws
#undef CTR
}

#undef args
extern "C" void kernel_launch(void* const* d_in, const int* in_sizes, int n_in, void* d_out, int out_size, void* d_ws, size_t ws_size, hipStream_t stream) {
    static int grid = 0;
    if (grid == 0) {
        if (n_in != 15 || out_size != MT * DM || ws_size < WS_END) { fprintf(stderr, "kernel_launch: unexpected shapes (n_in %d out %d ws %zu need %zu)\n", n_in, out_size, ws_size, (size_t)WS_END); grid = -1; return; }
        int dev = 0, cus = 0, per_cu = 0;
        hipGetDevice(&dev); hipDeviceGetAttribute(&cus, hipDeviceAttributeMultiprocessorCount, dev);
        if (hipFuncSetAttribute((const void*)hybrid_fwd, hipFuncAttributeMaxDynamicSharedMemorySize, LDS_BYTES) != hipSuccess) { fprintf(stderr, "kernel_launch: hipFuncSetAttribute failed\n"); grid = -1; return; }
        if (hipOccupancyMaxActiveBlocksPerMultiprocessor(&per_cu, (const void*)hybrid_fwd, NTHR, LDS_BYTES) != hipSuccess || per_cu < 1) { fprintf(stderr, "kernel_launch: occupancy query gave %d\n", per_cu); per_cu = 1; }
        (void)hipGetLastError();
        grid = cus * 1;
    }
    if (grid < 0) return;
    Args a{};
    for (int i = 0; i < 15; ++i) a.in[i] = (const float*)d_in[i];
    a.out = (float*)d_out; a.ws = (unsigned char*)d_ws;
    void* kargs[] = {&a};
    hipError_t e = hipLaunchCooperativeKernel((const void*)hybrid_fwd, dim3(grid), dim3(NTHR), kargs, LDS_BYTES, stream);
    if (e != hipSuccess) fprintf(stderr, "kernel_launch: cooperative launch failed: %s (grid %d)\n", hipGetErrorString(e), grid);
}
```

```cpp
#include <hip/hip_runtime.h>
#include <hip/hip_cooperative_groups.h>
#include <cstdio>
#include <cstdint>
#include <cstddef>
#include <cmath>
namespace cg = cooperative_groups;
namespace pg8 {
#define PG8_LAS __attribute__((address_space(3)))
typedef unsigned short bf16_t;
typedef short bf16x8 __attribute__((ext_vector_type(8)));
typedef float f32x4 __attribute__((ext_vector_type(4)));
typedef unsigned u32x4 __attribute__((ext_vector_type(4)));
constexpr int BM = 256, BK = 64, HALF = 128, HTB = HALF * BK * 2  , STAGE_BYTES = 8 * HTB, NXCD = 8, WGM = 8;

__host__ __device__ __forceinline__ int lds_byte(int r, int c) { const int st = (r >> 4) * 2 + (c >> 5), rr = r & 15, cc = c & 31, ob = rr * 64 + cc * 2; return st * 1024 + (ob ^ (((ob >> 9) & 1) << 5)); }
__host__ __device__ __forceinline__ void stage_rc(int b, int& R, int& C) { const int st = b / 1024, sb = b % 1024, swz = sb ^ (((sb >> 9) & 1) << 5); R = (st >> 1) * 16 + swz / 64; C = (st & 1) * 32 + (swz % 64) / 2; }
__host__ __device__ __forceinline__ int perm32(int rho) { const int n = rho >> 4, i = rho & 15; return 8 * (i >> 2) + 4 * n + (i & 3); }

struct Unit { int pm, pn; };
struct Gemm { const bf16_t* A; const bf16_t* Bt; int M, N, K, lda; };

struct StaticOrder {
    int nM, nN, nwg, G, c;
    __host__ __device__ void init(int M, int N, int G_, int c_) { nM = M / BM; nN = N / BM; nwg = nM * nN; G = G_; c = c_; }
    __host__ __device__ bool next(int i, Unit& u) const {
        const long L = (long)i * G + c; if (L >= nwg) return false;
        int wgid = (int)L; { const int q = nwg / NXCD, r = nwg % NXCD, xcd = wgid % NXCD, off = wgid / NXCD; wgid = (xcd < r ? xcd * (q + 1) : r * (q + 1) + (xcd - r) * q) + off; }
        const int nig = WGM * nN, gid = wgid / nig, fm = gid * WGM, gsz = (nM - fm) < WGM ? (nM - fm) : WGM;
        u.pm = fm + ((wgid % nig) % gsz); u.pn = (wgid % nig) / gsz; return true;
    }
    __device__ __forceinline__ void a_ready(const Unit&) const {}
    __device__ __forceinline__ void done(const Unit&) const {}
};

__device__ __forceinline__ unsigned cvt_pk_bf16(float lo, float hi) { unsigned r; asm volatile("v_cvt_pk_bf16_f32 %0, %1, %2" : "=v"(r) : "v"(lo), "v"(hi)); return r; }

typedef unsigned u32x2 __attribute__((ext_vector_type(2)));
constexpr int LDP = 14336;
__device__ __forceinline__ float silu_f(float v) { return v * __builtin_amdgcn_rcpf(1.0f + __expf(-v)); }
__device__ __forceinline__ float sigm_f(float v) { return __builtin_amdgcn_rcpf(1.0f + __expf(-v)); }
__device__ __forceinline__ float bflo(unsigned w) { return __uint_as_float(w << 16); }
__device__ __forceinline__ float bfhi(unsigned w) { return __uint_as_float(w & 0xffff0000u); }

struct EpiProj {
    static constexpr bool PERM = true, AFTER_DRAIN = false;
    bf16_t* P; float* small; const float* sbias;
    __device__ __forceinline__ void operator()(const f32x4 (&acc)[2][2][4][2], const Unit& u, int wr, int wc, int fr, int fq) const {
        asm volatile("" : "+v"(fr));
        const int row0 = u.pm * BM + wr * 64 + fr;
        if (u.pn < 56) {
            const int pn = u.pn;
            const int mode = (pn < 12) ? 0 : (pn < 20) ? 1 : (pn < 40) ? 0 : (pn < 44) ? 1 : 2;
            const int col0 = pn * BM + wc * 32 + 8 * fq;
#pragma unroll
            for (int ai = 0; ai < 2; ++ai)
#pragma unroll
                for (int m = 0; m < 4; ++m) { bf16_t* rowp = P + (size_t)(row0 + ai * HALF + m * 16) * LDP + col0;
#pragma unroll
                    for (int bj = 0; bj < 2; ++bj) { f32x4 v0 = acc[ai][bj][m][0], v1 = acc[ai][bj][m][1];
                        if (mode == 1) {
#pragma unroll
                            for (int i = 0; i < 4; ++i) { v0[i] = silu_f(v0[i]); v1[i] = silu_f(v1[i]); } }
                        else if (mode == 2) {
#pragma unroll
                            for (int i = 0; i < 4; ++i) { v0[i] = sigm_f(v0[i]); v1[i] = sigm_f(v1[i]); } }
                        u32x4 w; w.x = cvt_pk_bf16(v0[0], v0[1]); w.y = cvt_pk_bf16(v0[2], v0[3]); w.z = cvt_pk_bf16(v1[0], v1[1]); w.w = cvt_pk_bf16(v1[2], v1[3]);
                        *(u32x4*)(rowp + bj * HALF) = w; } }
        } else if (wc == 0) {
            const float* sbp = sbias; asm volatile("" : "+s"(sbp));
            f32x4 bb[2]; bb[0] = *(const f32x4*)(sbp + 8 * fq); bb[1] = *(const f32x4*)(sbp + 8 * fq + 4);
#pragma unroll
            for (int ai = 0; ai < 2; ++ai)
#pragma unroll
                for (int m = 0; m < 4; ++m) { const int row = row0 + ai * HALF + m * 16;
#pragma unroll
                    for (int n = 0; n < 2; ++n) { f32x4 o;
#pragma unroll
                        for (int i = 0; i < 4; ++i) { const int c = 8 * fq + 4 * n + i; const float v = acc[ai][0][m][n][i];
                            const float xx = v + bb[n][i];
                            const float sp = __logf(1.0f + __expf(-fabsf(xx)));
                            o[i] = (c < 16) ? (fminf(xx, 0.f) - sp) : (fmaxf(xx, 0.f) + sp); }
                        *(f32x4*)(small + (size_t)row * 32 + 8 * fq + 4 * n) = o; } }
        }
    }
};
struct EpiGate {
    static constexpr bool PERM = false, AFTER_DRAIN = false;
    const bf16_t* gate; float* m32; bf16_t* m16; int nidx;
    __device__ __forceinline__ void operator()(const f32x4 (&acc)[2][2][4][2], const Unit& u, int wr, int wc, int fr, int fq) const {
        asm volatile("" : "+v"(fr));
        const int row0 = u.pm * BM + wr * 64 + fr, col0 = u.pn * BM + wc * 32 + 4 * fq;
        u32x2 gw[2][4]; f32x4 mv[2][4]; u32x2 hv[2][4];
#define EG_LOAD(c_, s_) do { const int row_ = row0 + ((c_) >> 2) * HALF + ((c_) & 3) * 16; \
        _Pragma("unroll") for (int e_ = 0; e_ < 4; ++e_) { const int col_ = col0 + (e_ >> 1) * HALF + (e_ & 1) * 16; \
            gw[s_][e_] = *(const u32x2*)(gate + (size_t)row_ * LDP + col_); \
            if (nidx == 1) { mv[s_][e_] = *(const f32x4*)(m32 + (size_t)row_ * 1024 + col_); hv[s_][e_] = *(const u32x2*)(m16 + (size_t)row_ * 1024 + col_); } } } while (0)
        EG_LOAD(0, 0);
#pragma unroll
        for (int c = 0; c < 8; ++c) {
            if (c + 1 < 8) EG_LOAD(c + 1, (c + 1) & 1);
            const int ai = c >> 2, m = c & 3, row = row0 + ai * HALF + m * 16;
#pragma unroll
            for (int e = 0; e < 4; ++e) { const int bj = e >> 1, n = e & 1, col = col0 + bj * HALF + n * 16;
                const u32x2 g2 = gw[c & 1][e];
                f32x4 v = acc[ai][bj][m][n];
                v[0] *= bflo(g2.x); v[1] *= bfhi(g2.x); v[2] *= bflo(g2.y); v[3] *= bfhi(g2.y);
                if (nidx == 0) *(f32x4*)(m32 + (size_t)row * 1024 + col) = v;
                else { if (nidx == 1) { const u32x2 t2 = hv[c & 1][e]; v += mv[c & 1][e]; v[0] += bflo(t2.x); v[1] += bfhi(t2.x); v[2] += bflo(t2.y); v[3] += bfhi(t2.y); }
                    u32x2 w; w.x = cvt_pk_bf16(v[0], v[1]); w.y = cvt_pk_bf16(v[2], v[3]); *(u32x2*)(m16 + (size_t)row * 1024 + col) = w; } }
        }
#undef EG_LOAD
    }
};
struct EpiRes {
    static constexpr bool PERM = false, AFTER_DRAIN = false;
    const float* xin; float* out;
    __device__ __forceinline__ void operator()(const f32x4 (&acc)[2][2][4][2], const Unit& u, int wr, int wc, int fr, int fq) const {
        asm volatile("" : "+v"(fr));
        const int row0 = u.pm * BM + wr * 64 + fr, col0 = u.pn * BM + wc * 32 + 4 * fq;
        f32x4 bx[2][4];
#define ER_LOAD(c_, s_) do { const size_t off_ = (size_t)(row0 + ((c_) >> 2) * HALF + ((c_) & 3) * 16) * 1024 + col0; \
        _Pragma("unroll") for (int e_ = 0; e_ < 4; ++e_) bx[s_][e_] = *(const f32x4*)(xin + off_ + (e_ >> 1) * HALF + (e_ & 1) * 16); } while (0)
        ER_LOAD(0, 0);
#pragma unroll
        for (int c = 0; c < 8; ++c) {
            if (c + 1 < 8) ER_LOAD(c + 1, (c + 1) & 1);
            const int ai = c >> 2, m = c & 3; const size_t off = (size_t)(row0 + ai * HALF + m * 16) * 1024 + col0;
#pragma unroll
            for (int e = 0; e < 4; ++e) { const int bj = e >> 1, n = e & 1; *(f32x4*)(out + off + bj * HALF + n * 16) = bx[c & 1][e] + acc[ai][bj][m][n]; }
        }
#undef ER_LOAD
    }
};
template <class Epi, class Sched, bool ALIGN_EPI = false, bool SP2 = false>
__device__ __forceinline__ void gemm_phase(PG8_LAS unsigned char* lds, const Gemm g, const Sched& S, const Epi& E, int w0) {
    int lane_; asm volatile("v_mbcnt_lo_u32_b32 %0, -1, 0\n\tv_mbcnt_hi_u32_b32 %0, -1, %0" : "=v"(lane_)); int wid = w0; asm volatile("" : "+s"(wid)); const int tid = wid * 64 + lane_, lane = tid & 63, wr = wid >> 2, wc = wid & 3, fr = lane & 15, fq = lane >> 4;
    const int K = g.K, nt = K / BK;
    unsigned voffA[2], voffB[2];
#pragma unroll
    for (int i = 0; i < 2; ++i) { int R, C; stage_rc(tid * 16 + i * 8192, R, C); const int Rb = Epi::PERM ? ((R & ~31) + perm32(R & 31)) : R;
        voffA[i] = (unsigned)(R * g.lda + C) * 2u; voffB[i] = (unsigned)(Rb * K + C) * 2u; }
    const size_t kstep = (size_t)(BK * 2);
    const size_t hstepA = (size_t)HALF * g.lda * 2, hstepB = (size_t)HALF * K * 2;
    const size_t tstepA = 2 * hstepA, tstepB = 2 * hstepB;
    const unsigned ldsw = (unsigned)wid * 1024u;
    const int aoff = lds_byte(wr * 64 + fr, fq * 8), boff = lds_byte(wc * 32 + fr, fq * 8);
#define PG8_SA(b, h) (((b) * 2 + (h)) * HTB)
#define PG8_SB(b, h) ((4 + (b) * 2 + (h)) * HTB)
#define PG8_STAGE(bufoff, gbase, voff) do { _Pragma("unroll") for (int _i = 0; _i < 2; ++_i) \
        __builtin_amdgcn_global_load_lds((const unsigned*)((const char*)(gbase) + (voff)[_i]), (PG8_LAS unsigned*)(lds + (bufoff) + ldsw + _i * 8192), 16, 0, 0); } while (0)
#define PG8_LDA(dst, b, h) do { _Pragma("unroll") for (int m = 0; m < 4; ++m) _Pragma("unroll") for (int k = 0; k < 2; ++k) dst[m][k] = *(const PG8_LAS bf16x8*)(lds + PG8_SA(b, h) + aoff + m * 2048 + k * 1024); } while (0)
#define PG8_LDB(dst, b, h) do { _Pragma("unroll") for (int n = 0; n < 2; ++n) _Pragma("unroll") for (int k = 0; k < 2; ++k) dst[n][k] = *(const PG8_LAS bf16x8*)(lds + PG8_SB(b, h) + boff + n * 2048 + k * 1024); } while (0)
#define PG8_MMA(ai, bj, At, Bt) do { __builtin_amdgcn_s_setprio(1); _Pragma("unroll") for (int m = 0; m < 4; ++m) _Pragma("unroll") for (int n = 0; n < 2; ++n) _Pragma("unroll") for (int k = 0; k < 2; ++k) \
        acc[ai][bj][m][n] = __builtin_amdgcn_mfma_f32_16x16x32_bf16(Bt[n][k], At[m][k], acc[ai][bj][m][n], 0, 0, 0); __builtin_amdgcn_s_setprio(0); } while (0)
#define PG8_WAIT_V(n) asm volatile("s_waitcnt vmcnt(" #n ")" ::: "memory")
#define PG8_WAIT_L(n) asm volatile("s_waitcnt lgkmcnt(" #n ")" ::: "memory")
#define PG8_BAR __builtin_amdgcn_s_barrier()
#define PG8_SCHED __builtin_amdgcn_sched_barrier(0)
    Unit cur, nxt; int ui = 0;
    if (!S.next(0, cur)) return;
    f32x4 acc[2][2][4][2];
#pragma unroll
    for (int a = 0; a < 2; ++a)
#pragma unroll
        for (int b = 0; b < 2; ++b)
#pragma unroll
            for (int m = 0; m < 4; ++m)
#pragma unroll
                for (int n = 0; n < 2; ++n) acc[a][b][m][n] = (f32x4){0.f, 0.f, 0.f, 0.f};
    bf16x8 At[4][2], B0[2][2], B1[2][2];
    const char* cA = (const char*)g.A + (size_t)cur.pm * tstepA; const char* cB = (const char*)g.Bt + (size_t)cur.pn * tstepB;
    S.a_ready(cur);
    if constexpr (SP2) {
        PG8_STAGE(PG8_SB(0, 0), cB, voffB); PG8_STAGE(PG8_SB(0, 1), cB + hstepB, voffB); PG8_STAGE(PG8_SA(0, 0), cA, voffA); PG8_STAGE(PG8_SA(0, 1), cA + hstepA, voffA);
        if (wr == 1) PG8_BAR;
        PG8_WAIT_V(2); PG8_BAR;
        PG8_STAGE(PG8_SB(1, 0), cB + kstep, voffB); PG8_STAGE(PG8_SA(1, 0), cA + kstep, voffA); PG8_STAGE(PG8_SB(1, 1), cB + hstepB + kstep, voffB);
        PG8_WAIT_V(6); PG8_BAR;
    } else {
        PG8_STAGE(PG8_SB(0, 0), cB, voffB); PG8_STAGE(PG8_SA(0, 0), cA, voffA); PG8_STAGE(PG8_SB(0, 1), cB + hstepB, voffB); PG8_STAGE(PG8_SA(0, 1), cA + hstepA, voffA);
        if (wr == 1) PG8_BAR;
        PG8_WAIT_V(4); PG8_BAR;
        PG8_STAGE(PG8_SB(1, 0), cB + kstep, voffB); PG8_STAGE(PG8_SA(1, 0), cA + kstep, voffA); PG8_STAGE(PG8_SB(1, 1), cB + hstepB + kstep, voffB);
        PG8_WAIT_V(6); PG8_BAR;
    }
    for (;;) {
        const bool has_next = S.next(ui + 1, nxt);
        const char* nA = has_next ? (const char*)g.A + (size_t)nxt.pm * tstepA : cA; const char* nB = has_next ? (const char*)g.Bt + (size_t)nxt.pn * tstepB : cB;
        for (int t = 0; t < nt; t += 2) {
            const bool last = (t == nt - 2);
            const char* a1 = cA + (size_t)(t + 1) * kstep;
            const char* a2 = last ? nA : cA + (size_t)(t + 2) * kstep; const char* b2 = last ? nB : cB + (size_t)(t + 2) * kstep;
            const char* a3 = a2 + kstep; const char* b3 = b2 + kstep;
            if (last && has_next) S.a_ready(nxt);
            if constexpr (SP2) {
            PG8_LDB(B0, 0, 0); PG8_LDB(B1, 0, 1); PG8_SCHED; PG8_LDA(At, 0, 0); PG8_STAGE(PG8_SA(1, 1), a1 + hstepA, voffA);
            PG8_WAIT_V(8); PG8_WAIT_L(0); PG8_BAR; PG8_MMA(0, 0, At, B0); PG8_MMA(0, 1, At, B1); PG8_BAR; PG8_SCHED;
            PG8_LDA(At, 0, 1); PG8_STAGE(PG8_SB(0, 0), b2, voffB); PG8_STAGE(PG8_SB(0, 1), b2 + hstepB, voffB); PG8_STAGE(PG8_SA(0, 0), a2, voffA);
            PG8_WAIT_V(8); PG8_WAIT_L(0); PG8_BAR; PG8_MMA(1, 0, At, B0); PG8_MMA(1, 1, At, B1); PG8_BAR; PG8_SCHED;
            PG8_LDB(B0, 1, 0); PG8_LDB(B1, 1, 1); PG8_SCHED; PG8_LDA(At, 1, 0); PG8_STAGE(PG8_SA(0, 1), a2 + hstepA, voffA);
            PG8_WAIT_V(8); PG8_WAIT_L(0); PG8_BAR; PG8_MMA(0, 0, At, B0); PG8_MMA(0, 1, At, B1); PG8_BAR; PG8_SCHED;
            PG8_LDA(At, 1, 1); PG8_STAGE(PG8_SB(1, 0), b3, voffB); PG8_STAGE(PG8_SB(1, 1), b3 + hstepB, voffB); PG8_STAGE(PG8_SA(1, 0), a3, voffA);
            PG8_WAIT_V(8); PG8_WAIT_L(0); PG8_BAR; PG8_MMA(1, 0, At, B0); PG8_MMA(1, 1, At, B1); PG8_BAR; PG8_SCHED;
            } else {
            PG8_LDB(B0, 0, 0); PG8_SCHED; PG8_LDA(At, 0, 0); PG8_STAGE(PG8_SA(1, 1), a1 + hstepA, voffA);
            PG8_WAIT_L(8); PG8_BAR; PG8_WAIT_L(0); PG8_MMA(0, 0, At, B0); PG8_BAR; PG8_SCHED;
            PG8_LDB(B1, 0, 1); PG8_STAGE(PG8_SB(0, 0), b2, voffB);
            PG8_BAR; PG8_WAIT_L(0); PG8_MMA(0, 1, At, B1); PG8_BAR;
            PG8_LDA(At, 0, 1); PG8_STAGE(PG8_SA(0, 0), a2, voffA);
            PG8_BAR; PG8_WAIT_L(0); PG8_MMA(1, 0, At, B0); PG8_BAR; PG8_SCHED;
            PG8_STAGE(PG8_SB(0, 1), b2 + hstepB, voffB);
            PG8_WAIT_V(6); PG8_BAR; PG8_MMA(1, 1, At, B1); PG8_BAR;
            PG8_LDB(B0, 1, 0); PG8_SCHED; PG8_LDA(At, 1, 0); PG8_STAGE(PG8_SA(0, 1), a2 + hstepA, voffA);
            PG8_WAIT_L(8); PG8_BAR; PG8_WAIT_L(0); PG8_MMA(0, 0, At, B0); PG8_BAR; PG8_SCHED;
            PG8_LDB(B1, 1, 1); PG8_STAGE(PG8_SB(1, 0), b3, voffB);
            PG8_BAR; PG8_WAIT_L(0); PG8_MMA(0, 1, At, B1); PG8_BAR;
            PG8_LDA(At, 1, 1); PG8_STAGE(PG8_SA(1, 0), a3, voffA);
            PG8_BAR; PG8_WAIT_L(0); PG8_MMA(1, 0, At, B0); PG8_BAR; PG8_SCHED;
            PG8_STAGE(PG8_SB(1, 1), b3 + hstepB, voffB);
            PG8_WAIT_V(6); PG8_BAR; PG8_MMA(1, 1, At, B1); PG8_BAR;
            }
        }
        if constexpr (ALIGN_EPI) { if (wr == 0) PG8_BAR; }
        if constexpr (!Epi::AFTER_DRAIN) { E(acc, cur, wr, wc, fr, fq); S.done(cur); }
        if (!has_next) break;
#pragma unroll
        for (int a = 0; a < 2; ++a)
#pragma unroll
            for (int b = 0; b < 2; ++b)
#pragma unroll
                for (int m = 0; m < 4; ++m)
#pragma unroll
                    for (int n = 0; n < 2; ++n) acc[a][b][m][n] = (f32x4){0.f, 0.f, 0.f, 0.f};
        cur = nxt; cA = nA; cB = nB; ++ui;
        if constexpr (ALIGN_EPI) { if (wr == 1) PG8_BAR; }
    }
    PG8_WAIT_V(0);
    if constexpr (!ALIGN_EPI) { if (wr == 0) PG8_BAR; }
    PG8_BAR;
    if constexpr (Epi::AFTER_DRAIN) { E.fused(acc, cur, wr, wc, fr, fq, lds, wid, lane); S.done(cur); }
#undef PG8_SA
#undef PG8_SB
#undef PG8_STAGE
#undef PG8_LDA
#undef PG8_LDB
#undef PG8_MMA
#undef PG8_WAIT_V
#undef PG8_WAIT_L
#undef PG8_BAR
#undef PG8_SCHED
}
}

#define LAS __attribute__((address_space(3)))
typedef unsigned short bf16_t;
typedef short bf16x8 __attribute__((ext_vector_type(8)));
typedef short v4i16_t __attribute__((ext_vector_type(4)));
typedef float f32x4 __attribute__((ext_vector_type(4)));
typedef float f32x16 __attribute__((ext_vector_type(16)));
typedef unsigned u32x4 __attribute__((ext_vector_type(4)));
typedef unsigned u32x2 __attribute__((ext_vector_type(2)));
typedef float f32x2 __attribute__((ext_vector_type(2)));

constexpr int DM = 1024, SEQ = 2048, NBATCH = 16, MT = NBATCH * SEQ;
constexpr int GB = 4, TG = GB * SEQ, NGRP = NBATCH / GB;
constexpr int LDP = pg8::LDP, NP = 14592, NIN = 14368;
constexpr int C_FQ = 0, C_FK = 1024, C_FV = 2048, C_FG = 3072, C_SZ = 4096, C_XBC = 5120, C_DQ = 7168, C_DK = 8192, C_DV = 9216, C_DG = 10240, C_MG = 11264;
constexpr float EPS = 1e-6f, LOG2E = 1.4426950408889634f, C2 = 0.125f * 1.4426950408889634f;
constexpr int NTHR = 512, NWAVES = 8;
constexpr int LDS_BYTES = 147456, LDS_MISC = 131072 + 8192;

constexpr size_t WS_CTR = 0, WS_BAR = 32768, WS_ROPE = 65536, WS_LAM = WS_ROPE + 131072, WS_WIN = 1u << 20;
constexpr size_t WS_WBR = WS_WIN + (size_t)2 * NP * 1024 * 2;
constexpr size_t WS_WOUT = WS_WBR + (size_t)6 * 1024 * 1024 * 2;
constexpr size_t WS_H = WS_WOUT + (size_t)2 * 1024 * 1024 * 2;
constexpr size_t WS_PROJ = WS_H + (size_t)MT * 1024 * 2;
constexpr size_t WS_SMALL = WS_PROJ + (size_t)TG * LDP * 2;
constexpr size_t WS_F2 = WS_SMALL + (size_t)TG * 32 * 4;
constexpr size_t WS_CD = WS_F2 + (size_t)GB * 16 * SEQ * 4;
constexpr size_t WS_M32 = WS_CD + 65536;
constexpr size_t WS_M16 = WS_M32 + (size_t)TG * 1024 * 4;
constexpr size_t WS_ST = WS_M16 + (size_t)TG * 1024 * 2;
constexpr size_t WS_PREV = WS_ST + (size_t)GB * 32 * 16 * 8192 * 2;
constexpr size_t WS_END = WS_ST + (size_t)GB * 32 * 16 * 8192 * 4;

struct Args { const float* in[15]; float* out; unsigned char* ws; };

__device__ __forceinline__ unsigned f2bf(float f) { unsigned u = __builtin_bit_cast(unsigned, f); return (u + 0x7fffu + ((u >> 16) & 1u)) >> 16; }
__device__ __forceinline__ unsigned pk2(float lo, float hi) { return pg8::cvt_pk_bf16(lo, hi); }
typedef __bf16 bf16x2_t __attribute__((ext_vector_type(2)));
__device__ __forceinline__ unsigned pk2m(float lo, float hi) { const f32x2 v = {lo, hi}; return __builtin_bit_cast(unsigned, __builtin_convertvector(v, bf16x2_t)); }
__device__ __forceinline__ float bflo(unsigned w) { return __uint_as_float(w << 16); }
__device__ __forceinline__ float bfhi(unsigned w) { return __uint_as_float(w & 0xffff0000u); }
__device__ __forceinline__ float bf1(bf16_t b) { return __uint_as_float(((unsigned)b) << 16); }
__device__ __forceinline__ float lx_xor(float v, int mask, int lane) { return __int_as_float(__builtin_amdgcn_ds_bpermute((lane ^ mask) << 2, __float_as_int(v))); }
__device__ __forceinline__ float lx_up(float v, int d, int lane) { return __int_as_float(__builtin_amdgcn_ds_bpermute((lane - d) << 2, __float_as_int(v))); }
__device__ __forceinline__ float wave_sum(float v, int lane) {
#pragma unroll
    for (int o = 1; o < 64; o <<= 1) v += lx_xor(v, o, lane);
    return v;
}
__device__ __forceinline__ int crow(int r, int hi) { return (r & 3) + 8 * (r >> 2) + 4 * hi; }
#define LDS_WAIT() asm volatile("s_waitcnt lgkmcnt(0)" ::: "memory")
#define THREAD_IDS() int lane; asm volatile("v_mbcnt_lo_u32_b32 %0, -1, 0\n\tv_mbcnt_hi_u32_b32 %0, -1, %0" : "=v"(lane)); int wave = w0; asm volatile("" : "+s"(wave)); const int tid = wave * 64 + lane; (void)tid
#define MFMA32(a, b, c) __builtin_amdgcn_mfma_f32_32x32x16_bf16((a), (b), (c), 0, 0, 0)
#define MFMA16(a, b, c) __builtin_amdgcn_mfma_f32_16x16x32_bf16((a), (b), (c), 0, 0, 0)

__device__ __forceinline__ int lbx() { int b = (int)blockIdx.x; asm volatile("" : "+s"(b)); return b; }
#define GAS __attribute__((address_space(1)))
__device__ __forceinline__ unsigned char* wsl(unsigned char* p) { GAS unsigned char* q = (GAS unsigned char*)p; asm volatile("" : "+s"(q)); return (unsigned char*)q; }
__device__ __forceinline__ int q_draw(unsigned* ctr, int w0) { int v = 0; if (w0 == 0) { int lane; asm volatile("v_mbcnt_lo_u32_b32 %0, -1, 0\n\tv_mbcnt_hi_u32_b32 %0, -1, %0" : "=v"(lane)); if (lane == 0) v = (int)atomicAdd(ctr, 1u); } return v; }
__device__ __forceinline__ int q_pub(int drawn, unsigned char* lds, int w0) {
    volatile int* slot = (volatile int*)(lds + LDS_MISC);
    __syncthreads();
    if (w0 == 0) { int lane; asm volatile("v_mbcnt_lo_u32_b32 %0, -1, 0\n\tv_mbcnt_hi_u32_b32 %0, -1, %0" : "=v"(lane)); if (lane == 0) *slot = drawn; }
    __syncthreads();
    return *slot;
}
#define UNIT_LOOP(ctr_, total_, body_) do { unsigned* c__ = (ctr_); \
    for (;;) { const int d__ = q_draw(c__, wave0); const int u = q_pub(d__, lds, wave0); if (u >= (total_)) break; body_ } } while (0)

__device__ __forceinline__ int win_src_col(int n) {
    if (n < 3072) return n;
    if (n < 7168) return n + 16;
    if (n < 14336) return n + 32;
    if (n < 14352) return 3072 + (n - 14336);
    if (n < 14368) return 7184 + (n - 14352);
    return -1;
}
template <bool MAP> __device__ __forceinline__ void transpose_item(const float* W, int K, int Nsrc, bf16_t* WT, float* scr, int kb, int nb, int lane) {
    const int k0 = 64 * kb, n0 = 32 * nb;
    const int nn = n0 + (lane & 31); const int src = MAP ? win_src_col(nn) : nn;
#pragma unroll
    for (int i = 0; i < 32; ++i) { const int kk = 2 * i + (lane >> 5); scr[kk * 33 + (lane & 31)] = (src >= 0) ? W[(size_t)(k0 + kk) * Nsrc + src] : 0.f; }
    LDS_WAIT();
    const int c = lane & 7;
#pragma unroll
    for (int j = 0; j < 4; ++j) { const int n = (lane >> 3) + 8 * j; const float* s = scr + (8 * c) * 33 + n;
        u32x4 o; o.x = pk2(s[0 * 33], s[1 * 33]); o.y = pk2(s[2 * 33], s[3 * 33]); o.z = pk2(s[4 * 33], s[5 * 33]); o.w = pk2(s[6 * 33], s[7 * 33]);
        *(u32x4*)(WT + (size_t)(n0 + n) * K + k0 + 8 * c) = o; }
    LDS_WAIT();
}
__device__ __forceinline__ void p0_prologue(const Args& a, unsigned char* lds, int w0) {
    THREAD_IDS();
    unsigned char* ws = wsl(a.ws);
    float* scr = (float*)(lds + wave * 8448);
    const int gw = blockIdx.x * NWAVES + wave, NGW = gridDim.x * NWAVES;
    constexpr int I_IN = 16 * (NP / 32), I_SQ = 16 * 32;
    constexpr int NITEMS = 2 * I_IN + 8 * I_SQ;
    for (int it = gw; it < NITEMS; it += NGW) {
        int r = it;
        if (r < 2 * I_IN) { const int layer = r / I_IN; r -= layer * I_IN;
            transpose_item<true>(a.in[2] + (size_t)layer * 1024 * NIN, 1024, NIN, (bf16_t*)(ws + WS_WIN) + (size_t)layer * NP * 1024, scr, r / (NP / 32), r % (NP / 32), lane); continue; }
        r -= 2 * I_IN;
        if (r < 6 * I_SQ) { const int mi = r / I_SQ; r -= mi * I_SQ;
            transpose_item<false>(a.in[12] + (size_t)mi * 1024 * 1024, 1024, 1024, (bf16_t*)(ws + WS_WBR) + (size_t)mi * 1024 * 1024, scr, r / 32, r % 32, lane); continue; }
        r -= 6 * I_SQ;
        { const int mi = r / I_SQ; r -= mi * I_SQ;
            transpose_item<false>(a.in[13] + (size_t)mi * 1024 * 1024, 1024, 1024, (bf16_t*)(ws + WS_WOUT) + (size_t)mi * 1024 * 1024, scr, r / 32, r % 32, lane); }
    }
    for (int idx = blockIdx.x * NTHR + tid; idx < SEQ * 8; idx += gridDim.x * NTHR) {
        const int pos = idx >> 3, i = idx & 7;
        const float inv = powf(500000.0f, -(float)(2 * i) / 16.0f);
        const float ang = (float)pos * inv;
        ((f32x2*)(ws + WS_ROPE))[idx] = (f32x2){cosf(ang), sinf(ang)};
    }
    if (blockIdx.x == 0) {
        if (tid < 128) ((unsigned*)(ws + WS_CTR))[tid * 64] = 0u;
        if (tid >= 128 && tid < 192) { const int k = tid - 128, layer = k >> 5, c = k & 31;
            ((float*)(ws + WS_LAM))[16 + k] = (c < 16) ? a.in[3][layer * 16 + c] : a.in[6][layer * 16 + c - 16]; }
        if (tid >= 64 && tid < 66) { const int layer = tid - 64; const float* lp = a.in[10] + layer * 256;
            float s1 = 0.f, s2 = 0.f;
            for (int d = 0; d < 64; ++d) { s1 += lp[d] * lp[64 + d]; s2 += lp[128 + d] * lp[192 + d]; }
            const float li = 0.8f - 0.6f * expf(-0.3f * (float)layer);
            ((float*)(ws + WS_LAM))[layer * 2] = expf(s1) - expf(s2) + li; ((float*)(ws + WS_LAM))[layer * 2 + 1] = li; }
    }
}
template <bool TOBF> __device__ __forceinline__ void norm_rows(const float* X, const float* w, bf16_t* ob, float* of, int w0, int r0 = 0, int r1 = MT, int vb = -1, int nvb = 0) {
    THREAD_IDS();
    if (vb < 0) { vb = (int)blockIdx.x; nvb = (int)gridDim.x; }
    const int gw = vb * NWAVES + wave, NGW = nvb * NWAVES;
    f32x4 wv[4];
#pragma unroll
    for (int j = 0; j < 4; ++j) wv[j] = ((const f32x4*)w)[64 * j + lane];
    for (int m = r0 + gw; m < r1; m += 2 * NGW) {
        const int m2 = m + NGW;
        const f32x4* xr = (const f32x4*)(X + (size_t)m * DM) + lane; const f32x4* xr2 = (const f32x4*)(X + (size_t)m2 * DM) + lane;
        f32x4 v[4], v2[4]; float s = 0.f, s2 = 0.f;
#pragma unroll
        for (int j = 0; j < 4; ++j) { v[j] = xr[64 * j]; v2[j] = xr2[64 * j]; }
#pragma unroll
        for (int j = 0; j < 4; ++j) { s += (v[j].x * v[j].x + v[j].y * v[j].y) + (v[j].z * v[j].z + v[j].w * v[j].w); s2 += (v2[j].x * v2[j].x + v2[j].y * v2[j].y) + (v2[j].z * v2[j].z + v2[j].w * v2[j].w); }
        const float rs = rsqrtf(wave_sum(s, lane) * (1.0f / DM) + EPS), rs2 = rsqrtf(wave_sum(s2, lane) * (1.0f / DM) + EPS);
#pragma unroll
        for (int j = 0; j < 4; ++j) { const f32x4 o = v[j] * rs * wv[j], o2 = v2[j] * rs2 * wv[j];
            if (TOBF) { u32x2 p; p.x = pk2(o.x, o.y); p.y = pk2(o.z, o.w); ((u32x2*)(ob + (size_t)m * DM))[64 * j + lane] = p;
                        u32x2 q; q.x = pk2(o2.x, o2.y); q.y = pk2(o2.z, o2.w); ((u32x2*)(ob + (size_t)m2 * DM))[64 * j + lane] = q; }
            else { ((f32x4*)(of + (size_t)m * DM))[64 * j + lane] = o; ((f32x4*)(of + (size_t)m2 * DM))[64 * j + lane] = o2; } }
    }
}

constexpr int SL_ACS = 0, SL_DT = 1024, SL_PART = 2048, SL_XT = 4096, SL_B = SL_XT + 256 * 144, SL_C = SL_B + 18432;
constexpr int XTP = 144, BNP = 272;

__device__ __forceinline__ void ssd_acs(unsigned char* lds, const float* small, size_t row0, int g, const float* a_log, int wave, int lane) {
    if (wave < 4) {
        const int h = 4 * g + wave;
        const float dt = small[(row0 + lane) * 32 + 16 + h];
        float v = -expf(a_log[h]) * dt;
#pragma unroll
        for (int o = 1; o < 64; o <<= 1) { const float t = lx_up(v, o, lane); if (lane >= o) v += t; }
        ((float*)(lds + SL_ACS))[wave * 64 + lane] = v;
        ((float*)(lds + SL_DT))[wave * 64 + lane] = dt;
    }
}
__device__ __forceinline__ void conv_load(u32x4 (&raw)[11], f32x4 (&wv)[10], const bf16_t* xb, int pg, int c, const float* cw, const float* cb) {
#pragma unroll
    for (int i = 0; i < 11; ++i) { const int rr = pg * 8 - 3 + i;
        if (rr >= 0 || c > 0) raw[i] = *(const u32x4*)(xb + (ptrdiff_t)rr * LDP); else raw[i] = (u32x4){0u, 0u, 0u, 0u}; }
#pragma unroll
    for (int k = 0; k < 4; ++k) { wv[2 * k] = *(const f32x4*)(cw + k * 2048); wv[2 * k + 1] = *(const f32x4*)(cw + k * 2048 + 4); }
    wv[8] = *(const f32x4*)cb; wv[9] = *(const f32x4*)(cb + 4);
}
__device__ __forceinline__ void conv_compute(float (&out)[8][8], const u32x4 (&raw)[11], const f32x4 (&wv)[10]) {
#pragma unroll
    for (int p = 0; p < 8; ++p) {
#pragma unroll
        for (int ch = 0; ch < 8; ++ch) { float s = wv[8 + (ch >> 2)][ch & 3];
#pragma unroll
            for (int k = 0; k < 4; ++k) { const unsigned wd = raw[p + k][ch >> 1]; const float u = (ch & 1) ? bfhi(wd) : bflo(wd); s += wv[2 * k + (ch >> 2)][ch & 3] * u; }
            out[p][ch] = pg8::silu_f(s); }
    }
}
__device__ __forceinline__ void put_T(unsigned char* img, int chrow0, int s0, const float (&v)[8][8]) {
#pragma unroll
    for (int ch = 0; ch < 8; ++ch) { u32x4 o; o.x = pk2(v[0][ch], v[1][ch]); o.y = pk2(v[2][ch], v[3][ch]); o.z = pk2(v[4][ch], v[5][ch]); o.w = pk2(v[6][ch], v[7][ch]);
        *(u32x4*)(img + (chrow0 + ch) * XTP + s0 * 2) = o; }
}
__device__ __forceinline__ void put_N(unsigned char* img, int n0, int s0, const float (&v)[8][8]) {
#pragma unroll
    for (int p = 0; p < 8; ++p) { u32x4 o; o.x = pk2(v[p][0], v[p][1]); o.y = pk2(v[p][2], v[p][3]); o.z = pk2(v[p][4], v[p][5]); o.w = pk2(v[p][6], v[p][7]);
        *(u32x4*)(img + (s0 + p) * BNP + n0 * 2) = o; }
}

__device__ __forceinline__ void ssd_states_unit(const Args& a, int layer, int u, unsigned char* lds, int w0) {
    THREAD_IDS();
    const int g = u & 3, c = (u >> 2) & 31, bl = u >> 7;
    unsigned char* ws = wsl(a.ws);
    const bf16_t* PROJ = (const bf16_t*)(ws + WS_PROJ);
    const size_t row0 = (size_t)bl * SEQ + c * 64;
    const int cgi = tid & 63, pg = tid >> 6;
    const int chx = (cgi < 32) ? (g * 256 + cgi * 8) : (1024 + g * 128 + ((cgi < 48 ? cgi : 32) - 32) * 8);
    u32x4 raw[11]; f32x4 wv[10];
    if (cgi < 48) conv_load(raw, wv, PROJ + row0 * LDP + C_XBC + chx, pg, c, a.in[4] + (size_t)layer * 4 * 2048 + chx, a.in[5] + layer * 2048 + chx);
    ssd_acs(lds, (const float*)(ws + WS_SMALL), row0, g, a.in[7] + layer * 16, wave, lane);
    __syncthreads();
    const float* ACS = (const float*)(lds + SL_ACS); const float* DTL = (const float*)(lds + SL_DT);
    if (cgi < 48) {
        float v[8][8];
        conv_compute(v, raw, wv);
        if (cgi < 32) { const int hh = cgi >> 3; const float al = ACS[hh * 64 + 63];
#pragma unroll
            for (int p = 0; p < 8; ++p) { const int s = pg * 8 + p; const float sc = __expf(al - ACS[hh * 64 + s]) * DTL[hh * 64 + s];
#pragma unroll
                for (int ch = 0; ch < 8; ++ch) v[p][ch] *= sc; }
            put_T(lds + SL_XT, cgi * 8, pg * 8, v);
        } else put_T(lds + SL_B, (cgi - 32) * 8, pg * 8, v);
    }
    __syncthreads();
    const int fr = lane & 15, fq = lane >> 4, hh = wave >> 1, nh = wave & 1;
    f32x4 acc[4][4];
#pragma unroll
    for (int i = 0; i < 4; ++i)
#pragma unroll
        for (int j = 0; j < 4; ++j) acc[i][j] = (f32x4){0.f, 0.f, 0.f, 0.f};
    {   bf16x8 af[2][4], bf[2][4];
#pragma unroll
        for (int ks = 0; ks < 2; ++ks) {
#pragma unroll
            for (int i = 0; i < 4; ++i) af[ks][i] = *(const bf16x8*)(lds + SL_B + (64 * nh + 16 * i + fr) * XTP + (32 * ks + 8 * fq) * 2);
#pragma unroll
            for (int j = 0; j < 4; ++j) bf[ks][j] = *(const bf16x8*)(lds + SL_XT + (hh * 64 + 16 * j + fr) * XTP + (32 * ks + 8 * fq) * 2); }
        __builtin_amdgcn_sched_barrier(0);
#pragma unroll
        for (int ks = 0; ks < 2; ++ks)
#pragma unroll
            for (int i = 0; i < 4; ++i)
#pragma unroll
                for (int j = 0; j < 4; ++j) acc[i][j] = MFMA16(af[ks][i], bf[ks][j], acc[i][j]);
    }
    const int h = 4 * g + hh;
    bf16_t* ST = (bf16_t*)(ws + WS_ST) + ((size_t)(bl * 32 + c) * 16 + h) * 8192;
#pragma unroll
    for (int i = 0; i < 4; ++i)
#pragma unroll
        for (int j = 0; j < 4; ++j) { u32x2 w; w.x = pk2m(acc[i][j][0], acc[i][j][1]); w.y = pk2m(acc[i][j][2], acc[i][j][3]);
            *(u32x2*)(ST + (16 * j + fr) * 128 + 64 * nh + 16 * i + 4 * fq) = w; }
    if (tid < 4) ((float*)(ws + WS_CD))[(bl * 32 + c) * 16 + 4 * g + tid] = __expf(ACS[tid * 64 + 63]);
}

__device__ __forceinline__ void ssd_scan_unit(const Args& a, int u, int w0) {
    THREAD_IDS();
    const int qt = u & 3, h = (u >> 2) & 15, bl = u >> 6;
    const bf16_t* ST = (const bf16_t*)(wsl(a.ws) + WS_ST); bf16_t* PV = (bf16_t*)(wsl(a.ws) + WS_PREV); const float* CD = (const float*)(wsl(a.ws) + WS_CD);
    const int e = qt * 2048 + tid * 4;
    float z0 = 0.f; asm volatile("" : "+v"(z0));
    f32x4 hc = (f32x4){z0, z0, z0, z0};
#pragma unroll 1
    for (int c0 = 0; c0 < 32; c0 += 16) {
        u32x2 sv[16]; float dcv[16];
#pragma unroll
        for (int c = 0; c < 16; ++c) { sv[c] = *(const u32x2*)(ST + ((size_t)(bl * 32 + c0 + c) * 16 + h) * 8192 + e); dcv[c] = CD[(bl * 32 + c0 + c) * 16 + h]; }
#pragma unroll
        for (int c = 0; c < 16; ++c) { const float dec = dcv[c];
            u32x2 w; w.x = pk2(hc[0], hc[1]); w.y = pk2(hc[2], hc[3]);
            *(u32x2*)(PV + ((size_t)(bl * 32 + c0 + c) * 16 + h) * 8192 + e) = w;
            hc = hc * dec + (f32x4){bflo(sv[c].x), bfhi(sv[c].x), bflo(sv[c].y), bfhi(sv[c].y)}; }
    }
}

__device__ __forceinline__ void ssd_out_unit(const Args& a, int layer, int u, unsigned char* lds, int w0, bool dry = false) {
    THREAD_IDS();
    const int g = u & 3, c = (u >> 2) & 31, bl = u >> 7;
    unsigned char* ws = wsl(a.ws);
    bf16_t* PROJ = (bf16_t*)(ws + WS_PROJ);
    const size_t row0 = (size_t)bl * SEQ + c * 64;
    const int cgi = tid & 63, pg = tid >> 6;
    {
        const int chx = (cgi < 32) ? (g * 256 + cgi * 8) : (cgi < 48) ? (1024 + g * 128 + (cgi - 32) * 8) : (1536 + g * 128 + (cgi - 48) * 8);
        u32x4 raw[11]; f32x4 wv[10];
        conv_load(raw, wv, PROJ + row0 * LDP + C_XBC + chx, pg, c, a.in[4] + (size_t)layer * 4 * 2048 + chx, a.in[5] + layer * 2048 + chx);
        ssd_acs(lds, (const float*)(ws + WS_SMALL), row0, g, a.in[7] + layer * 16, wave, lane);
        float v[8][8];
        conv_compute(v, raw, wv);
        if (cgi < 32) put_T(lds + SL_XT, cgi * 8, pg * 8, v);
        else if (cgi < 48) put_N(lds + SL_B, (cgi - 32) * 8, pg * 8, v);
        else put_N(lds + SL_C, (cgi - 48) * 8, pg * 8, v);
    }
    const int fr = lane & 15, fq = lane >> 4, hh = wave >> 1, lh = wave & 1, h = 4 * g + hh;
    const bf16_t* PV = (const bf16_t*)(ws + WS_PREV) + ((size_t)(bl * 32 + c) * 16 + h) * 8192;
    u32x2 zws[2][4]; f32x4 nwv[4];
#pragma unroll
    for (int lt = 0; lt < 2; ++lt)
#pragma unroll
        for (int pt = 0; pt < 4; ++pt) zws[lt][pt] = *(const u32x2*)(PROJ + (row0 + 32 * lh + 16 * lt + fr) * LDP + C_SZ + h * 64 + 16 * pt + 4 * fq);
#pragma unroll
    for (int pt = 0; pt < 4; ++pt) nwv[pt] = *(const f32x4*)(a.in[9] + layer * 1024 + h * 64 + 16 * pt + 4 * fq);
    bf16x8 pa[4][4];
#pragma unroll
    for (int ks = 0; ks < 4; ++ks)
#pragma unroll
        for (int pt = 0; pt < 4; ++pt) pa[ks][pt] = *(const bf16x8*)(PV + (16 * pt + fr) * 128 + 32 * ks + 8 * fq);
    __syncthreads();
    const float* ACS = (const float*)(lds + SL_ACS); const float* DTL = (const float*)(lds + SL_DT);
    f32x4 acc[4][2], dd[4][2];
#pragma unroll
    for (int i = 0; i < 4; ++i)
#pragma unroll
        for (int j = 0; j < 2; ++j) { acc[i][j] = (f32x4){0.f, 0.f, 0.f, 0.f}; dd[i][j] = (f32x4){0.f, 0.f, 0.f, 0.f}; }
    bf16x8 cf[4][2];
#pragma unroll
    for (int ks = 0; ks < 4; ++ks)
#pragma unroll
        for (int lt = 0; lt < 2; ++lt) cf[ks][lt] = *(const bf16x8*)(lds + SL_C + (32 * lh + 16 * lt + fr) * BNP + (32 * ks + 8 * fq) * 2);
    __builtin_amdgcn_sched_barrier(0);
#pragma unroll
    for (int ks = 0; ks < 4; ++ks)
#pragma unroll
        for (int pt = 0; pt < 4; ++pt)
#pragma unroll
            for (int lt = 0; lt < 2; ++lt) acc[pt][lt] = MFMA16(pa[ks][pt], cf[ks][lt], acc[pt][lt]);
    __builtin_amdgcn_sched_barrier(0);
    {   bf16x8 bq[4][4];
#pragma unroll
        for (int ks = 0; ks < 4; ++ks)
#pragma unroll
            for (int st = 0; st < 4; ++st) if (st < 2 || lh) bq[ks][st] = *(const bf16x8*)(lds + SL_B + (16 * st + fr) * BNP + (32 * ks + 8 * fq) * 2);
        __builtin_amdgcn_sched_barrier(0);
#pragma unroll
        for (int ks = 0; ks < 4; ++ks)
#pragma unroll
            for (int st = 0; st < 4; ++st) if (st < 2 || lh) {
#pragma unroll
                for (int lt = 0; lt < 2; ++lt) dd[st][lt] = MFMA16(bq[ks][st], cf[ks][lt], dd[st][lt]); }
    }
    float acl[2];
#pragma unroll
    for (int lt = 0; lt < 2; ++lt) { acl[lt] = ACS[hh * 64 + 32 * lh + 16 * lt + fr]; const float e = __expf(acl[lt]);
#pragma unroll
        for (int pt = 0; pt < 4; ++pt) acc[pt][lt] *= e; }
#pragma unroll
    for (int st = 0; st < 4; ++st) if (st < 2 || lh) {
#pragma unroll
        for (int r = 0; r < 4; ++r) { const int s = 16 * st + 4 * fq + r; const float as = ACS[hh * 64 + s], ds = DTL[hh * 64 + s];
#pragma unroll
            for (int lt = 0; lt < 2; ++lt) { const int l = 32 * lh + 16 * lt + fr; dd[st][lt][r] = (s <= l) ? dd[st][lt][r] * __expf(acl[lt] - as) * ds : 0.f; } }
    }
#pragma unroll
    for (int kk = 0; kk < 2; ++kk) if (kk == 0 || lh) {
        bf16x8 mb[2];
#pragma unroll
        for (int lt = 0; lt < 2; ++lt) { u32x4 w; w.x = pk2(dd[2 * kk][lt][0], dd[2 * kk][lt][1]); w.y = pk2(dd[2 * kk][lt][2], dd[2 * kk][lt][3]);
            w.z = pk2(dd[2 * kk + 1][lt][0], dd[2 * kk + 1][lt][1]); w.w = pk2(dd[2 * kk + 1][lt][2], dd[2 * kk + 1][lt][3]); mb[lt] = __builtin_bit_cast(bf16x8, w); }
#pragma unroll
        for (int pt = 0; pt < 4; ++pt) { const unsigned char* xr = lds + SL_XT + (hh * 64 + 16 * pt + fr) * XTP + (32 * kk + 4 * fq) * 2;
            const u32x2 lo = *(const u32x2*)xr, hi2 = *(const u32x2*)(xr + 32);
            const bf16x8 af = __builtin_bit_cast(bf16x8, (u32x4){lo.x, lo.y, hi2.x, hi2.y});
#pragma unroll
            for (int lt = 0; lt < 2; ++lt) acc[pt][lt] = MFMA16(af, mb[lt], acc[pt][lt]); }
    }
    const float dsk = a.in[8][layer * 16 + h];
    float ss[2] = {0.f, 0.f};
#pragma unroll
    for (int lt = 0; lt < 2; ++lt) { const int l = 32 * lh + 16 * lt + fr;
#pragma unroll
        for (int pt = 0; pt < 4; ++pt) { const int p4 = 16 * pt + 4 * fq;
            const u32x2 zw = zws[lt][pt];
            const float zz[4] = {bflo(zw.x), bfhi(zw.x), bflo(zw.y), bfhi(zw.y)};
#pragma unroll
            for (int r = 0; r < 4; ++r) { const float xv = bf1(*(const bf16_t*)(lds + SL_XT + (hh * 64 + p4 + r) * XTP + l * 2));
                const float y = (acc[pt][lt][r] + xv * dsk) * zz[r]; acc[pt][lt][r] = y; ss[lt] += y * y; } } }
#pragma unroll
    for (int lt = 0; lt < 2; ++lt) { ss[lt] += lx_xor(ss[lt], 16, lane); ss[lt] += lx_xor(ss[lt], 32, lane);
        if (fq == 0) ((float*)(lds + SL_PART))[hh * 64 + 32 * lh + 16 * lt + fr] = ss[lt]; }
    __syncthreads();
    const float* nw = a.in[9] + layer * 1024 + h * 64;
#pragma unroll
    for (int lt = 0; lt < 2; ++lt) { const int l = 32 * lh + 16 * lt + fr; const float* pr = (const float*)(lds + SL_PART);
        const float tot = (pr[l] + pr[64 + l]) + (pr[128 + l] + pr[192 + l]);
        const float rs = rsqrtf(tot * (1.0f / 256.0f) + EPS);
#pragma unroll
        for (int pt = 0; pt < 4; ++pt) { const int p4 = 16 * pt + 4 * fq; const f32x4 wv = nwv[pt];
            u32x2 o; o.x = pk2(acc[pt][lt][0] * rs * wv.x, acc[pt][lt][1] * rs * wv.y); o.y = pk2(acc[pt][lt][2] * rs * wv.z, acc[pt][lt][3] * rs * wv.w);
            if (dry) *(u32x2*)((bf16_t*)(ws + WS_M16) + (row0 + l) * 1024 + h * 64 + p4) = o; else *(u32x2*)(PROJ + (row0 + l) * LDP + C_SZ + h * 64 + p4) = o; } }
}

__device__ __forceinline__ void fcum_unit(const Args& a, int fu, int w0) {
    THREAD_IDS();
    const int task = fu * 8 + wave, bl = task >> 4, h = task & 15;
    const float* sm = (const float*)(wsl(a.ws) + WS_SMALL) + ((size_t)bl * SEQ + lane * 32) * 32 + h;
    float v[32]; float run = 0.f;
#pragma unroll
    for (int i = 0; i < 32; ++i) { run += sm[i * 32]; v[i] = run; }
    float sc = run;
#pragma unroll
    for (int o = 1; o < 64; o <<= 1) { const float t = lx_up(sc, o, lane); if (lane >= o) sc += t; }
    const float off = sc - run;
    float* F = (float*)(wsl(a.ws) + WS_F2) + (size_t)task * SEQ + lane * 32;
#pragma unroll
    for (int i = 0; i < 32; i += 4) *(f32x4*)(F + i) = (f32x4){(off + v[i]) * LOG2E, (off + v[i + 1]) * LOG2E, (off + v[i + 2]) * LOG2E, (off + v[i + 3]) * LOG2E};
}
__device__ __forceinline__ void rope_unit(const Args& a, int ru, int w0) {
    THREAD_IDS();
    const int row = ru * 64 + (tid >> 3), j = tid & 7, pos = row & (SEQ - 1);
    bf16_t* PROJ = (bf16_t*)(wsl(a.ws) + WS_PROJ);
    const f32x2* cs = (const f32x2*)(wsl(a.ws) + WS_ROPE) + pos * 8;
    f32x2 t[8];
#pragma unroll
    for (int i = 0; i < 8; ++i) t[i] = cs[i];
#pragma unroll
    for (int k = 0; k < 4; ++k) { const int hc = 4 * j + k; const int col = (hc < 16) ? (C_DQ + hc * 64) : (C_DK + (hc - 16) * 64);
        u32x4* p = (u32x4*)(PROJ + (size_t)row * LDP + col);
        const u32x4 a1 = p[0], a2 = p[1]; u32x4 o1, o2;
#pragma unroll
        for (int w = 0; w < 4; ++w) {
            const float x1l = bflo(a1[w]), x1h = bfhi(a1[w]), x2l = bflo(a2[w]), x2h = bfhi(a2[w]);
            const f32x2 c0 = t[2 * w], c1 = t[2 * w + 1];
            o1[w] = pk2(x1l * c0.x - x2l * c0.y, x1h * c1.x - x2h * c1.y);
            o2[w] = pk2(x2l * c0.x + x1l * c0.y, x2h * c1.x + x1h * c1.y); }
        p[0] = o1; p[1] = o2; }
}

__device__ __forceinline__ v4i16_t vtr(const unsigned char* p) { return __builtin_amdgcn_ds_read_tr16_b64_v4i16((LAS v4i16_t*)(LAS unsigned char*)p); }
__device__ __forceinline__ float max3f(float a, float b, float c) { float r; asm("v_max3_f32 %0, %1, %2, %3" : "=v"(r) : "v"(a), "v"(b), "v"(c)); return r; }
template <int DV, bool FOX>
__device__ __forceinline__ void attn_pass(f32x16 (&o)[DV / 32], float& l_out, const bf16_t* Qw, const bf16_t* Kb, const bf16_t* Vb, const float* F2,
                                          int q0, unsigned char* lds, int w0) {
    THREAD_IDS(); const int wid = wave;
    constexpr int KP = 144, VP = DV * 2 + 64, OFF_K = 0, OFF_V = 64 * KP, OFF_F = OFF_V + 64 * VP, STAGE = OFF_F + 256, NV = DV / 64;
    const int r32 = lane & 31, hi = lane >> 5;
    const int NT = (q0 + 256) / 64, my_nt = (q0 + 32 * wid) / 64 + 1;
    bf16x8 qf[4];
#pragma unroll
    for (int d0 = 0; d0 < 4; ++d0) qf[d0] = *(const bf16x8*)(Qw + (size_t)r32 * LDP + d0 * 16 + hi * 8);
    float m = -INFINITY, l = 0.f;
#pragma unroll
    for (int i = 0; i < DV / 32; ++i)
#pragma unroll
        for (int r = 0; r < 16; ++r) o[i][r] = 0.f;
    u32x4 kreg[2], vreg[2][NV]; float freg = 0.f;
    const int krow = tid >> 3, kch = tid & 7;
#define ATT_LOAD(T) do { _Pragma("unroll") for (int j_ = 0; j_ < 2; ++j_) { kreg[j_] = *(const u32x4*)(Kb + (size_t)(128 * (T) + 64 * j_ + krow) * LDP + kch * 8); \
        _Pragma("unroll") for (int i_ = 0; i_ < NV; ++i_) { const int idx_ = tid + 512 * i_; const int vr_ = (DV == 64) ? (idx_ >> 3) : (idx_ >> 4), vc_ = (DV == 64) ? (idx_ & 7) : (idx_ & 15); \
            vreg[j_][i_] = *(const u32x4*)(Vb + (size_t)(128 * (T) + 64 * j_ + vr_) * LDP + vc_ * 8); } } \
        if (FOX && tid < 128) freg = -F2[128 * (T) + tid]; } while (0)
#define ATT_STORE(sb_) do { _Pragma("unroll") for (int j_ = 0; j_ < 2; ++j_) { *(u32x4*)((sb_) + j_ * STAGE + OFF_K + krow * KP + kch * 16) = kreg[j_]; \
        _Pragma("unroll") for (int i_ = 0; i_ < NV; ++i_) { const int idx_ = tid + 512 * i_; const int vr_ = (DV == 64) ? (idx_ >> 3) : (idx_ >> 4), vc_ = (DV == 64) ? (idx_ & 7) : (idx_ & 15); \
            *(u32x4*)((sb_) + j_ * STAGE + OFF_V + vr_ * VP + vc_ * 16) = vreg[j_][i_]; } } \
        if (FOX && tid < 128) ((float*)((sb_) + (tid >> 6) * STAGE + OFF_F))[tid & 63] = freg; } while (0)
    const int NT2 = NT / 2;
    __syncthreads();
    ATT_LOAD(0); ATT_STORE(lds);
    if (NT2 > 1) ATT_LOAD(1);
    __syncthreads();
    for (int T = 0; T < NT2; ++T) {
      const unsigned char* sbase = lds + (T & 1) * (2 * STAGE);
      if constexpr (FOX) {
        const int t0 = 2 * T;
        if (t0 < my_nt) {
            const unsigned char* sb0 = sbase; const unsigned char* sb1 = sbase + STAGE;
            const unsigned char* vb0 = sb0 + OFF_V + (4 * hi + ((lane & 15) >> 2)) * VP + (16 * ((lane >> 4) & 1) + 4 * (lane & 3)) * 2;
            const unsigned char* vb1 = vb0 + STAGE;
            v4i16_t vs[2][DV / 32][2];
#pragma unroll
            for (int dvt = 0; dvt < DV / 32; ++dvt) { vs[0][dvt][0] = vtr(vb0 + dvt * 64); vs[0][dvt][1] = vtr(vb0 + 8 * VP + dvt * 64); }
            f32x16 p[4];
#pragma unroll
            for (int j = 0; j < 2; ++j) {
                const unsigned char* sbj = j ? sb1 : sb0;
                bf16x8 kf[8];
#pragma unroll
                for (int d0 = 0; d0 < 4; ++d0) { kf[2 * d0] = *(const bf16x8*)(sbj + OFF_K + r32 * KP + d0 * 32 + hi * 16);
                    kf[2 * d0 + 1] = *(const bf16x8*)(sbj + OFF_K + (32 + r32) * KP + d0 * 32 + hi * 16); }
                __builtin_amdgcn_sched_barrier(0);
#pragma unroll
                for (int r = 0; r < 16; ++r) { p[2 * j][r] = 0.f; p[2 * j + 1][r] = 0.f; }
#pragma unroll
                for (int d0 = 0; d0 < 4; ++d0) { p[2 * j] = MFMA32(kf[2 * d0], qf[d0], p[2 * j]); p[2 * j + 1] = MFMA32(kf[2 * d0 + 1], qf[d0], p[2 * j + 1]); }
            }
#pragma unroll
            for (int j = 0; j < 2; ++j) { const float* fk = (const float*)((j ? sb1 : sb0) + OFF_F);
#pragma unroll
                for (int g4 = 0; g4 < 4; ++g4) { const f32x4 fa = *(const f32x4*)(fk + 8 * g4 + 4 * hi), fb = *(const f32x4*)(fk + 32 + 8 * g4 + 4 * hi);
#pragma unroll
                    for (int i = 0; i < 4; ++i) { p[2 * j][4 * g4 + i] = p[2 * j][4 * g4 + i] * C2 + fa[i]; p[2 * j + 1][4 * g4 + i] = p[2 * j + 1][4 * g4 + i] * C2 + fb[i]; } } }
            if (t0 + 1 >= my_nt - 1) { const int qpos = q0 + 32 * wid + r32;
#pragma unroll
                for (int r = 0; r < 16; ++r) { const int kp = 64 * t0 + crow(r, hi);
                    if (kp > qpos) p[0][r] = -INFINITY; if (kp + 32 > qpos) p[1][r] = -INFINITY; if (kp + 64 > qpos) p[2][r] = -INFINITY; if (kp + 96 > qpos) p[3][r] = -INFINITY; } }
            float ma = max3f(p[0][0], p[1][0], p[2][0]), mb = max3f(p[3][0], p[0][1], p[1][1]);
            ma = max3f(ma, p[2][1], p[3][1]);
#pragma unroll
            for (int r = 2; r < 16; r += 2) { ma = max3f(ma, p[0][r], p[1][r]); mb = max3f(mb, p[2][r], p[3][r]); ma = max3f(ma, p[0][r + 1], p[1][r + 1]); mb = max3f(mb, p[2][r + 1], p[3][r + 1]); }
            float mx = max3f(ma, mb, ma);
            mx = max3f(mx, lx_xor(mx, 32, lane), mx);
            if (__any(mx > m)) {
                const float mn = max3f(m, mx, mx), alpha = __builtin_amdgcn_exp2f(m - mn);
                m = mn; l *= alpha;
#pragma unroll
                for (int i = 0; i < DV / 32; ++i)
#pragma unroll
                    for (int r = 0; r < 16; ++r) o[i][r] *= alpha;
            }
            float rsa = 0.f, rsb = 0.f;
#pragma unroll
            for (int q = 0; q < 4; ++q)
#pragma unroll
                for (int r = 0; r < 16; r += 2) { f32x2 a2 = {p[q][r], p[q][r + 1]}; a2 = a2 - (f32x2){m, m};
                    p[q][r] = __builtin_amdgcn_exp2f(a2.x); p[q][r + 1] = __builtin_amdgcn_exp2f(a2.y); if (q & 1) rsb += p[q][r] + p[q][r + 1]; else rsa += p[q][r] + p[q][r + 1]; }
            l += rsa + rsb;
            bf16x8 pf[8];
#pragma unroll
            for (int q = 0; q < 4; ++q) { u32x4 w;
                w.x = pk2(p[q][0], p[q][1]); w.y = pk2(p[q][2], p[q][3]); w.z = pk2(p[q][4], p[q][5]); w.w = pk2(p[q][6], p[q][7]); pf[2 * q] = __builtin_bit_cast(bf16x8, w);
                w.x = pk2(p[q][8], p[q][9]); w.y = pk2(p[q][10], p[q][11]); w.z = pk2(p[q][12], p[q][13]); w.w = pk2(p[q][14], p[q][15]); pf[2 * q + 1] = __builtin_bit_cast(bf16x8, w); }
            __builtin_amdgcn_sched_barrier(0);
#pragma unroll
            for (int ks = 0; ks < 8; ++ks) {
                if (ks + 1 < 8) { const unsigned char* vbn = ((ks + 1) < 4 ? vb0 : vb1) + 16 * ((ks + 1) & 3) * VP;
#pragma unroll
                    for (int dvt = 0; dvt < DV / 32; ++dvt) { vs[(ks + 1) & 1][dvt][0] = vtr(vbn + dvt * 64); vs[(ks + 1) & 1][dvt][1] = vtr(vbn + 8 * VP + dvt * 64); }
                    __builtin_amdgcn_sched_barrier(0);
                }
#pragma unroll
                for (int dvt = 0; dvt < DV / 32; ++dvt) {
                    const v4i16_t lo = vs[ks & 1][dvt][0], h8 = vs[ks & 1][dvt][1];
                    const bf16x8 vf = (bf16x8){lo[0], lo[1], lo[2], lo[3], h8[0], h8[1], h8[2], h8[3]};
                    o[dvt] = MFMA32(vf, pf[ks], o[dvt]);
                }
                __builtin_amdgcn_sched_barrier(0);
            }
        }
      } else {
#pragma unroll
      for (int sub = 0; sub < 2; ++sub) {
        const int t = 2 * T + sub;
        const unsigned char* sb = sbase + sub * STAGE;
        if (t < my_nt) {
            bf16x8 kf[8];
#pragma unroll
            for (int d0 = 0; d0 < 4; ++d0) { kf[2 * d0] = *(const bf16x8*)(sb + OFF_K + r32 * KP + d0 * 32 + hi * 16);
                kf[2 * d0 + 1] = *(const bf16x8*)(sb + OFF_K + (32 + r32) * KP + d0 * 32 + hi * 16); }
            const unsigned char* vb = sb + OFF_V + (4 * hi + ((lane & 15) >> 2)) * VP + (16 * ((lane >> 4) & 1) + 4 * (lane & 3)) * 2;
            f32x4 fka[4], fkb[4];
            if (FOX) { const float* fk = (const float*)(sb + OFF_F);
#pragma unroll
                for (int g4 = 0; g4 < 4; ++g4) { fka[g4] = *(const f32x4*)(fk + 8 * g4 + 4 * hi); fkb[g4] = *(const f32x4*)(fk + 32 + 8 * g4 + 4 * hi); } }
            v4i16_t vs[2][DV / 32][2];
#pragma unroll
            for (int dvt = 0; dvt < DV / 32; ++dvt) { vs[0][dvt][0] = vtr(vb + dvt * 64); vs[0][dvt][1] = vtr(vb + 8 * VP + dvt * 64); }
            __builtin_amdgcn_sched_barrier(0);
            f32x16 p0, p1;
#pragma unroll
            for (int r = 0; r < 16; ++r) { p0[r] = 0.f; p1[r] = 0.f; }
#pragma unroll
            for (int d0 = 0; d0 < 4; ++d0) { p0 = MFMA32(kf[2 * d0], qf[d0], p0); p1 = MFMA32(kf[2 * d0 + 1], qf[d0], p1); }
            if (FOX) {
#pragma unroll
                for (int g4 = 0; g4 < 4; ++g4) { const f32x4 fa = fka[g4], fb = fkb[g4];
#pragma unroll
                    for (int i = 0; i < 4; ++i) { p0[4 * g4 + i] = p0[4 * g4 + i] * C2 + fa[i]; p1[4 * g4 + i] = p1[4 * g4 + i] * C2 + fb[i]; } }
                if (t == my_nt - 1) { const int qpos = q0 + 32 * wid + r32;
#pragma unroll
                    for (int r = 0; r < 16; ++r) { const int kp = 64 * t + crow(r, hi); if (kp > qpos) p0[r] = -INFINITY; if (kp + 32 > qpos) p1[r] = -INFINITY; } }
            } else {
                asm volatile("s_nop 15\n\ts_nop 7" : "+v"(p0), "+v"(p1));
            }
            float ma = max3f(p0[0], p0[1], p1[0]), mb = max3f(p0[2], p0[3], p1[1]);
            ma = max3f(ma, p1[2], p1[3]);
#pragma unroll
            for (int r = 4; r < 16; r += 4) { ma = max3f(ma, p0[r], p0[r + 1]); mb = max3f(mb, p0[r + 2], p0[r + 3]); ma = max3f(ma, p1[r], p1[r + 1]); mb = max3f(mb, p1[r + 2], p1[r + 3]); }
            float mx = max3f(ma, mb, ma);
            if (!FOX) mx *= C2;
            mx = max3f(mx, lx_xor(mx, 32, lane), mx);
            if (__any(mx > m)) {
                const float mn = max3f(m, mx, mx), alpha = __builtin_amdgcn_exp2f(m - mn);
                m = mn; l *= alpha;
#pragma unroll
                for (int i = 0; i < DV / 32; ++i)
#pragma unroll
                    for (int r = 0; r < 16; ++r) o[i][r] *= alpha;
            }
            float rsa = 0.f, rsb = 0.f;
#pragma unroll
            for (int r = 0; r < 16; r += 2) {
                f32x2 a = {p0[r], p0[r + 1]}, b = {p1[r], p1[r + 1]};
                if (FOX) { a = a - (f32x2){m, m}; b = b - (f32x2){m, m}; }
                else { a = a * (f32x2){C2, C2} - (f32x2){m, m}; b = b * (f32x2){C2, C2} - (f32x2){m, m}; }
                p0[r] = __builtin_amdgcn_exp2f(a.x); p0[r + 1] = __builtin_amdgcn_exp2f(a.y); p1[r] = __builtin_amdgcn_exp2f(b.x); p1[r + 1] = __builtin_amdgcn_exp2f(b.y);
                rsa += p0[r] + p0[r + 1]; rsb += p1[r] + p1[r + 1]; }
            l += rsa + rsb;
            bf16x8 pf[4];
            { u32x4 w;
              w.x = pk2(p0[0], p0[1]); w.y = pk2(p0[2], p0[3]); w.z = pk2(p0[4], p0[5]); w.w = pk2(p0[6], p0[7]); pf[0] = __builtin_bit_cast(bf16x8, w);
              w.x = pk2(p0[8], p0[9]); w.y = pk2(p0[10], p0[11]); w.z = pk2(p0[12], p0[13]); w.w = pk2(p0[14], p0[15]); pf[1] = __builtin_bit_cast(bf16x8, w);
              w.x = pk2(p1[0], p1[1]); w.y = pk2(p1[2], p1[3]); w.z = pk2(p1[4], p1[5]); w.w = pk2(p1[6], p1[7]); pf[2] = __builtin_bit_cast(bf16x8, w);
              w.x = pk2(p1[8], p1[9]); w.y = pk2(p1[10], p1[11]); w.z = pk2(p1[12], p1[13]); w.w = pk2(p1[14], p1[15]); pf[3] = __builtin_bit_cast(bf16x8, w); }
            __builtin_amdgcn_sched_barrier(0);
#pragma unroll
            for (int ks = 0; ks < 4; ++ks) {
                if (ks + 1 < 4) {
#pragma unroll
                    for (int dvt = 0; dvt < DV / 32; ++dvt) { vs[(ks + 1) & 1][dvt][0] = vtr(vb + 16 * (ks + 1) * VP + dvt * 64); vs[(ks + 1) & 1][dvt][1] = vtr(vb + (16 * (ks + 1) + 8) * VP + dvt * 64); }
                    __builtin_amdgcn_sched_barrier(0);
                }
#pragma unroll
                for (int dvt = 0; dvt < DV / 32; ++dvt) {
                    const v4i16_t lo = vs[ks & 1][dvt][0], h8 = vs[ks & 1][dvt][1];
                    const bf16x8 vf = (bf16x8){lo[0], lo[1], lo[2], lo[3], h8[0], h8[1], h8[2], h8[3]};
                    o[dvt] = MFMA32(vf, pf[ks], o[dvt]);
                }
                __builtin_amdgcn_sched_barrier(0);
            }
        }
      }
      }
        if (T + 1 < NT2) { ATT_STORE(lds + ((T + 1) & 1) * (2 * STAGE)); if (T + 2 < NT2) ATT_LOAD(T + 2); }
        __syncthreads();
    }
#undef ATT_LOAD
#undef ATT_STORE
    l_out = l + lx_xor(l, 32, lane);
}

__device__ __forceinline__ void fox_unit(const Args& a, int bh, int qb, unsigned char* lds, int w0, bool dry = false) {
    THREAD_IDS(); const int wid = wave;
    const int bl = bh >> 4, h = bh & 15, q0 = qb * 256, r32 = lane & 31, hi = lane >> 5;
    bf16_t* PROJ = (bf16_t*)(wsl(a.ws) + WS_PROJ);
    const size_t rowb = (size_t)bl * SEQ;
    f32x16 o[2]; float l;
    bf16_t* orow = PROJ + (rowb + q0 + 32 * wid + r32) * LDP;
    u32x2 gws[8];
#pragma unroll
    for (int k = 0; k < 8; ++k) gws[k] = *(const u32x2*)(orow + C_FG + h * 64 + 32 * (k >> 2) + 8 * (k & 3) + 4 * hi);
    attn_pass<64, true>(o, l, PROJ + (rowb + q0 + 32 * wid) * LDP + C_FQ + h * 64, PROJ + rowb * LDP + C_FK + h * 64, PROJ + rowb * LDP + C_FV + h * 64,
                        (const float*)(wsl(a.ws) + WS_F2) + (size_t)bh * SEQ, q0, lds, w0);
    const float inv = 1.0f / l;
    bf16_t* owr = dry ? (bf16_t*)(wsl(a.ws) + WS_M16) + (rowb + q0 + 32 * wid + r32) * 1024 : orow + C_FQ;
#pragma unroll
    for (int dvt = 0; dvt < 2; ++dvt)
#pragma unroll
        for (int g4 = 0; g4 < 4; ++g4) { const int dv = 32 * dvt + 8 * g4 + 4 * hi;
            const u32x2 gw = gws[dvt * 4 + g4];
            u32x2 w; w.x = pk2(o[dvt][4 * g4] * inv * bflo(gw.x), o[dvt][4 * g4 + 1] * inv * bfhi(gw.x)); w.y = pk2(o[dvt][4 * g4 + 2] * inv * bflo(gw.y), o[dvt][4 * g4 + 3] * inv * bfhi(gw.y));
            *(u32x2*)(owr + h * 64 + dv) = w; }
}
__device__ __forceinline__ void diff_unit(const Args& a, int layer, int bh, int qb, unsigned char* lds, int w0, bool dry = false) {
    THREAD_IDS(); const int wid = wave;
    const int bl = bh >> 3, h = bh & 7, q0 = qb * 256, r32 = lane & 31, hi = lane >> 5;
    bf16_t* PROJ = (bf16_t*)(wsl(a.ws) + WS_PROJ);
    const size_t rowb = (size_t)bl * SEQ;
    const float lam = ((const float*)(wsl(a.ws) + WS_LAM))[layer * 2], lami = ((const float*)(wsl(a.ws) + WS_LAM))[layer * 2 + 1];
    f32x16 o1[4]; float l1, l2;
    float* scr = (float*)(wsl(a.ws) + WS_M32) + ((size_t)((bh * 8 + qb) * 8 + wid) * 64 + lane) * 64;
    attn_pass<128, false>(o1, l1, PROJ + (rowb + q0 + 32 * wid) * LDP + C_DQ + h * 128, PROJ + rowb * LDP + C_DK + h * 128, PROJ + rowb * LDP + C_DV + h * 128, nullptr, q0, lds, w0);
    { const float inv = 1.0f / l1;
#pragma unroll
      for (int i = 0; i < 4; ++i)
#pragma unroll
          for (int r = 0; r < 16; r += 4) *(f32x4*)(scr + i * 16 + r) = (f32x4){o1[i][r] * inv, o1[i][r + 1] * inv, o1[i][r + 2] * inv, o1[i][r + 3] * inv}; }
    attn_pass<128, false>(o1, l2, PROJ + (rowb + q0 + 32 * wid) * LDP + C_DQ + h * 128 + 64, PROJ + rowb * LDP + C_DK + h * 128 + 64, PROJ + rowb * LDP + C_DV + h * 128, nullptr, q0, lds, w0);
    const float sc2 = lam / l2; float ss = 0.f;
    {   f32x4 c1[16];
#pragma unroll
        for (int k = 0; k < 16; ++k) c1[k] = *(const f32x4*)(scr + 4 * k);
#pragma unroll
        for (int k = 0; k < 16; ++k)
#pragma unroll
            for (int e = 0; e < 4; ++e) { const int i = k >> 2, r = 4 * (k & 3) + e; const float v = c1[k][e] - sc2 * o1[i][r]; o1[i][r] = v; ss += v * v; }
    }
    ss += lx_xor(ss, 32, lane);
    const float rs = rsqrtf(ss * (1.0f / 128.0f) + EPS) * (1.0f - lami);
    bf16_t* orow = PROJ + (rowb + q0 + 32 * wid + r32) * LDP;
    const float* sw = a.in[11] + layer * 128;
    bf16_t* owr = dry ? (bf16_t*)(wsl(a.ws) + WS_M16) + (rowb + q0 + 32 * wid + r32) * 1024 : orow + C_DQ;
#pragma unroll
    for (int half = 0; half < 2; ++half) {
        u32x2 gwv[8]; f32x4 wvv[8];
#pragma unroll
        for (int k = 0; k < 8; ++k) { const int dvt = 2 * half + (k >> 2), g4 = k & 3, dv = 32 * dvt + 8 * g4 + 4 * hi;
            gwv[k] = *(const u32x2*)(orow + C_DG + h * 128 + dv); wvv[k] = *(const f32x4*)(sw + dv); }
#pragma unroll
        for (int k = 0; k < 8; ++k) { const int dvt = 2 * half + (k >> 2), g4 = k & 3, dv = 32 * dvt + 8 * g4 + 4 * hi;
            const u32x2 gw = gwv[k]; const f32x4 wv = wvv[k];
            u32x2 w; w.x = pk2(o1[dvt][4 * g4] * rs * wv.x * bflo(gw.x), o1[dvt][4 * g4 + 1] * rs * wv.y * bfhi(gw.x));
            w.y = pk2(o1[dvt][4 * g4 + 2] * rs * wv.z * bflo(gw.y), o1[dvt][4 * g4 + 3] * rs * wv.w * bfhi(gw.y));
            *(u32x2*)(owr + h * 128 + dv) = w; }
    }
}

#define XB_TMO      128
#define XB_XCNT(j)  (256  + 64 * (j))
#define XB_XSUB(j)  (1280 + 64 * (j))
#define XB_XGEN(j)  (2304 + 64 * (j))
#define XB_TOP      3328
#define XB_TOPGEN   3392
#define XCD_BAR_WORDS 3456
#define XB_SPIN_CAP (1u << 18)

__device__ __forceinline__ unsigned xb_ld(unsigned* p)              { return __hip_atomic_load(p, __ATOMIC_RELAXED, __HIP_MEMORY_SCOPE_AGENT); }
__device__ __forceinline__ unsigned xb_add(unsigned* p, unsigned v) { return __hip_atomic_fetch_add(p, v, __ATOMIC_RELAXED, __HIP_MEMORY_SCOPE_AGENT); }
__device__ __forceinline__ unsigned xb_xcc_id() { return (unsigned)__builtin_amdgcn_s_getreg((3 << 11) | 20) & 0xFu; }
#define XB_SPIN(cond, bar) do { unsigned _sp = 0; while (cond) { __builtin_amdgcn_s_sleep(1); \
    if ((++_sp & 255u) == 0u) { if (xb_ld(&(bar)[XB_TMO])) break; if (_sp > XB_SPIN_CAP) { atomicAdd(&(bar)[XB_TMO], 1u); break; } } } } while (0)

struct XcdBarrier {
    unsigned* bar; unsigned x;
    volatile LAS unsigned* st;
};

__device__ __forceinline__ XcdBarrier xcd_barrier_post(unsigned* bar, volatile LAS unsigned* st) {
    XcdBarrier b; b.bar = bar; b.x = xb_xcc_id(); b.st = st;
    if (threadIdx.x == 0) (void)xb_add(&bar[XB_XCNT(b.x)], 1u);
    return b;
}
__device__ __forceinline__ void xcd_barrier_complete(unsigned* bar, unsigned x, unsigned& nloc, unsigned& nx) {
    const unsigned G = gridDim.x * gridDim.y * gridDim.z;
    unsigned sum, cnt, mine, sp = 0u;
    for (;;) {
        sum = 0u; cnt = 0u; mine = 0u;
#pragma unroll
        for (unsigned j = 0; j < 16; ++j) { const unsigned c = xb_ld(&bar[XB_XCNT(j)]); sum += c; cnt += (c > 0u) ? 1u : 0u; mine = (j == x) ? c : mine; }
        if (sum == G) break;
        __builtin_amdgcn_s_sleep(1);
        if ((++sp & 255u) == 0u) { if (xb_ld(&bar[XB_TMO])) break; if (sp > XB_SPIN_CAP) { atomicAdd(&bar[XB_TMO], 1u); break; } }
    }
    nloc = mine > 0u ? mine : 1u; nx = cnt > 0u ? cnt : 1u;
}

__device__ __forceinline__ bool is_thread0(int w0) { int lane; asm volatile("v_mbcnt_lo_u32_b32 %0, -1, 0\n\tv_mbcnt_hi_u32_b32 %0, -1, %0" : "=v"(lane)); return w0 == 0 && lane == 0; }
__device__ __forceinline__ void xcd_barrier(const XcdBarrier& b, int w0) {
    asm volatile("s_waitcnt vmcnt(0)" ::: "memory");
    __syncthreads();
    if (is_thread0(w0)) {
        unsigned* bar = b.bar;
        __builtin_amdgcn_s_waitcnt(0);
        unsigned nloc = b.st[0], nx = b.st[1];
        if (nloc == 0u) { xcd_barrier_complete(bar, b.x, nloc, nx); b.st[0] = nloc; b.st[1] = nx; }
        const unsigned old = xb_add(&bar[XB_XSUB(b.x)], 1u);
        const unsigned gen = old / nloc;
        if (old + 1u == (gen + 1u) * nloc) {
            __builtin_amdgcn_fence(__ATOMIC_RELEASE, "agent");
            asm volatile("s_waitcnt vmcnt(0)" ::: "memory");
            const unsigned og = xb_add(&bar[XB_TOP], 1u);
            const unsigned tg = og / nx;
            if (og + 1u == (tg + 1u) * nx) xb_add(&bar[XB_TOPGEN], 1u);
            else XB_SPIN(xb_ld(&bar[XB_TOPGEN]) == tg, bar);
            __builtin_amdgcn_fence(__ATOMIC_ACQUIRE, "agent");
            xb_add(&bar[XB_XGEN(b.x)], 1u);
            asm volatile("s_waitcnt vmcnt(0)" ::: "memory");
        } else {
            XB_SPIN(xb_ld(&bar[XB_XGEN(b.x)]) == gen, bar);
            __builtin_amdgcn_fence(__ATOMIC_ACQUIRE, "agent");
            asm volatile("s_waitcnt vmcnt(0)" ::: "memory");
        }
    }
    __syncthreads();
}

__global__ void __launch_bounds__(NTHR, 2) hybrid_fwd(Args args) {
    extern __shared__ __attribute__((aligned(16))) unsigned char lds[];
    cg::grid_group grid = cg::this_grid();
    const int wave0 = __builtin_amdgcn_readfirstlane((int)threadIdx.x >> 6);
    Args A2;
#pragma unroll
    for (int i = 0; i < 15; ++i) A2.in[i] = (const float*)(GAS const float*)args.in[i];
    A2.out = (float*)(GAS float*)args.out; A2.ws = (unsigned char*)(GAS unsigned char*)args.ws;
#define args A2
#define ws (wsl(args.ws))
#define CTR ((unsigned*)(ws + WS_CTR))
    LAS unsigned char* ldsl = (LAS unsigned char*)lds;

#ifndef PHM
#define PHM 0xffff
#endif
    { volatile LAS unsigned* st0 = (volatile LAS unsigned*)(ldsl + LDS_MISC + 64); if (threadIdx.x < 2) st0[threadIdx.x] = 0u; }
    if (blockIdx.x == 0) { unsigned* bw = (unsigned*)(ws + WS_BAR); for (int i = threadIdx.x; i < XCD_BAR_WORDS; i += NTHR) bw[i] = 0u; }
    __syncthreads();
    p0_prologue(args, lds, wave0);
    grid.sync();
    const XcdBarrier xbar = xcd_barrier_post((unsigned*)(ws + WS_BAR), (volatile LAS unsigned*)(ldsl + LDS_MISC + 64));
#define GRID_SYNC() xcd_barrier(xbar, wave0)
#ifndef TMASK
#define TMASK 0
#endif
    unsigned long long t_acc = 0ull, t_0 = 0ull;
#define T_BEGIN(bit) do { if (TMASK & (bit)) t_0 = __builtin_amdgcn_s_memrealtime(); } while (0)
#define T_END(bit) do { if (TMASK & (bit)) t_acc += __builtin_amdgcn_s_memrealtime() - t_0; } while (0)
    for (int layer = 0; layer < 2; ++layer) {
        const float* xin = (layer == 0) ? args.in[0] : args.out;
        if (layer == 0) { norm_rows<true>(xin, args.in[1], (bf16_t*)(ws + WS_H), nullptr, wave0); GRID_SYNC(); }
        for (int g = 0; g < NGRP; ++g) {
            const int pass = layer * NGRP + g;
            T_BEGIN(1);
            if (PHM & 4) { pg8::Gemm gm{(const bf16_t*)(ws + WS_H) + (size_t)g * TG * 1024, (const bf16_t*)(ws + WS_WIN) + (size_t)layer * NP * 1024, TG, NP, 1024, 1024};
              pg8::StaticOrder S; S.init(TG, NP, (int)gridDim.x, lbx());
              pg8::EpiProj E{(bf16_t*)(ws + WS_PROJ), (float*)(ws + WS_SMALL), (const float*)(ws + WS_LAM) + 16 + layer * 32};
              pg8::gemm_phase<pg8::EpiProj, pg8::StaticOrder, true, true>(ldsl, gm, S, E, wave0); }
            if (g > 0 && lbx() >= 128) {
              pg8::Gemm gm{(const bf16_t*)(ws + WS_M16), (const bf16_t*)(ws + WS_WOUT) + (size_t)layer * 1024 * 1024, TG, 1024, 1024, 1024};
              pg8::StaticOrder S; S.init(TG, 1024, (int)gridDim.x, lbx() - 128);
              pg8::EpiRes E{xin + (size_t)(g - 1) * TG * 1024, args.out + (size_t)(g - 1) * TG * 1024};
              pg8::gemm_phase<pg8::EpiRes, pg8::StaticOrder, true, true>(ldsl, gm, S, E, wave0); }
            GRID_SYNC();
            T_END(1); T_BEGIN(2);
#ifndef EXPER
#define EXPER 0
#endif
            if (EXPER == 2) { pg8::Gemm gm{(const bf16_t*)(ws + WS_H) + (size_t)g * TG * 1024, (const bf16_t*)(ws + WS_WIN) + (size_t)layer * NP * 1024, TG, NP, 1024, 1024};
              pg8::StaticOrder S; S.init(TG, NP, (int)gridDim.x, lbx());
              pg8::EpiProj E{(bf16_t*)(ws + WS_PROJ), (float*)(ws + WS_SMALL), (const float*)(ws + WS_LAM) + 16 + layer * 32};
              pg8::gemm_phase<pg8::EpiProj, pg8::StaticOrder, true, true>(ldsl, gm, S, E, wave0); GRID_SYNC(); }
            if (EXPER == 5) { for (int q = 0; q < 10; ++q) GRID_SYNC(); }
            UNIT_LOOP(CTR + (pass * 3 + 0) * 64, 648,
                  if (u < 8) fcum_unit(args, u, wave0);
                  else if (u < 136) rope_unit(args, u - 8, wave0);
                  else ssd_states_unit(args, layer, u - 136, lds, wave0););
            GRID_SYNC();
            T_END(2); T_BEGIN(4);
            UNIT_LOOP(CTR + (pass * 3 + 1) * 64, 1024,
                  if (u < 256) diff_unit(args, layer, u & 31, 7 - (u >> 5), lds, wave0);
                  else if (u < 512) ssd_scan_unit(args, u - 256, wave0);
                  else { const int j = u - 512; fox_unit(args, j & 63, 7 - (j >> 6), lds, wave0); });
            GRID_SYNC();
            T_END(4); T_BEGIN(8);
            { const int n = (lbx() < 128) ? 0 : 2;
              const int ycol = (n == 0) ? C_FQ : C_DQ;
              pg8::Gemm gm{(const bf16_t*)(ws + WS_PROJ) + ycol, (const bf16_t*)(ws + WS_WBR) + (size_t)(layer * 3 + n) * 1024 * 1024, TG, 1024, 1024, LDP};
              pg8::StaticOrder S; S.init(TG, 1024, (int)gridDim.x, lbx() & 127);
              pg8::EpiGate E{(const bf16_t*)(ws + WS_PROJ) + C_MG + n * 1024, (float*)(ws + WS_M32), (bf16_t*)(ws + WS_M16), n};
              pg8::gemm_phase<pg8::EpiGate, pg8::StaticOrder, true, true>(ldsl, gm, S, E, wave0); }
            UNIT_LOOP(CTR + (pass * 3 + 2) * 64, 512, ssd_out_unit(args, layer, u, lds, wave0););
            GRID_SYNC();
            T_END(8); T_BEGIN(16);
            { pg8::Gemm gm{(const bf16_t*)(ws + WS_PROJ) + C_SZ, (const bf16_t*)(ws + WS_WBR) + (size_t)(layer * 3 + 1) * 1024 * 1024, TG, 1024, 1024, LDP};
              pg8::StaticOrder S; S.init(TG, 1024, (int)gridDim.x, lbx());
              pg8::EpiGate E{(const bf16_t*)(ws + WS_PROJ) + C_MG + 1024, (float*)(ws + WS_M32), (bf16_t*)(ws + WS_M16), 1};
              pg8::gemm_phase<pg8::EpiGate, pg8::StaticOrder, true, true>(ldsl, gm, S, E, wave0); }
            GRID_SYNC();
            T_END(16);
        }
        if (lbx() < 128) { pg8::Gemm gm{(const bf16_t*)(ws + WS_M16), (const bf16_t*)(ws + WS_WOUT) + (size_t)layer * 1024 * 1024, TG, 1024, 1024, 1024};
          pg8::StaticOrder S; S.init(TG, 1024, (int)gridDim.x, lbx());
          pg8::EpiRes E{xin + (size_t)(NGRP - 1) * TG * 1024, args.out + (size_t)(NGRP - 1) * TG * 1024};
          pg8::gemm_phase<pg8::EpiRes, pg8::StaticOrder, true, true>(ldsl, gm, S, E, wave0); }
        else { if (layer == 0) norm_rows<true>(args.out, args.in[1] + 1024, (bf16_t*)(ws + WS_H), nullptr, wave0, 0, 3 * TG, lbx() - 128, 128);
               else norm_rows<false>(args.out, args.in[14], nullptr, args.out, wave0, 0, 3 * TG, lbx() - 128, 128); }
        if (TMASK && layer == 1 && blockIdx.x == 0) { const unsigned long long ts = __builtin_amdgcn_s_memrealtime(); while (__builtin_amdgcn_s_memrealtime() - ts < 4ull * t_acc) __builtin_amdgcn_s_sleep(32); }
        GRID_SYNC();
        if (layer == 0) { norm_rows<true>(args.out, args.in[1] + 1024, (bf16_t*)(ws + WS_H), nullptr, wave0, 3 * TG, MT, lbx(), (int)gridDim.x); GRID_SYNC(); }
        else norm_rows<false>(args.out, args.in[14], nullptr, args.out, wave0, 3 * TG, MT, lbx(), (int)gridDim.x);
    }
#undef ws
#undef CTR
}

#undef args
extern "C" void kernel_launch(void* const* d_in, const int* in_sizes, int n_in, void* d_out, int out_size, void* d_ws, size_t ws_size, hipStream_t stream) {
    static int grid = 0;
    if (grid == 0) {
        if (n_in != 15 || out_size != MT * DM || ws_size < WS_END) { fprintf(stderr, "kernel_launch: unexpected shapes (n_in %d out %d ws %zu need %zu)\n", n_in, out_size, ws_size, (size_t)WS_END); grid = -1; return; }
        int dev = 0, cus = 0, per_cu = 0;
        hipGetDevice(&dev); hipDeviceGetAttribute(&cus, hipDeviceAttributeMultiprocessorCount, dev);
        if (hipFuncSetAttribute((const void*)hybrid_fwd, hipFuncAttributeMaxDynamicSharedMemorySize, LDS_BYTES) != hipSuccess) { fprintf(stderr, "kernel_launch: hipFuncSetAttribute failed\n"); grid = -1; return; }
        if (hipOccupancyMaxActiveBlocksPerMultiprocessor(&per_cu, (const void*)hybrid_fwd, NTHR, LDS_BYTES) != hipSuccess || per_cu < 1) { fprintf(stderr, "kernel_launch: occupancy query gave %d\n", per_cu); per_cu = 1; }
        (void)hipGetLastError();
        grid = cus * 1;
    }
    if (grid < 0) return;
    Args a{};
    for (int i = 0; i < 15; ++i) a.in[i] = (const float*)d_in[i];
    a.out = (float*)d_out; a.ws = (unsigned char*)d_ws;
    void* kargs[] = {&a};
    hipError_t e = hipLaunchCooperativeKernel((const void*)hybrid_fwd, dim3(grid), dim3(NTHR), kargs, LDS_BYTES, stream);
    if (e != hipSuccess) fprintf(stderr, "kernel_launch: cooperative launch failed: %s (grid %d)\n", hipGetErrorString(e), grid);
}
```

```cpp
#include <hip/hip_runtime.h>
#include <hip/hip_cooperative_groups.h>
#include <cstdio>
#include <cstdint>
#include <cstddef>
#include <cmath>
namespace cg = cooperative_groups;
namespace pg8 {
#define PG8_LAS __attribute__((address_space(3)))
typedef unsigned short bf16_t;
typedef short bf16x8 __attribute__((ext_vector_type(8)));
typedef float f32x4 __attribute__((ext_vector_type(4)));
typedef unsigned u32x4 __attribute__((ext_vector_type(4)));
constexpr int BM = 256, BK = 64, HALF = 128, HTB = HALF * BK * 2  , STAGE_BYTES = 8 * HTB, NXCD = 8, WGM = 8;

__host__ __device__ __forceinline__ int lds_byte(int r, int c) { const int st = (r >> 4) * 2 + (c >> 5), rr = r & 15, cc = c & 31, ob = rr * 64 + cc * 2; return st * 1024 + (ob ^ (((ob >> 9) & 1) << 5)); }
__host__ __device__ __forceinline__ void stage_rc(int b, int& R, int& C) { const int st = b / 1024, sb = b % 1024, swz = sb ^ (((sb >> 9) & 1) << 5); R = (st >> 1) * 16 + swz / 64; C = (st & 1) * 32 + (swz % 64) / 2; }
__host__ __device__ __forceinline__ int perm32(int rho) { const int n = rho >> 4, i = rho & 15; return 8 * (i >> 2) + 4 * n + (i & 3); }

struct Unit { int pm, pn; };
struct Gemm { const bf16_t* A; const bf16_t* Bt; int M, N, K, lda; };

struct StaticOrder {
    int nM, nN, nwg, G, c;
    __host__ __device__ void init(int M, int N, int G_, int c_) { nM = M / BM; nN = N / BM; nwg = nM * nN; G = G_; c = c_; }
    __host__ __device__ bool next(int i, Unit& u) const {
        const long L = (long)i * G + c; if (L >= nwg) return false;
        int wgid = (int)L; { const int q = nwg / NXCD, r = nwg % NXCD, xcd = wgid % NXCD, off = wgid / NXCD; wgid = (xcd < r ? xcd * (q + 1) : r * (q + 1) + (xcd - r) * q) + off; }
        const int nig = WGM * nN, gid = wgid / nig, fm = gid * WGM, gsz = (nM - fm) < WGM ? (nM - fm) : WGM;
        u.pm = fm + ((wgid % nig) % gsz); u.pn = (wgid % nig) / gsz; return true;
    }
    __device__ __forceinline__ void a_ready(const Unit&) const {}
    __device__ __forceinline__ void done(const Unit&) const {}
};

__device__ __forceinline__ unsigned cvt_pk_bf16(float lo, float hi) { unsigned r; asm volatile("v_cvt_pk_bf16_f32 %0, %1, %2" : "=v"(r) : "v"(lo), "v"(hi)); return r; }

typedef unsigned u32x2 __attribute__((ext_vector_type(2)));
constexpr int LDP = 14336;
__device__ __forceinline__ float silu_f(float v) { return v * __builtin_amdgcn_rcpf(1.0f + __expf(-v)); }
__device__ __forceinline__ float sigm_f(float v) { return __builtin_amdgcn_rcpf(1.0f + __expf(-v)); }
__device__ __forceinline__ float bflo(unsigned w) { return __uint_as_float(w << 16); }
__device__ __forceinline__ float bfhi(unsigned w) { return __uint_as_float(w & 0xffff0000u); }

struct EpiProj {
    static constexpr bool PERM = true, AFTER_DRAIN = false;
    bf16_t* P; float* small; const float* sbias;
    __device__ __forceinline__ void operator()(const f32x4 (&acc)[2][2][4][2], const Unit& u, int wr, int wc, int fr, int fq) const {
        asm volatile("" : "+v"(fr));
        const int row0 = u.pm * BM + wr * 64 + fr;
        if (u.pn < 56) {
            const int pn = u.pn;
            const int mode = (pn < 12) ? 0 : (pn < 20) ? 1 : (pn < 40) ? 0 : (pn < 44) ? 1 : 2;
            const int col0 = pn * BM + wc * 32 + 8 * fq;
#pragma unroll
            for (int ai = 0; ai < 2; ++ai)
#pragma unroll
                for (int m = 0; m < 4; ++m) { bf16_t* rowp = P + (size_t)(row0 + ai * HALF + m * 16) * LDP + col0;
#pragma unroll
                    for (int bj = 0; bj < 2; ++bj) { f32x4 v0 = acc[ai][bj][m][0], v1 = acc[ai][bj][m][1];
                        if (mode == 1) {
#pragma unroll
                            for (int i = 0; i < 4; ++i) { v0[i] = silu_f(v0[i]); v1[i] = silu_f(v1[i]); } }
                        else if (mode == 2) {
#pragma unroll
                            for (int i = 0; i < 4; ++i) { v0[i] = sigm_f(v0[i]); v1[i] = sigm_f(v1[i]); } }
                        u32x4 w; w.x = cvt_pk_bf16(v0[0], v0[1]); w.y = cvt_pk_bf16(v0[2], v0[3]); w.z = cvt_pk_bf16(v1[0], v1[1]); w.w = cvt_pk_bf16(v1[2], v1[3]);
                        *(u32x4*)(rowp + bj * HALF) = w; } }
        } else if (wc == 0) {
            const float* sbp = sbias; asm volatile("" : "+s"(sbp));
            f32x4 bb[2]; bb[0] = *(const f32x4*)(sbp + 8 * fq); bb[1] = *(const f32x4*)(sbp + 8 * fq + 4);
#pragma unroll
            for (int ai = 0; ai < 2; ++ai)
#pragma unroll
                for (int m = 0; m < 4; ++m) { const int row = row0 + ai * HALF + m * 16;
#pragma unroll
                    for (int n = 0; n < 2; ++n) { f32x4 o;
#pragma unroll
                        for (int i = 0; i < 4; ++i) { const int c = 8 * fq + 4 * n + i; const float v = acc[ai][0][m][n][i];
                            const float xx = v + bb[n][i];
                            const float sp = __logf(1.0f + __expf(-fabsf(xx)));
                            o[i] = (c < 16) ? (fminf(xx, 0.f) - sp) : (fmaxf(xx, 0.f) + sp); }
                        *(f32x4*)(small + (size_t)row * 32 + 8 * fq + 4 * n) = o; } }
        }
    }
};
struct EpiGate {
    static constexpr bool PERM = false, AFTER_DRAIN = false;
    const bf16_t* gate; float* m32; bf16_t* m16; int nidx;
    __device__ __forceinline__ void operator()(const f32x4 (&acc)[2][2][4][2], const Unit& u, int wr, int wc, int fr, int fq) const {
        asm volatile("" : "+v"(fr));
        const int row0 = u.pm * BM + wr * 64 + fr, col0 = u.pn * BM + wc * 32 + 4 * fq;
        u32x2 gw[2][4]; f32x4 mv[2][4]; u32x2 hv[2][4];
#define EG_LOAD(c_, s_) do { const int row_ = row0 + ((c_) >> 2) * HALF + ((c_) & 3) * 16; \
        _Pragma("unroll") for (int e_ = 0; e_ < 4; ++e_) { const int col_ = col0 + (e_ >> 1) * HALF + (e_ & 1) * 16; \
            gw[s_][e_] = *(const u32x2*)(gate + (size_t)row_ * LDP + col_); \
            if (nidx == 1) { mv[s_][e_] = *(const f32x4*)(m32 + (size_t)row_ * 1024 + col_); hv[s_][e_] = *(const u32x2*)(m16 + (size_t)row_ * 1024 + col_); } } } while (0)
        EG_LOAD(0, 0);
#pragma unroll
        for (int c = 0; c < 8; ++c) {
            if (c + 1 < 8) EG_LOAD(c + 1, (c + 1) & 1);
            const int ai = c >> 2, m = c & 3, row = row0 + ai * HALF + m * 16;
#pragma unroll
            for (int e = 0; e < 4; ++e) { const int bj = e >> 1, n = e & 1, col = col0 + bj * HALF + n * 16;
                const u32x2 g2 = gw[c & 1][e];
                f32x4 v = acc[ai][bj][m][n];
                v[0] *= bflo(g2.x); v[1] *= bfhi(g2.x); v[2] *= bflo(g2.y); v[3] *= bfhi(g2.y);
                if (nidx == 0) *(f32x4*)(m32 + (size_t)row * 1024 + col) = v;
                else { if (nidx == 1) { const u32x2 t2 = hv[c & 1][e]; v += mv[c & 1][e]; v[0] += bflo(t2.x); v[1] += bfhi(t2.x); v[2] += bflo(t2.y); v[3] += bfhi(t2.y); }
                    u32x2 w; w.x = cvt_pk_bf16(v[0], v[1]); w.y = cvt_pk_bf16(v[2], v[3]); *(u32x2*)(m16 + (size_t)row * 1024 + col) = w; } }
        }
#undef EG_LOAD
    }
};
struct EpiRes {
    static constexpr bool PERM = false, AFTER_DRAIN = false;
    const float* xin; float* out;
    __device__ __forceinline__ void operator()(const f32x4 (&acc)[2][2][4][2], const Unit& u, int wr, int wc, int fr, int fq) const {
        asm volatile("" : "+v"(fr));
        const int row0 = u.pm * BM + wr * 64 + fr, col0 = u.pn * BM + wc * 32 + 4 * fq;
        f32x4 bx[2][4];
#define ER_LOAD(c_, s_) do { const size_t off_ = (size_t)(row0 + ((c_) >> 2) * HALF + ((c_) & 3) * 16) * 1024 + col0; \
        _Pragma("unroll") for (int e_ = 0; e_ < 4; ++e_) bx[s_][e_] = *(const f32x4*)(xin + off_ + (e_ >> 1) * HALF + (e_ & 1) * 16); } while (0)
        ER_LOAD(0, 0);
#pragma unroll
        for (int c = 0; c < 8; ++c) {
            if (c + 1 < 8) ER_LOAD(c + 1, (c + 1) & 1);
            const int ai = c >> 2, m = c & 3; const size_t off = (size_t)(row0 + ai * HALF + m * 16) * 1024 + col0;
#pragma unroll
            for (int e = 0; e < 4; ++e) { const int bj = e >> 1, n = e & 1; *(f32x4*)(out + off + bj * HALF + n * 16) = bx[c & 1][e] + acc[ai][bj][m][n]; }
        }
#undef ER_LOAD
    }
};
template <class Epi, class Sched, bool ALIGN_EPI = false, bool SP2 = false>
__device__ __forceinline__ void gemm_phase(PG8_LAS unsigned char* lds, const Gemm g, const Sched& S, const Epi& E, int w0) {
    int lane_; asm volatile("v_mbcnt_lo_u32_b32 %0, -1, 0\n\tv_mbcnt_hi_u32_b32 %0, -1, %0" : "=v"(lane_)); int wid = w0; asm volatile("" : "+s"(wid)); const int tid = wid * 64 + lane_, lane = tid & 63, wr = wid >> 2, wc = wid & 3, fr = lane & 15, fq = lane >> 4;
    const int K = g.K, nt = K / BK;
    unsigned voffA[2], voffB[2];
#pragma unroll
    for (int i = 0; i < 2; ++i) { int R, C; stage_rc(tid * 16 + i * 8192, R, C); const int Rb = Epi::PERM ? ((R & ~31) + perm32(R & 31)) : R;
        voffA[i] = (unsigned)(R * g.lda + C) * 2u; voffB[i] = (unsigned)(Rb * K + C) * 2u; }
    const size_t kstep = (size_t)(BK * 2);
    const size_t hstepA = (size_t)HALF * g.lda * 2, hstepB = (size_t)HALF * K * 2;
    const size_t tstepA = 2 * hstepA, tstepB = 2 * hstepB;
    const unsigned ldsw = (unsigned)wid * 1024u;
    const int aoff = lds_byte(wr * 64 + fr, fq * 8), boff = lds_byte(wc * 32 + fr, fq * 8);
#define PG8_SA(b, h) (((b) * 2 + (h)) * HTB)
#define PG8_SB(b, h) ((4 + (b) * 2 + (h)) * HTB)
#define PG8_STAGE(bufoff, gbase, voff) do { _Pragma("unroll") for (int _i = 0; _i < 2; ++_i) \
        __builtin_amdgcn_global_load_lds((const unsigned*)((const char*)(gbase) + (voff)[_i]), (PG8_LAS unsigned*)(lds + (bufoff) + ldsw + _i * 8192), 16, 0, 0); } while (0)
#define PG8_LDA(dst, b, h) do { _Pragma("unroll") for (int m = 0; m < 4; ++m) _Pragma("unroll") for (int k = 0; k < 2; ++k) dst[m][k] = *(const PG8_LAS bf16x8*)(lds + PG8_SA(b, h) + aoff + m * 2048 + k * 1024); } while (0)
#define PG8_LDB(dst, b, h) do { _Pragma("unroll") for (int n = 0; n < 2; ++n) _Pragma("unroll") for (int k = 0; k < 2; ++k) dst[n][k] = *(const PG8_LAS bf16x8*)(lds + PG8_SB(b, h) + boff + n * 2048 + k * 1024); } while (0)
#define PG8_MMA(ai, bj, At, Bt) do { __builtin_amdgcn_s_setprio(1); _Pragma("unroll") for (int m = 0; m < 4; ++m) _Pragma("unroll") for (int n = 0; n < 2; ++n) _Pragma("unroll") for (int k = 0; k < 2; ++k) \
        acc[ai][bj][m][n] = __builtin_amdgcn_mfma_f32_16x16x32_bf16(Bt[n][k], At[m][k], acc[ai][bj][m][n], 0, 0, 0); __builtin_amdgcn_s_setprio(0); } while (0)
#define PG8_WAIT_V(n) asm volatile("s_waitcnt vmcnt(" #n ")" ::: "memory")
#define PG8_WAIT_L(n) asm volatile("s_waitcnt lgkmcnt(" #n ")" ::: "memory")
#define PG8_BAR __builtin_amdgcn_s_barrier()
#define PG8_SCHED __builtin_amdgcn_sched_barrier(0)
    Unit cur, nxt; int ui = 0;
    if (!S.next(0, cur)) return;
    f32x4 acc[2][2][4][2];
#pragma unroll
    for (int a = 0; a < 2; ++a)
#pragma unroll
        for (int b = 0; b < 2; ++b)
#pragma unroll
            for (int m = 0; m < 4; ++m)
#pragma unroll
                for (int n = 0; n < 2; ++n) acc[a][b][m][n] = (f32x4){0.f, 0.f, 0.f, 0.f};
    bf16x8 At[4][2], B0[2][2], B1[2][2];
    const char* cA = (const char*)g.A + (size_t)cur.pm * tstepA; const char* cB = (const char*)g.Bt + (size_t)cur.pn * tstepB;
    S.a_ready(cur);
    if constexpr (SP2) {
        PG8_STAGE(PG8_SB(0, 0), cB, voffB); PG8_STAGE(PG8_SB(0, 1), cB + hstepB, voffB); PG8_STAGE(PG8_SA(0, 0), cA, voffA); PG8_STAGE(PG8_SA(0, 1), cA + hstepA, voffA);
        if (wr == 1) PG8_BAR;
        PG8_WAIT_V(2); PG8_BAR;
        PG8_STAGE(PG8_SB(1, 0), cB + kstep, voffB); PG8_STAGE(PG8_SA(1, 0), cA + kstep, voffA); PG8_STAGE(PG8_SB(1, 1), cB + hstepB + kstep, voffB);
        PG8_WAIT_V(6); PG8_BAR;
    } else {
        PG8_STAGE(PG8_SB(0, 0), cB, voffB); PG8_STAGE(PG8_SA(0, 0), cA, voffA); PG8_STAGE(PG8_SB(0, 1), cB + hstepB, voffB); PG8_STAGE(PG8_SA(0, 1), cA + hstepA, voffA);
        if (wr == 1) PG8_BAR;
        PG8_WAIT_V(4); PG8_BAR;
        PG8_STAGE(PG8_SB(1, 0), cB + kstep, voffB); PG8_STAGE(PG8_SA(1, 0), cA + kstep, voffA); PG8_STAGE(PG8_SB(1, 1), cB + hstepB + kstep, voffB);
        PG8_WAIT_V(6); PG8_BAR;
    }
    for (;;) {
        const bool has_next = S.next(ui + 1, nxt);
        const char* nA = has_next ? (const char*)g.A + (size_t)nxt.pm * tstepA : cA; const char* nB = has_next ? (const char*)g.Bt + (size_t)nxt.pn * tstepB : cB;
        for (int t = 0; t < nt; t += 2) {
            const bool last = (t == nt - 2);
            const char* a1 = cA + (size_t)(t + 1) * kstep;
            const char* a2 = last ? nA : cA + (size_t)(t + 2) * kstep; const char* b2 = last ? nB : cB + (size_t)(t + 2) * kstep;
            const char* a3 = a2 + kstep; const char* b3 = b2 + kstep;
            if (last && has_next) S.a_ready(nxt);
            if constexpr (SP2) {
            PG8_LDB(B0, 0, 0); PG8_LDB(B1, 0, 1); PG8_SCHED; PG8_LDA(At, 0, 0); PG8_STAGE(PG8_SA(1, 1), a1 + hstepA, voffA);
            PG8_WAIT_V(8); PG8_WAIT_L(0); PG8_BAR; PG8_MMA(0, 0, At, B0); PG8_MMA(0, 1, At, B1); PG8_BAR; PG8_SCHED;
            PG8_LDA(At, 0, 1); PG8_STAGE(PG8_SB(0, 0), b2, voffB); PG8_STAGE(PG8_SB(0, 1), b2 + hstepB, voffB); PG8_STAGE(PG8_SA(0, 0), a2, voffA);
            PG8_WAIT_V(8); PG8_WAIT_L(0); PG8_BAR; PG8_MMA(1, 0, At, B0); PG8_MMA(1, 1, At, B1); PG8_BAR; PG8_SCHED;
            PG8_LDB(B0, 1, 0); PG8_LDB(B1, 1, 1); PG8_SCHED; PG8_LDA(At, 1, 0); PG8_STAGE(PG8_SA(0, 1), a2 + hstepA, voffA);
            PG8_WAIT_V(8); PG8_WAIT_L(0); PG8_BAR; PG8_MMA(0, 0, At, B0); PG8_MMA(0, 1, At, B1); PG8_BAR; PG8_SCHED;
            PG8_LDA(At, 1, 1); PG8_STAGE(PG8_SB(1, 0), b3, voffB); PG8_STAGE(PG8_SB(1, 1), b3 + hstepB, voffB); PG8_STAGE(PG8_SA(1, 0), a3, voffA);
            PG8_WAIT_V(8); PG8_WAIT_L(0); PG8_BAR; PG8_MMA(1, 0, At, B0); PG8_MMA(1, 1, At, B1); PG8_BAR; PG8_SCHED;
            } else {
            PG8_LDB(B0, 0, 0); PG8_SCHED; PG8_LDA(At, 0, 0); PG8_STAGE(PG8_SA(1, 1), a1 + hstepA, voffA);
            PG8_WAIT_L(8); PG8_BAR; PG8_WAIT_L(0); PG8_MMA(0, 0, At, B0); PG8_BAR; PG8_SCHED;
            PG8_LDB(B1, 0, 1); PG8_STAGE(PG8_SB(0, 0), b2, voffB);
            PG8_BAR; PG8_WAIT_L(0); PG8_MMA(0, 1, At, B1); PG8_BAR;
            PG8_LDA(At, 0, 1); PG8_STAGE(PG8_SA(0, 0), a2, voffA);
            PG8_BAR; PG8_WAIT_L(0); PG8_MMA(1, 0, At, B0); PG8_BAR; PG8_SCHED;
            PG8_STAGE(PG8_SB(0, 1), b2 + hstepB, voffB);
            PG8_WAIT_V(6); PG8_BAR; PG8_MMA(1, 1, At, B1); PG8_BAR;
            PG8_LDB(B0, 1, 0); PG8_SCHED; PG8_LDA(At, 1, 0); PG8_STAGE(PG8_SA(0, 1), a2 + hstepA, voffA);
            PG8_WAIT_L(8); PG8_BAR; PG8_WAIT_L(0); PG8_MMA(0, 0, At, B0); PG8_BAR; PG8_SCHED;
            PG8_LDB(B1, 1, 1); PG8_STAGE(PG8_SB(1, 0), b3, voffB);
            PG8_BAR; PG8_WAIT_L(0); PG8_MMA(0, 1, At, B1); PG8_BAR;
            PG8_LDA(At, 1, 1); PG8_STAGE(PG8_SA(1, 0), a3, voffA);
            PG8_BAR; PG8_WAIT_L(0); PG8_MMA(1, 0, At, B0); PG8_BAR; PG8_SCHED;
            PG8_STAGE(PG8_SB(1, 1), b3 + hstepB, voffB);
            PG8_WAIT_V(6); PG8_BAR; PG8_MMA(1, 1, At, B1); PG8_BAR;
            }
        }
        if constexpr (ALIGN_EPI) { if (wr == 0) PG8_BAR; }
        if constexpr (!Epi::AFTER_DRAIN) { E(acc, cur, wr, wc, fr, fq); S.done(cur); }
        if (!has_next) break;
#pragma unroll
        for (int a = 0; a < 2; ++a)
#pragma unroll
            for (int b = 0; b < 2; ++b)
#pragma unroll
                for (int m = 0; m < 4; ++m)
#pragma unroll
                    for (int n = 0; n < 2; ++n) acc[a][b][m][n] = (f32x4){0.f, 0.f, 0.f, 0.f};
        cur = nxt; cA = nA; cB = nB; ++ui;
        if constexpr (ALIGN_EPI) { if (wr == 1) PG8_BAR; }
    }
    PG8_WAIT_V(0);
    if constexpr (!ALIGN_EPI) { if (wr == 0) PG8_BAR; }
    PG8_BAR;
    if constexpr (Epi::AFTER_DRAIN) { E.fused(acc, cur, wr, wc, fr, fq, lds, wid, lane); S.done(cur); }
#undef PG8_SA
#undef PG8_SB
#undef PG8_STAGE
#undef PG8_LDA
#undef PG8_LDB
#undef PG8_MMA
#undef PG8_WAIT_V
#undef PG8_WAIT_L
#undef PG8_BAR
#undef PG8_SCHED
}
}

#define LAS __attribute__((address_space(3)))
typedef unsigned short bf16_t;
typedef short bf16x8 __attribute__((ext_vector_type(8)));
typedef short v4i16_t __attribute__((ext_vector_type(4)));
typedef float f32x4 __attribute__((ext_vector_type(4)));
typedef float f32x16 __attribute__((ext_vector_type(16)));
typedef unsigned u32x4 __attribute__((ext_vector_type(4)));
typedef unsigned u32x2 __attribute__((ext_vector_type(2)));
typedef float f32x2 __attribute__((ext_vector_type(2)));

constexpr int DM = 1024, SEQ = 2048, NBATCH = 16, MT = NBATCH * SEQ;
constexpr int GB = 4, TG = GB * SEQ, NGRP = NBATCH / GB;
constexpr int LDP = pg8::LDP, NP = 14592, NIN = 14368;
constexpr int C_FQ = 0, C_FK = 1024, C_FV = 2048, C_FG = 3072, C_SZ = 4096, C_XBC = 5120, C_DQ = 7168, C_DK = 8192, C_DV = 9216, C_DG = 10240, C_MG = 11264;
constexpr float EPS = 1e-6f, LOG2E = 1.4426950408889634f, C2 = 0.125f * 1.4426950408889634f;
constexpr int NTHR = 512, NWAVES = 8;
constexpr int LDS_BYTES = 147456, LDS_MISC = 131072 + 8192;

constexpr size_t WS_CTR = 0, WS_BAR = 32768, WS_ROPE = 65536, WS_LAM = WS_ROPE + 131072, WS_WIN = 1u << 20;
constexpr size_t WS_WBR = WS_WIN + (size_t)2 * NP * 1024 * 2;
constexpr size_t WS_WOUT = WS_WBR + (size_t)6 * 1024 * 1024 * 2;
constexpr size_t WS_H = WS_WOUT + (size_t)2 * 1024 * 1024 * 2;
constexpr size_t WS_PROJ = WS_H + (size_t)MT * 1024 * 2;
constexpr size_t WS_SMALL = WS_PROJ + (size_t)TG * LDP * 2;
constexpr size_t WS_F2 = WS_SMALL + (size_t)TG * 32 * 4;
constexpr size_t WS_CD = WS_F2 + (size_t)GB * 16 * SEQ * 4;
constexpr size_t WS_M32 = WS_CD + 65536;
constexpr size_t WS_M16 = WS_M32 + (size_t)TG * 1024 * 4;
constexpr size_t WS_ST = WS_M16 + (size_t)TG * 1024 * 2;
constexpr size_t WS_PREV = WS_ST + (size_t)GB * 32 * 16 * 8192 * 2;
constexpr size_t WS_END = WS_ST + (size_t)GB * 32 * 16 * 8192 * 4;

struct Args { const float* in[15]; float* out; unsigned char* ws; };

__device__ __forceinline__ unsigned f2bf(float f) { unsigned u = __builtin_bit_cast(unsigned, f); return (u + 0x7fffu + ((u >> 16) & 1u)) >> 16; }
__device__ __forceinline__ unsigned pk2(float lo, float hi) { return pg8::cvt_pk_bf16(lo, hi); }
typedef __bf16 bf16x2_t __attribute__((ext_vector_type(2)));
__device__ __forceinline__ unsigned pk2m(float lo, float hi) { const f32x2 v = {lo, hi}; return __builtin_bit_cast(unsigned, __builtin_convertvector(v, bf16x2_t)); }
__device__ __forceinline__ float bflo(unsigned w) { return __uint_as_float(w << 16); }
__device__ __forceinline__ float bfhi(unsigned w) { return __uint_as_float(w & 0xffff0000u); }
__device__ __forceinline__ float bf1(bf16_t b) { return __uint_as_float(((unsigned)b) << 16); }
__device__ __forceinline__ float lx_xor(float v, int mask, int lane) { return __int_as_float(__builtin_amdgcn_ds_bpermute((lane ^ mask) << 2, __float_as_int(v))); }
__device__ __forceinline__ float lx_up(float v, int d, int lane) { return __int_as_float(__builtin_amdgcn_ds_bpermute((lane - d) << 2, __float_as_int(v))); }
__device__ __forceinline__ float wave_sum(float v, int lane) {
#pragma unroll
    for (int o = 1; o < 64; o <<= 1) v += lx_xor(v, o, lane);
    return v;
}
__device__ __forceinline__ int crow(int r, int hi) { return (r & 3) + 8 * (r >> 2) + 4 * hi; }
#define LDS_WAIT() asm volatile("s_waitcnt lgkmcnt(0)" ::: "memory")
#define THREAD_IDS() int lane; asm volatile("v_mbcnt_lo_u32_b32 %0, -1, 0\n\tv_mbcnt_hi_u32_b32 %0, -1, %0" : "=v"(lane)); int wave = w0; asm volatile("" : "+s"(wave)); const int tid = wave * 64 + lane; (void)tid
#define MFMA32(a, b, c) __builtin_amdgcn_mfma_f32_32x32x16_bf16((a), (b), (c), 0, 0, 0)
#define MFMA16(a, b, c) __builtin_amdgcn_mfma_f32_16x16x32_bf16((a), (b), (c), 0, 0, 0)

__device__ __forceinline__ int lbx() { int b = (int)blockIdx.x; asm volatile("" : "+s"(b)); return b; }
#define GAS __attribute__((address_space(1)))
__device__ __forceinline__ unsigned char* wsl(unsigned char* p) { GAS unsigned char* q = (GAS unsigned char*)p; asm volatile("" : "+s"(q)); return (unsigned char*)q; }
__device__ __forceinline__ int q_draw(unsigned* ctr, int w0) { int v = 0; if (w0 == 0) { int lane; asm volatile("v_mbcnt_lo_u32_b32 %0, -1, 0\n\tv_mbcnt_hi_u32_b32 %0, -1, %0" : "=v"(lane)); if (lane == 0) v = (int)atomicAdd(ctr, 1u); } return v; }
__device__ __forceinline__ int q_pub(int drawn, unsigned char* lds, int w0) {
    volatile int* slot = (volatile int*)(lds + LDS_MISC);
    __syncthreads();
    if (w0 == 0) { int lane; asm volatile("v_mbcnt_lo_u32_b32 %0, -1, 0\n\tv_mbcnt_hi_u32_b32 %0, -1, %0" : "=v"(lane)); if (lane == 0) *slot = drawn; }
    __syncthreads();
    return *slot;
}
#define UNIT_LOOP(ctr_, total_, body_) do { unsigned* c__ = (ctr_); \
    for (;;) { const int d__ = q_draw(c__, wave0); const int u = q_pub(d__, lds, wave0); if (u >= (total_)) break; body_ } } while (0)

__device__ __forceinline__ int win_src_col(int n) {
    if (n < 3072) return n;
    if (n < 7168) return n + 16;
    if (n < 14336) return n + 32;
    if (n < 14352) return 3072 + (n - 14336);
    if (n < 14368) return 7184 + (n - 14352);
    return -1;
}
template <bool MAP> __device__ __forceinline__ void transpose_item(const float* W, int K, int Nsrc, bf16_t* WT, float* scr, int kb, int nb, int lane) {
    const int k0 = 64 * kb, n0 = 32 * nb;
    const int nn = n0 + (lane & 31); const int src = MAP ? win_src_col(nn) : nn;
#pragma unroll
    for (int i = 0; i < 32; ++i) { const int kk = 2 * i + (lane >> 5); scr[kk * 33 + (lane & 31)] = (src >= 0) ? W[(size_t)(k0 + kk) * Nsrc + src] : 0.f; }
    LDS_WAIT();
    const int c = lane & 7;
#pragma unroll
    for (int j = 0; j < 4; ++j) { const int n = (lane >> 3) + 8 * j; const float* s = scr + (8 * c) * 33 + n;
        u32x4 o; o.x = pk2(s[0 * 33], s[1 * 33]); o.y = pk2(s[2 * 33], s[3 * 33]); o.z = pk2(s[4 * 33], s[5 * 33]); o.w = pk2(s[6 * 33], s[7 * 33]);
        *(u32x4*)(WT + (size_t)(n0 + n) * K + k0 + 8 * c) = o; }
    LDS_WAIT();
}
__device__ __forceinline__ void p0_prologue(const Args& a, unsigned char* lds, int w0) {
    THREAD_IDS();
    unsigned char* ws = wsl(a.ws);
    float* scr = (float*)(lds + wave * 8448);
    const int gw = blockIdx.x * NWAVES + wave, NGW = gridDim.x * NWAVES;
    constexpr int I_IN = 16 * (NP / 32), I_SQ = 16 * 32;
    constexpr int NITEMS = 2 * I_IN + 8 * I_SQ;
    for (int it = gw; it < NITEMS; it += NGW) {
        int r = it;
        if (r < 2 * I_IN) { const int layer = r / I_IN; r -= layer * I_IN;
            transpose_item<true>(a.in[2] + (size_t)layer * 1024 * NIN, 1024, NIN, (bf16_t*)(ws + WS_WIN) + (size_t)layer * NP * 1024, scr, r / (NP / 32), r % (NP / 32), lane); continue; }
        r -= 2 * I_IN;
        if (r < 6 * I_SQ) { const int mi = r / I_SQ; r -= mi * I_SQ;
            transpose_item<false>(a.in[12] + (size_t)mi * 1024 * 1024, 1024, 1024, (bf16_t*)(ws + WS_WBR) + (size_t)mi * 1024 * 1024, scr, r / 32, r % 32, lane); continue; }
        r -= 6 * I_SQ;
        { const int mi = r / I_SQ; r -= mi * I_SQ;
            transpose_item<false>(a.in[13] + (size_t)mi * 1024 * 1024, 1024, 1024, (bf16_t*)(ws + WS_WOUT) + (size_t)mi * 1024 * 1024, scr, r / 32, r % 32, lane); }
    }
    for (int idx = blockIdx.x * NTHR + tid; idx < SEQ * 8; idx += gridDim.x * NTHR) {
        const int pos = idx >> 3, i = idx & 7;
        const float inv = powf(500000.0f, -(float)(2 * i) / 16.0f);
        const float ang = (float)pos * inv;
        ((f32x2*)(ws + WS_ROPE))[idx] = (f32x2){cosf(ang), sinf(ang)};
    }
    if (blockIdx.x == 0) {
        if (tid < 128) ((unsigned*)(ws + WS_CTR))[tid * 64] = 0u;
        if (tid >= 128 && tid < 192) { const int k = tid - 128, layer = k >> 5, c = k & 31;
            ((float*)(ws + WS_LAM))[16 + k] = (c < 16) ? a.in[3][layer * 16 + c] : a.in[6][layer * 16 + c - 16]; }
        if (tid >= 64 && tid < 66) { const int layer = tid - 64; const float* lp = a.in[10] + layer * 256;
            float s1 = 0.f, s2 = 0.f;
            for (int d = 0; d < 64; ++d) { s1 += lp[d] * lp[64 + d]; s2 += lp[128 + d] * lp[192 + d]; }
            const float li = 0.8f - 0.6f * expf(-0.3f * (float)layer);
            ((float*)(ws + WS_LAM))[layer * 2] = expf(s1) - expf(s2) + li; ((float*)(ws + WS_LAM))[layer * 2 + 1] = li; }
    }
}
template <bool TOBF> __device__ __forceinline__ void norm_rows(const float* X, const float* w, bf16_t* ob, float* of, int w0, int r0 = 0, int r1 = MT, int vb = -1, int nvb = 0) {
    THREAD_IDS();
    if (vb < 0) { vb = (int)blockIdx.x; nvb = (int)gridDim.x; }
    const int gw = vb * NWAVES + wave, NGW = nvb * NWAVES;
    f32x4 wv[4];
#pragma unroll
    for (int j = 0; j < 4; ++j) wv[j] = ((const f32x4*)w)[64 * j + lane];
    for (int m = r0 + gw; m < r1; m += 2 * NGW) {
        const int m2 = m + NGW;
        const f32x4* xr = (const f32x4*)(X + (size_t)m * DM) + lane; const f32x4* xr2 = (const f32x4*)(X + (size_t)m2 * DM) + lane;
        f32x4 v[4], v2[4]; float s = 0.f, s2 = 0.f;
#pragma unroll
        for (int j = 0; j < 4; ++j) { v[j] = xr[64 * j]; v2[j] = xr2[64 * j]; }
#pragma unroll
        for (int j = 0; j < 4; ++j) { s += (v[j].x * v[j].x + v[j].y * v[j].y) + (v[j].z * v[j].z + v[j].w * v[j].w); s2 += (v2[j].x * v2[j].x + v2[j].y * v2[j].y) + (v2[j].z * v2[j].z + v2[j].w * v2[j].w); }
        const float rs = rsqrtf(wave_sum(s, lane) * (1.0f / DM) + EPS), rs2 = rsqrtf(wave_sum(s2, lane) * (1.0f / DM) + EPS);
#pragma unroll
        for (int j = 0; j < 4; ++j) { const f32x4 o = v[j] * rs * wv[j], o2 = v2[j] * rs2 * wv[j];
            if (TOBF) { u32x2 p; p.x = pk2(o.x, o.y); p.y = pk2(o.z, o.w); ((u32x2*)(ob + (size_t)m * DM))[64 * j + lane] = p;
                        u32x2 q; q.x = pk2(o2.x, o2.y); q.y = pk2(o2.z, o2.w); ((u32x2*)(ob + (size_t)m2 * DM))[64 * j + lane] = q; }
            else { ((f32x4*)(of + (size_t)m * DM))[64 * j + lane] = o; ((f32x4*)(of + (size_t)m2 * DM))[64 * j + lane] = o2; } }
    }
}

constexpr int SL_ACS = 0, SL_DT = 1024, SL_PART = 2048, SL_XT = 4096, SL_B = SL_XT + 256 * 144, SL_C = SL_B + 18432;
constexpr int XTP = 144, BNP = 272;

__device__ __forceinline__ void ssd_acs(unsigned char* lds, const float* small, size_t row0, int g, const float* a_log, int wave, int lane) {
    if (wave < 4) {
        const int h = 4 * g + wave;
        const float dt = small[(row0 + lane) * 32 + 16 + h];
        float v = -expf(a_log[h]) * dt;
#pragma unroll
        for (int o = 1; o < 64; o <<= 1) { const float t = lx_up(v, o, lane); if (lane >= o) v += t; }
        ((float*)(lds + SL_ACS))[wave * 64 + lane] = v;
        ((float*)(lds + SL_DT))[wave * 64 + lane] = dt;
    }
}
__device__ __forceinline__ void conv_load(u32x4 (&raw)[11], f32x4 (&wv)[10], const bf16_t* xb, int pg, int c, const float* cw, const float* cb) {
#pragma unroll
    for (int i = 0; i < 11; ++i) { const int rr = pg * 8 - 3 + i;
        if (rr >= 0 || c > 0) raw[i] = *(const u32x4*)(xb + (ptrdiff_t)rr * LDP); else raw[i] = (u32x4){0u, 0u, 0u, 0u}; }
#pragma unroll
    for (int k = 0; k < 4; ++k) { wv[2 * k] = *(const f32x4*)(cw + k * 2048); wv[2 * k + 1] = *(const f32x4*)(cw + k * 2048 + 4); }
    wv[8] = *(const f32x4*)cb; wv[9] = *(const f32x4*)(cb + 4);
}
__device__ __forceinline__ void conv_compute(float (&out)[8][8], const u32x4 (&raw)[11], const f32x4 (&wv)[10]) {
#pragma unroll
    for (int p = 0; p < 8; ++p) {
#pragma unroll
        for (int ch = 0; ch < 8; ++ch) { float s = wv[8 + (ch >> 2)][ch & 3];
#pragma unroll
            for (int k = 0; k < 4; ++k) { const unsigned wd = raw[p + k][ch >> 1]; const float u = (ch & 1) ? bfhi(wd) : bflo(wd); s += wv[2 * k + (ch >> 2)][ch & 3] * u; }
            out[p][ch] = pg8::silu_f(s); }
    }
}
__device__ __forceinline__ void put_T(unsigned char* img, int chrow0, int s0, const float (&v)[8][8]) {
#pragma unroll
    for (int ch = 0; ch < 8; ++ch) { u32x4 o; o.x = pk2(v[0][ch], v[1][ch]); o.y = pk2(v[2][ch], v[3][ch]); o.z = pk2(v[4][ch], v[5][ch]); o.w = pk2(v[6][ch], v[7][ch]);
        *(u32x4*)(img + (chrow0 + ch) * XTP + s0 * 2) = o; }
}
__device__ __forceinline__ void put_N(unsigned char* img, int n0, int s0, const float (&v)[8][8]) {
#pragma unroll
    for (int p = 0; p < 8; ++p) { u32x4 o; o.x = pk2(v[p][0], v[p][1]); o.y = pk2(v[p][2], v[p][3]); o.z = pk2(v[p][4], v[p][5]); o.w = pk2(v[p][6], v[p][7]);
        *(u32x4*)(img + (s0 + p) * BNP + n0 * 2) = o; }
}

__device__ __forceinline__ void ssd_states_unit(const Args& a, int layer, int u, unsigned char* lds, int w0) {
    THREAD_IDS();
    const int g = u & 3, c = (u >> 2) & 31, bl = u >> 7;
    unsigned char* ws = wsl(a.ws);
    const bf16_t* PROJ = (const bf16_t*)(ws + WS_PROJ);
    const size_t row0 = (size_t)bl * SEQ + c * 64;
    const int cgi = tid & 63, pg = tid >> 6;
    const int chx = (cgi < 32) ? (g * 256 + cgi * 8) : (1024 + g * 128 + ((cgi < 48 ? cgi : 32) - 32) * 8);
    u32x4 raw[11]; f32x4 wv[10];
    if (cgi < 48) conv_load(raw, wv, PROJ + row0 * LDP + C_XBC + chx, pg, c, a.in[4] + (size_t)layer * 4 * 2048 + chx, a.in[5] + layer * 2048 + chx);
    ssd_acs(lds, (const float*)(ws + WS_SMALL), row0, g, a.in[7] + layer * 16, wave, lane);
    __syncthreads();
    const float* ACS = (const float*)(lds + SL_ACS); const float* DTL = (const float*)(lds + SL_DT);
    if (cgi < 48) {
        float v[8][8];
        conv_compute(v, raw, wv);
        if (cgi < 32) { const int hh = cgi >> 3; const float al = ACS[hh * 64 + 63];
#pragma unroll
            for (int p = 0; p < 8; ++p) { const int s = pg * 8 + p; const float sc = __expf(al - ACS[hh * 64 + s]) * DTL[hh * 64 + s];
#pragma unroll
                for (int ch = 0; ch < 8; ++ch) v[p][ch] *= sc; }
            put_T(lds + SL_XT, cgi * 8, pg * 8, v);
        } else put_T(lds + SL_B, (cgi - 32) * 8, pg * 8, v);
    }
    __syncthreads();
    const int fr = lane & 15, fq = lane >> 4, hh = wave >> 1, nh = wave & 1;
    f32x4 acc[4][4];
#pragma unroll
    for (int i = 0; i < 4; ++i)
#pragma unroll
        for (int j = 0; j < 4; ++j) acc[i][j] = (f32x4){0.f, 0.f, 0.f, 0.f};
    {   bf16x8 af[2][4], bf[2][4];
#pragma unroll
        for (int ks = 0; ks < 2; ++ks) {
#pragma unroll
            for (int i = 0; i < 4; ++i) af[ks][i] = *(const bf16x8*)(lds + SL_B + (64 * nh + 16 * i + fr) * XTP + (32 * ks + 8 * fq) * 2);
#pragma unroll
            for (int j = 0; j < 4; ++j) bf[ks][j] = *(const bf16x8*)(lds + SL_XT + (hh * 64 + 16 * j + fr) * XTP + (32 * ks + 8 * fq) * 2); }
        __builtin_amdgcn_sched_barrier(0);
#pragma unroll
        for (int ks = 0; ks < 2; ++ks)
#pragma unroll
            for (int i = 0; i < 4; ++i)
#pragma unroll
                for (int j = 0; j < 4; ++j) acc[i][j] = MFMA16(af[ks][i], bf[ks][j], acc[i][j]);
    }
    const int h = 4 * g + hh;
    bf16_t* ST = (bf16_t*)(ws + WS_ST) + ((size_t)(bl * 32 + c) * 16 + h) * 8192;
#pragma unroll
    for (int i = 0; i < 4; ++i)
#pragma unroll
        for (int j = 0; j < 4; ++j) { u32x2 w; w.x = pk2m(acc[i][j][0], acc[i][j][1]); w.y = pk2m(acc[i][j][2], acc[i][j][3]);
            *(u32x2*)(ST + (16 * j + fr) * 128 + 64 * nh + 16 * i + 4 * fq) = w; }
    if (tid < 4) ((float*)(ws + WS_CD))[(bl * 32 + c) * 16 + 4 * g + tid] = __expf(ACS[tid * 64 + 63]);
}

__device__ __forceinline__ void ssd_scan_unit(const Args& a, int u, int w0) {
    THREAD_IDS();
    const int qt = u & 3, h = (u >> 2) & 15, bl = u >> 6;
    const bf16_t* ST = (const bf16_t*)(wsl(a.ws) + WS_ST); bf16_t* PV = (bf16_t*)(wsl(a.ws) + WS_PREV); const float* CD = (const float*)(wsl(a.ws) + WS_CD);
    const int e = qt * 2048 + tid * 4;
    float z0 = 0.f; asm volatile("" : "+v"(z0));
    f32x4 hc = (f32x4){z0, z0, z0, z0};
#pragma unroll 1
    for (int c0 = 0; c0 < 32; c0 += 16) {
        u32x2 sv[16]; float dcv[16];
#pragma unroll
        for (int c = 0; c < 16; ++c) { sv[c] = *(const u32x2*)(ST + ((size_t)(bl * 32 + c0 + c) * 16 + h) * 8192 + e); dcv[c] = CD[(bl * 32 + c0 + c) * 16 + h]; }
#pragma unroll
        for (int c = 0; c < 16; ++c) { const float dec = dcv[c];
            u32x2 w; w.x = pk2(hc[0], hc[1]); w.y = pk2(hc[2], hc[3]);
            *(u32x2*)(PV + ((size_t)(bl * 32 + c0 + c) * 16 + h) * 8192 + e) = w;
            hc = hc * dec + (f32x4){bflo(sv[c].x), bfhi(sv[c].x), bflo(sv[c].y), bfhi(sv[c].y)}; }
    }
}

__device__ __forceinline__ void ssd_out_unit(const Args& a, int layer, int u, unsigned char* lds, int w0, bool dry = false) {
    THREAD_IDS();
    const int g = u & 3, c = (u >> 2) & 31, bl = u >> 7;
    unsigned char* ws = wsl(a.ws);
    bf16_t* PROJ = (bf16_t*)(ws + WS_PROJ);
    const size_t row0 = (size_t)bl * SEQ + c * 64;
    const int cgi = tid & 63, pg = tid >> 6;
    {
        const int chx = (cgi < 32) ? (g * 256 + cgi * 8) : (cgi < 48) ? (1024 + g * 128 + (cgi - 32) * 8) : (1536 + g * 128 + (cgi - 48) * 8);
        u32x4 raw[11]; f32x4 wv[10];
        conv_load(raw, wv, PROJ + row0 * LDP + C_XBC + chx, pg, c, a.in[4] + (size_t)layer * 4 * 2048 + chx, a.in[5] + layer * 2048 + chx);
        ssd_acs(lds, (const float*)(ws + WS_SMALL), row0, g, a.in[7] + layer * 16, wave, lane);
        float v[8][8];
        conv_compute(v, raw, wv);
        if (cgi < 32) put_T(lds + SL_XT, cgi * 8, pg * 8, v);
        else if (cgi < 48) put_N(lds + SL_B, (cgi - 32) * 8, pg * 8, v);
        else put_N(lds + SL_C, (cgi - 48) * 8, pg * 8, v);
    }
    const int fr = lane & 15, fq = lane >> 4, hh = wave >> 1, lh = wave & 1, h = 4 * g + hh;
    const bf16_t* PV = (const bf16_t*)(ws + WS_PREV) + ((size_t)(bl * 32 + c) * 16 + h) * 8192;
    u32x2 zws[2][4]; f32x4 nwv[4];
#pragma unroll
    for (int lt = 0; lt < 2; ++lt)
#pragma unroll
        for (int pt = 0; pt < 4; ++pt) zws[lt][pt] = *(const u32x2*)(PROJ + (row0 + 32 * lh + 16 * lt + fr) * LDP + C_SZ + h * 64 + 16 * pt + 4 * fq);
#pragma unroll
    for (int pt = 0; pt < 4; ++pt) nwv[pt] = *(const f32x4*)(a.in[9] + layer * 1024 + h * 64 + 16 * pt + 4 * fq);
    bf16x8 pa[4][4];
#pragma unroll
    for (int ks = 0; ks < 4; ++ks)
#pragma unroll
        for (int pt = 0; pt < 4; ++pt) pa[ks][pt] = *(const bf16x8*)(PV + (16 * pt + fr) * 128 + 32 * ks + 8 * fq);
    __syncthreads();
    const float* ACS = (const float*)(lds + SL_ACS); const float* DTL = (const float*)(lds + SL_DT);
    f32x4 acc[4][2], dd[4][2];
#pragma unroll
    for (int i = 0; i < 4; ++i)
#pragma unroll
        for (int j = 0; j < 2; ++j) { acc[i][j] = (f32x4){0.f, 0.f, 0.f, 0.f}; dd[i][j] = (f32x4){0.f, 0.f, 0.f, 0.f}; }
    bf16x8 cf[4][2];
#pragma unroll
    for (int ks = 0; ks < 4; ++ks)
#pragma unroll
        for (int lt = 0; lt < 2; ++lt) cf[ks][lt] = *(const bf16x8*)(lds + SL_C + (32 * lh + 16 * lt + fr) * BNP + (32 * ks + 8 * fq) * 2);
    __builtin_amdgcn_sched_barrier(0);
#pragma unroll
    for (int ks = 0; ks < 4; ++ks)
#pragma unroll
        for (int pt = 0; pt < 4; ++pt)
#pragma unroll
            for (int lt = 0; lt < 2; ++lt) acc[pt][lt] = MFMA16(pa[ks][pt], cf[ks][lt], acc[pt][lt]);
    __builtin_amdgcn_sched_barrier(0);
    {   bf16x8 bq[4][4];
#pragma unroll
        for (int ks = 0; ks < 4; ++ks)
#pragma unroll
            for (int st = 0; st < 4; ++st) if (st < 2 || lh) bq[ks][st] = *(const bf16x8*)(lds + SL_B + (16 * st + fr) * BNP + (32 * ks + 8 * fq) * 2);
        __builtin_amdgcn_sched_barrier(0);
#pragma unroll
        for (int ks = 0; ks < 4; ++ks)
#pragma unroll
            for (int st = 0; st < 4; ++st) if (st < 2 || lh) {
#pragma unroll
                for (int lt = 0; lt < 2; ++lt) dd[st][lt] = MFMA16(bq[ks][st], cf[ks][lt], dd[st][lt]); }
    }
    float acl[2];
#pragma unroll
    for (int lt = 0; lt < 2; ++lt) { acl[lt] = ACS[hh * 64 + 32 * lh + 16 * lt + fr]; const float e = __expf(acl[lt]);
#pragma unroll
        for (int pt = 0; pt < 4; ++pt) acc[pt][lt] *= e; }
#pragma unroll
    for (int st = 0; st < 4; ++st) if (st < 2 || lh) {
#pragma unroll
        for (int r = 0; r < 4; ++r) { const int s = 16 * st + 4 * fq + r; const float as = ACS[hh * 64 + s], ds = DTL[hh * 64 + s];
#pragma unroll
            for (int lt = 0; lt < 2; ++lt) { const int l = 32 * lh + 16 * lt + fr; dd[st][lt][r] = (s <= l) ? dd[st][lt][r] * __expf(acl[lt] - as) * ds : 0.f; } }
    }
#pragma unroll
    for (int kk = 0; kk < 2; ++kk) if (kk == 0 || lh) {
        bf16x8 mb[2];
#pragma unroll
        for (int lt = 0; lt < 2; ++lt) { u32x4 w; w.x = pk2(dd[2 * kk][lt][0], dd[2 * kk][lt][1]); w.y = pk2(dd[2 * kk][lt][2], dd[2 * kk][lt][3]);
            w.z = pk2(dd[2 * kk + 1][lt][0], dd[2 * kk + 1][lt][1]); w.w = pk2(dd[2 * kk + 1][lt][2], dd[2 * kk + 1][lt][3]); mb[lt] = __builtin_bit_cast(bf16x8, w); }
#pragma unroll
        for (int pt = 0; pt < 4; ++pt) { const unsigned char* xr = lds + SL_XT + (hh * 64 + 16 * pt + fr) * XTP + (32 * kk + 4 * fq) * 2;
            const u32x2 lo = *(const u32x2*)xr, hi2 = *(const u32x2*)(xr + 32);
            const bf16x8 af = __builtin_bit_cast(bf16x8, (u32x4){lo.x, lo.y, hi2.x, hi2.y});
#pragma unroll
            for (int lt = 0; lt < 2; ++lt) acc[pt][lt] = MFMA16(af, mb[lt], acc[pt][lt]); }
    }
    const float dsk = a.in[8][layer * 16 + h];
    float ss[2] = {0.f, 0.f};
#pragma unroll
    for (int lt = 0; lt < 2; ++lt) { const int l = 32 * lh + 16 * lt + fr;
#pragma unroll
        for (int pt = 0; pt < 4; ++pt) { const int p4 = 16 * pt + 4 * fq;
            const u32x2 zw = zws[lt][pt];
            const float zz[4] = {bflo(zw.x), bfhi(zw.x), bflo(zw.y), bfhi(zw.y)};
#pragma unroll
            for (int r = 0; r < 4; ++r) { const float xv = bf1(*(const bf16_t*)(lds + SL_XT + (hh * 64 + p4 + r) * XTP + l * 2));
                const float y = (acc[pt][lt][r] + xv * dsk) * zz[r]; acc[pt][lt][r] = y; ss[lt] += y * y; } } }
#pragma unroll
    for (int lt = 0; lt < 2; ++lt) { ss[lt] += lx_xor(ss[lt], 16, lane); ss[lt] += lx_xor(ss[lt], 32, lane);
        if (fq == 0) ((float*)(lds + SL_PART))[hh * 64 + 32 * lh + 16 * lt + fr] = ss[lt]; }
    __syncthreads();
    const float* nw = a.in[9] + layer * 1024 + h * 64;
#pragma unroll
    for (int lt = 0; lt < 2; ++lt) { const int l = 32 * lh + 16 * lt + fr; const float* pr = (const float*)(lds + SL_PART);
        const float tot = (pr[l] + pr[64 + l]) + (pr[128 + l] + pr[192 + l]);
        const float rs = rsqrtf(tot * (1.0f / 256.0f) + EPS);
#pragma unroll
        for (int pt = 0; pt < 4; ++pt) { const int p4 = 16 * pt + 4 * fq; const f32x4 wv = nwv[pt];
            u32x2 o; o.x = pk2(acc[pt][lt][0] * rs * wv.x, acc[pt][lt][1] * rs * wv.y); o.y = pk2(acc[pt][lt][2] * rs * wv.z, acc[pt][lt][3] * rs * wv.w);
            if (dry) *(u32x2*)((bf16_t*)(ws + WS_M16) + (row0 + l) * 1024 + h * 64 + p4) = o; else *(u32x2*)(PROJ + (row0 + l) * LDP + C_SZ + h * 64 + p4) = o; } }
}

__device__ __forceinline__ void fcum_unit(const Args& a, int fu, int w0) {
    THREAD_IDS();
    const int task = fu * 8 + wave, bl = task >> 4, h = task & 15;
    const float* sm = (const float*)(wsl(a.ws) + WS_SMALL) + ((size_t)bl * SEQ + lane * 32) * 32 + h;
    float v[32]; float run = 0.f;
#pragma unroll
    for (int i = 0; i < 32; ++i) { run += sm[i * 32]; v[i] = run; }
    float sc = run;
#pragma unroll
    for (int o = 1; o < 64; o <<= 1) { const float t = lx_up(sc, o, lane); if (lane >= o) sc += t; }
    const float off = sc - run;
    float* F = (float*)(wsl(a.ws) + WS_F2) + (size_t)task * SEQ + lane * 32;
#pragma unroll
    for (int i = 0; i < 32; i += 4) *(f32x4*)(F + i) = (f32x4){(off + v[i]) * LOG2E, (off + v[i + 1]) * LOG2E, (off + v[i + 2]) * LOG2E, (off + v[i + 3]) * LOG2E};
}
__device__ __forceinline__ void rope_unit(const Args& a, int ru, int w0) {
    THREAD_IDS();
    const int row = ru * 64 + (tid >> 3), j = tid & 7, pos = row & (SEQ - 1);
    bf16_t* PROJ = (bf16_t*)(wsl(a.ws) + WS_PROJ);
    const f32x2* cs = (const f32x2*)(wsl(a.ws) + WS_ROPE) + pos * 8;
    f32x2 t[8];
#pragma unroll
    for (int i = 0; i < 8; ++i) t[i] = cs[i];
#pragma unroll
    for (int k = 0; k < 4; ++k) { const int hc = 4 * j + k; const int col = (hc < 16) ? (C_DQ + hc * 64) : (C_DK + (hc - 16) * 64);
        u32x4* p = (u32x4*)(PROJ + (size_t)row * LDP + col);
        const u32x4 a1 = p[0], a2 = p[1]; u32x4 o1, o2;
#pragma unroll
        for (int w = 0; w < 4; ++w) {
            const float x1l = bflo(a1[w]), x1h = bfhi(a1[w]), x2l = bflo(a2[w]), x2h = bfhi(a2[w]);
            const f32x2 c0 = t[2 * w], c1 = t[2 * w + 1];
            o1[w] = pk2(x1l * c0.x - x2l * c0.y, x1h * c1.x - x2h * c1.y);
            o2[w] = pk2(x2l * c0.x + x1l * c0.y, x2h * c1.x + x1h * c1.y); }
        p[0] = o1; p[1] = o2; }
}

__device__ __forceinline__ v4i16_t vtr(const unsigned char* p) { return __builtin_amdgcn_ds_read_tr16_b64_v4i16((LAS v4i16_t*)(LAS unsigned char*)p); }
__device__ __forceinline__ float max3f(float a, float b, float c) { float r; asm("v_max3_f32 %0, %1, %2, %3" : "=v"(r) : "v"(a), "v"(b), "v"(c)); return r; }
template <int DV, bool FOX>
__device__ __forceinline__ void attn_pass(f32x16 (&o)[DV / 32], float& l_out, const bf16_t* Qw, const bf16_t* Kb, const bf16_t* Vb, const float* F2,
                                          int q0, unsigned char* lds, int w0) {
    THREAD_IDS(); const int wid = wave;
    constexpr int KP = 144, VP = DV * 2 + 64, OFF_K = 0, OFF_V = 64 * KP, OFF_F = OFF_V + 64 * VP, STAGE = OFF_F + 256, NV = DV / 64;
    const int r32 = lane & 31, hi = lane >> 5;
    const int NT = (q0 + 256) / 64, my_nt = (q0 + 32 * wid) / 64 + 1;
    bf16x8 qf[4];
#pragma unroll
    for (int d0 = 0; d0 < 4; ++d0) qf[d0] = *(const bf16x8*)(Qw + (size_t)r32 * LDP + d0 * 16 + hi * 8);
    float m = -INFINITY, l = 0.f;
#pragma unroll
    for (int i = 0; i < DV / 32; ++i)
#pragma unroll
        for (int r = 0; r < 16; ++r) o[i][r] = 0.f;
    u32x4 kreg[2], vreg[2][NV]; float freg = 0.f;
    const int krow = tid >> 3, kch = tid & 7;
#define ATT_LOAD(T) do { _Pragma("unroll") for (int j_ = 0; j_ < 2; ++j_) { kreg[j_] = *(const u32x4*)(Kb + (size_t)(128 * (T) + 64 * j_ + krow) * LDP + kch * 8); \
        _Pragma("unroll") for (int i_ = 0; i_ < NV; ++i_) { const int idx_ = tid + 512 * i_; const int vr_ = (DV == 64) ? (idx_ >> 3) : (idx_ >> 4), vc_ = (DV == 64) ? (idx_ & 7) : (idx_ & 15); \
            vreg[j_][i_] = *(const u32x4*)(Vb + (size_t)(128 * (T) + 64 * j_ + vr_) * LDP + vc_ * 8); } } \
        if (FOX && tid < 128) freg = -F2[128 * (T) + tid]; } while (0)
#define ATT_STORE(sb_) do { _Pragma("unroll") for (int j_ = 0; j_ < 2; ++j_) { *(u32x4*)((sb_) + j_ * STAGE + OFF_K + krow * KP + kch * 16) = kreg[j_]; \
        _Pragma("unroll") for (int i_ = 0; i_ < NV; ++i_) { const int idx_ = tid + 512 * i_; const int vr_ = (DV == 64) ? (idx_ >> 3) : (idx_ >> 4), vc_ = (DV == 64) ? (idx_ & 7) : (idx_ & 15); \
            *(u32x4*)((sb_) + j_ * STAGE + OFF_V + vr_ * VP + vc_ * 16) = vreg[j_][i_]; } } \
        if (FOX && tid < 128) ((float*)((sb_) + (tid >> 6) * STAGE + OFF_F))[tid & 63] = freg; } while (0)
#ifndef JD
#define JD 1
#endif
    constexpr bool JOINT_DIFF = (JD != 0);
    const int NT2 = NT / 2;
    __syncthreads();
    ATT_LOAD(0); ATT_STORE(lds);
    if (NT2 > 1) ATT_LOAD(1);
    __syncthreads();
    for (int T = 0; T < NT2; ++T) {
      const unsigned char* sbase = lds + (T & 1) * (2 * STAGE);
      if constexpr (FOX || JOINT_DIFF) {
        const int t0 = 2 * T;
        if (t0 < my_nt) {
            const unsigned char* sb0 = sbase; const unsigned char* sb1 = sbase + STAGE;
            const unsigned char* vb0 = sb0 + OFF_V + (4 * hi + ((lane & 15) >> 2)) * VP + (16 * ((lane >> 4) & 1) + 4 * (lane & 3)) * 2;
            const unsigned char* vb1 = vb0 + STAGE;
            v4i16_t vs[2][DV / 32][2];
#pragma unroll
            for (int dvt = 0; dvt < DV / 32; ++dvt) { vs[0][dvt][0] = vtr(vb0 + dvt * 64); vs[0][dvt][1] = vtr(vb0 + 8 * VP + dvt * 64); }
            f32x16 p[4];
#pragma unroll
            for (int j = 0; j < 2; ++j) {
                const unsigned char* sbj = j ? sb1 : sb0;
                bf16x8 kf[8];
#pragma unroll
                for (int d0 = 0; d0 < 4; ++d0) { kf[2 * d0] = *(const bf16x8*)(sbj + OFF_K + r32 * KP + d0 * 32 + hi * 16);
                    kf[2 * d0 + 1] = *(const bf16x8*)(sbj + OFF_K + (32 + r32) * KP + d0 * 32 + hi * 16); }
                __builtin_amdgcn_sched_barrier(0);
#pragma unroll
                for (int r = 0; r < 16; ++r) { p[2 * j][r] = 0.f; p[2 * j + 1][r] = 0.f; }
#pragma unroll
                for (int d0 = 0; d0 < 4; ++d0) { p[2 * j] = MFMA32(kf[2 * d0], qf[d0], p[2 * j]); p[2 * j + 1] = MFMA32(kf[2 * d0 + 1], qf[d0], p[2 * j + 1]); }
            }
            if (FOX) {
#pragma unroll
            for (int j = 0; j < 2; ++j) { const float* fk = (const float*)((j ? sb1 : sb0) + OFF_F);
#pragma unroll
                for (int g4 = 0; g4 < 4; ++g4) { const f32x4 fa = *(const f32x4*)(fk + 8 * g4 + 4 * hi), fb = *(const f32x4*)(fk + 32 + 8 * g4 + 4 * hi);
#pragma unroll
                    for (int i = 0; i < 4; ++i) { p[2 * j][4 * g4 + i] = p[2 * j][4 * g4 + i] * C2 + fa[i]; p[2 * j + 1][4 * g4 + i] = p[2 * j + 1][4 * g4 + i] * C2 + fb[i]; } } }
            } else {
                asm volatile("s_nop 15\n\ts_nop 7" : "+v"(p[0]), "+v"(p[1]), "+v"(p[2]), "+v"(p[3]));
                if (t0 + 1 >= my_nt) {
#pragma unroll
                    for (int r = 0; r < 16; ++r) { p[2][r] = -INFINITY; p[3][r] = -INFINITY; } }
            }
            if (FOX && t0 + 1 >= my_nt - 1) { const int qpos = q0 + 32 * wid + r32;
#pragma unroll
                for (int r = 0; r < 16; ++r) { const int kp = 64 * t0 + crow(r, hi);
                    if (kp > qpos) p[0][r] = -INFINITY; if (kp + 32 > qpos) p[1][r] = -INFINITY; if (kp + 64 > qpos) p[2][r] = -INFINITY; if (kp + 96 > qpos) p[3][r] = -INFINITY; } }
            float ma = max3f(p[0][0], p[1][0], p[2][0]), mb = max3f(p[3][0], p[0][1], p[1][1]);
            ma = max3f(ma, p[2][1], p[3][1]);
#pragma unroll
            for (int r = 2; r < 16; r += 2) { ma = max3f(ma, p[0][r], p[1][r]); mb = max3f(mb, p[2][r], p[3][r]); ma = max3f(ma, p[0][r + 1], p[1][r + 1]); mb = max3f(mb, p[2][r + 1], p[3][r + 1]); }
            float mx = max3f(ma, mb, ma);
            if (!FOX) mx *= C2;
            mx = max3f(mx, lx_xor(mx, 32, lane), mx);
            if (__any(mx > m)) {
                const float mn = max3f(m, mx, mx), alpha = __builtin_amdgcn_exp2f(m - mn);
                m = mn; l *= alpha;
#pragma unroll
                for (int i = 0; i < DV / 32; ++i)
#pragma unroll
                    for (int r = 0; r < 16; ++r) o[i][r] *= alpha;
            }
            float rsa = 0.f, rsb = 0.f;
#pragma unroll
            for (int q = 0; q < 4; ++q)
#pragma unroll
                for (int r = 0; r < 16; r += 2) { f32x2 a2 = {p[q][r], p[q][r + 1]}; if (FOX) a2 = a2 - (f32x2){m, m}; else a2 = a2 * (f32x2){C2, C2} - (f32x2){m, m};
                    p[q][r] = __builtin_amdgcn_exp2f(a2.x); p[q][r + 1] = __builtin_amdgcn_exp2f(a2.y); if (q & 1) rsb += p[q][r] + p[q][r + 1]; else rsa += p[q][r] + p[q][r + 1]; }
            l += rsa + rsb;
            bf16x8 pf[8];
#pragma unroll
            for (int q = 0; q < 4; ++q) { u32x4 w;
                w.x = pk2(p[q][0], p[q][1]); w.y = pk2(p[q][2], p[q][3]); w.z = pk2(p[q][4], p[q][5]); w.w = pk2(p[q][6], p[q][7]); pf[2 * q] = __builtin_bit_cast(bf16x8, w);
                w.x = pk2(p[q][8], p[q][9]); w.y = pk2(p[q][10], p[q][11]); w.z = pk2(p[q][12], p[q][13]); w.w = pk2(p[q][14], p[q][15]); pf[2 * q + 1] = __builtin_bit_cast(bf16x8, w); }
            __builtin_amdgcn_sched_barrier(0);
#pragma unroll
            for (int ks = 0; ks < 8; ++ks) {
                if (ks + 1 < 8) { const unsigned char* vbn = ((ks + 1) < 4 ? vb0 : vb1) + 16 * ((ks + 1) & 3) * VP;
#pragma unroll
                    for (int dvt = 0; dvt < DV / 32; ++dvt) { vs[(ks + 1) & 1][dvt][0] = vtr(vbn + dvt * 64); vs[(ks + 1) & 1][dvt][1] = vtr(vbn + 8 * VP + dvt * 64); }
                    __builtin_amdgcn_sched_barrier(0);
                }
#pragma unroll
                for (int dvt = 0; dvt < DV / 32; ++dvt) {
                    const v4i16_t lo = vs[ks & 1][dvt][0], h8 = vs[ks & 1][dvt][1];
                    const bf16x8 vf = (bf16x8){lo[0], lo[1], lo[2], lo[3], h8[0], h8[1], h8[2], h8[3]};
                    o[dvt] = MFMA32(vf, pf[ks], o[dvt]);
                }
                __builtin_amdgcn_sched_barrier(0);
            }
        }
      } else {
#pragma unroll
      for (int sub = 0; sub < 2; ++sub) {
        const int t = 2 * T + sub;
        const unsigned char* sb = sbase + sub * STAGE;
        if (t < my_nt) {
            bf16x8 kf[8];
#pragma unroll
            for (int d0 = 0; d0 < 4; ++d0) { kf[2 * d0] = *(const bf16x8*)(sb + OFF_K + r32 * KP + d0 * 32 + hi * 16);
                kf[2 * d0 + 1] = *(const bf16x8*)(sb + OFF_K + (32 + r32) * KP + d0 * 32 + hi * 16); }
            const unsigned char* vb = sb + OFF_V + (4 * hi + ((lane & 15) >> 2)) * VP + (16 * ((lane >> 4) & 1) + 4 * (lane & 3)) * 2;
            f32x4 fka[4], fkb[4];
            if (FOX) { const float* fk = (const float*)(sb + OFF_F);
#pragma unroll
                for (int g4 = 0; g4 < 4; ++g4) { fka[g4] = *(const f32x4*)(fk + 8 * g4 + 4 * hi); fkb[g4] = *(const f32x4*)(fk + 32 + 8 * g4 + 4 * hi); } }
            v4i16_t vs[2][DV / 32][2];
#pragma unroll
            for (int dvt = 0; dvt < DV / 32; ++dvt) { vs[0][dvt][0] = vtr(vb + dvt * 64); vs[0][dvt][1] = vtr(vb + 8 * VP + dvt * 64); }
            __builtin_amdgcn_sched_barrier(0);
            f32x16 p0, p1;
#pragma unroll
            for (int r = 0; r < 16; ++r) { p0[r] = 0.f; p1[r] = 0.f; }
#pragma unroll
            for (int d0 = 0; d0 < 4; ++d0) { p0 = MFMA32(kf[2 * d0], qf[d0], p0); p1 = MFMA32(kf[2 * d0 + 1], qf[d0], p1); }
            if (FOX) {
#pragma unroll
                for (int g4 = 0; g4 < 4; ++g4) { const f32x4 fa = fka[g4], fb = fkb[g4];
#pragma unroll
                    for (int i = 0; i < 4; ++i) { p0[4 * g4 + i] = p0[4 * g4 + i] * C2 + fa[i]; p1[4 * g4 + i] = p1[4 * g4 + i] * C2 + fb[i]; } }
                if (t == my_nt - 1) { const int qpos = q0 + 32 * wid + r32;
#pragma unroll
                    for (int r = 0; r < 16; ++r) { const int kp = 64 * t + crow(r, hi); if (kp > qpos) p0[r] = -INFINITY; if (kp + 32 > qpos) p1[r] = -INFINITY; } }
            } else {
                asm volatile("s_nop 15\n\ts_nop 7" : "+v"(p0), "+v"(p1));
            }
            float ma = max3f(p0[0], p0[1], p1[0]), mb = max3f(p0[2], p0[3], p1[1]);
            ma = max3f(ma, p1[2], p1[3]);
#pragma unroll
            for (int r = 4; r < 16; r += 4) { ma = max3f(ma, p0[r], p0[r + 1]); mb = max3f(mb, p0[r + 2], p0[r + 3]); ma = max3f(ma, p1[r], p1[r + 1]); mb = max3f(mb, p1[r + 2], p1[r + 3]); }
            float mx = max3f(ma, mb, ma);
            if (!FOX) mx *= C2;
            mx = max3f(mx, lx_xor(mx, 32, lane), mx);
            if (__any(mx > m)) {
                const float mn = max3f(m, mx, mx), alpha = __builtin_amdgcn_exp2f(m - mn);
                m = mn; l *= alpha;
#pragma unroll
                for (int i = 0; i < DV / 32; ++i)
#pragma unroll
                    for (int r = 0; r < 16; ++r) o[i][r] *= alpha;
            }
            float rsa = 0.f, rsb = 0.f;
#pragma unroll
            for (int r = 0; r < 16; r += 2) {
                f32x2 a = {p0[r], p0[r + 1]}, b = {p1[r], p1[r + 1]};
                if (FOX) { a = a - (f32x2){m, m}; b = b - (f32x2){m, m}; }
                else { a = a * (f32x2){C2, C2} - (f32x2){m, m}; b = b * (f32x2){C2, C2} - (f32x2){m, m}; }
                p0[r] = __builtin_amdgcn_exp2f(a.x); p0[r + 1] = __builtin_amdgcn_exp2f(a.y); p1[r] = __builtin_amdgcn_exp2f(b.x); p1[r + 1] = __builtin_amdgcn_exp2f(b.y);
                rsa += p0[r] + p0[r + 1]; rsb += p1[r] + p1[r + 1]; }
            l += rsa + rsb;
            bf16x8 pf[4];
            { u32x4 w;
              w.x = pk2(p0[0], p0[1]); w.y = pk2(p0[2], p0[3]); w.z = pk2(p0[4], p0[5]); w.w = pk2(p0[6], p0[7]); pf[0] = __builtin_bit_cast(bf16x8, w);
              w.x = pk2(p0[8], p0[9]); w.y = pk2(p0[10], p0[11]); w.z = pk2(p0[12], p0[13]); w.w = pk2(p0[14], p0[15]); pf[1] = __builtin_bit_cast(bf16x8, w);
              w.x = pk2(p1[0], p1[1]); w.y = pk2(p1[2], p1[3]); w.z = pk2(p1[4], p1[5]); w.w = pk2(p1[6], p1[7]); pf[2] = __builtin_bit_cast(bf16x8, w);
              w.x = pk2(p1[8], p1[9]); w.y = pk2(p1[10], p1[11]); w.z = pk2(p1[12], p1[13]); w.w = pk2(p1[14], p1[15]); pf[3] = __builtin_bit_cast(bf16x8, w); }
            __builtin_amdgcn_sched_barrier(0);
#pragma unroll
            for (int ks = 0; ks < 4; ++ks) {
                if (ks + 1 < 4) {
#pragma unroll
                    for (int dvt = 0; dvt < DV / 32; ++dvt) { vs[(ks + 1) & 1][dvt][0] = vtr(vb + 16 * (ks + 1) * VP + dvt * 64); vs[(ks + 1) & 1][dvt][1] = vtr(vb + (16 * (ks + 1) + 8) * VP + dvt * 64); }
                    __builtin_amdgcn_sched_barrier(0);
                }
#pragma unroll
                for (int dvt = 0; dvt < DV / 32; ++dvt) {
                    const v4i16_t lo = vs[ks & 1][dvt][0], h8 = vs[ks & 1][dvt][1];
                    const bf16x8 vf = (bf16x8){lo[0], lo[1], lo[2], lo[3], h8[0], h8[1], h8[2], h8[3]};
                    o[dvt] = MFMA32(vf, pf[ks], o[dvt]);
                }
                __builtin_amdgcn_sched_barrier(0);
            }
        }
      }
      }
        if (T + 1 < NT2) { ATT_STORE(lds + ((T + 1) & 1) * (2 * STAGE)); if (T + 2 < NT2) ATT_LOAD(T + 2); }
        __syncthreads();
    }
#undef ATT_LOAD
#undef ATT_STORE
    l_out = l + lx_xor(l, 32, lane);
}

__device__ __forceinline__ void fox_unit(const Args& a, int bh, int qb, unsigned char* lds, int w0, bool dry = false) {
    THREAD_IDS(); const int wid = wave;
    const int bl = bh >> 4, h = bh & 15, q0 = qb * 256, r32 = lane & 31, hi = lane >> 5;
    bf16_t* PROJ = (bf16_t*)(wsl(a.ws) + WS_PROJ);
    const size_t rowb = (size_t)bl * SEQ;
    f32x16 o[2]; float l;
    bf16_t* orow = PROJ + (rowb + q0 + 32 * wid + r32) * LDP;
    u32x2 gws[8];
#pragma unroll
    for (int k = 0; k < 8; ++k) gws[k] = *(const u32x2*)(orow + C_FG + h * 64 + 32 * (k >> 2) + 8 * (k & 3) + 4 * hi);
    attn_pass<64, true>(o, l, PROJ + (rowb + q0 + 32 * wid) * LDP + C_FQ + h * 64, PROJ + rowb * LDP + C_FK + h * 64, PROJ + rowb * LDP + C_FV + h * 64,
                        (const float*)(wsl(a.ws) + WS_F2) + (size_t)bh * SEQ, q0, lds, w0);
    const float inv = 1.0f / l;
    bf16_t* owr = dry ? (bf16_t*)(wsl(a.ws) + WS_M16) + (rowb + q0 + 32 * wid + r32) * 1024 : orow + C_FQ;
#pragma unroll
    for (int dvt = 0; dvt < 2; ++dvt)
#pragma unroll
        for (int g4 = 0; g4 < 4; ++g4) { const int dv = 32 * dvt + 8 * g4 + 4 * hi;
            const u32x2 gw = gws[dvt * 4 + g4];
            u32x2 w; w.x = pk2(o[dvt][4 * g4] * inv * bflo(gw.x), o[dvt][4 * g4 + 1] * inv * bfhi(gw.x)); w.y = pk2(o[dvt][4 * g4 + 2] * inv * bflo(gw.y), o[dvt][4 * g4 + 3] * inv * bfhi(gw.y));
            *(u32x2*)(owr + h * 64 + dv) = w; }
}
__device__ __forceinline__ void diff_unit(const Args& a, int layer, int bh, int qb, unsigned char* lds, int w0, bool dry = false) {
    THREAD_IDS(); const int wid = wave;
    const int bl = bh >> 3, h = bh & 7, q0 = qb * 256, r32 = lane & 31, hi = lane >> 5;
    bf16_t* PROJ = (bf16_t*)(wsl(a.ws) + WS_PROJ);
    const size_t rowb = (size_t)bl * SEQ;
    const float lam = ((const float*)(wsl(a.ws) + WS_LAM))[layer * 2], lami = ((const float*)(wsl(a.ws) + WS_LAM))[layer * 2 + 1];
    f32x16 o1[4]; float l1, l2;
    float* scr = (float*)(wsl(a.ws) + WS_M32) + ((size_t)((bh * 8 + qb) * 8 + wid) * 64 + lane) * 64;
    attn_pass<128, false>(o1, l1, PROJ + (rowb + q0 + 32 * wid) * LDP + C_DQ + h * 128, PROJ + rowb * LDP + C_DK + h * 128, PROJ + rowb * LDP + C_DV + h * 128, nullptr, q0, lds, w0);
    { const float inv = 1.0f / l1;
#pragma unroll
      for (int i = 0; i < 4; ++i)
#pragma unroll
          for (int r = 0; r < 16; r += 4) *(f32x4*)(scr + i * 16 + r) = (f32x4){o1[i][r] * inv, o1[i][r + 1] * inv, o1[i][r + 2] * inv, o1[i][r + 3] * inv}; }
    attn_pass<128, false>(o1, l2, PROJ + (rowb + q0 + 32 * wid) * LDP + C_DQ + h * 128 + 64, PROJ + rowb * LDP + C_DK + h * 128 + 64, PROJ + rowb * LDP + C_DV + h * 128, nullptr, q0, lds, w0);
    const float sc2 = lam / l2; float ss = 0.f;
    {   f32x4 c1[16];
#pragma unroll
        for (int k = 0; k < 16; ++k) c1[k] = *(const f32x4*)(scr + 4 * k);
#pragma unroll
        for (int k = 0; k < 16; ++k)
#pragma unroll
            for (int e = 0; e < 4; ++e) { const int i = k >> 2, r = 4 * (k & 3) + e; const float v = c1[k][e] - sc2 * o1[i][r]; o1[i][r] = v; ss += v * v; }
    }
    ss += lx_xor(ss, 32, lane);
    const float rs = rsqrtf(ss * (1.0f / 128.0f) + EPS) * (1.0f - lami);
    bf16_t* orow = PROJ + (rowb + q0 + 32 * wid + r32) * LDP;
    const float* sw = a.in[11] + layer * 128;
    bf16_t* owr = dry ? (bf16_t*)(wsl(a.ws) + WS_M16) + (rowb + q0 + 32 * wid + r32) * 1024 : orow + C_DQ;
#pragma unroll
    for (int half = 0; half < 2; ++half) {
        u32x2 gwv[8]; f32x4 wvv[8];
#pragma unroll
        for (int k = 0; k < 8; ++k) { const int dvt = 2 * half + (k >> 2), g4 = k & 3, dv = 32 * dvt + 8 * g4 + 4 * hi;
            gwv[k] = *(const u32x2*)(orow + C_DG + h * 128 + dv); wvv[k] = *(const f32x4*)(sw + dv); }
#pragma unroll
        for (int k = 0; k < 8; ++k) { const int dvt = 2 * half + (k >> 2), g4 = k & 3, dv = 32 * dvt + 8 * g4 + 4 * hi;
            const u32x2 gw = gwv[k]; const f32x4 wv = wvv[k];
            u32x2 w; w.x = pk2(o1[dvt][4 * g4] * rs * wv.x * bflo(gw.x), o1[dvt][4 * g4 + 1] * rs * wv.y * bfhi(gw.x));
            w.y = pk2(o1[dvt][4 * g4 + 2] * rs * wv.z * bflo(gw.y), o1[dvt][4 * g4 + 3] * rs * wv.w * bfhi(gw.y));
            *(u32x2*)(owr + h * 128 + dv) = w; }
    }
}

#define XB_TMO      128
#define XB_XCNT(j)  (256  + 64 * (j))
#define XB_XSUB(j)  (1280 + 64 * (j))
#define XB_XGEN(j)  (2304 + 64 * (j))
#define XB_TOP      3328
#define XB_TOPGEN   3392
#define XCD_BAR_WORDS 3456
#define XB_SPIN_CAP (1u << 18)

__device__ __forceinline__ unsigned xb_ld(unsigned* p)              { return __hip_atomic_load(p, __ATOMIC_RELAXED, __HIP_MEMORY_SCOPE_AGENT); }
__device__ __forceinline__ unsigned xb_add(unsigned* p, unsigned v) { return __hip_atomic_fetch_add(p, v, __ATOMIC_RELAXED, __HIP_MEMORY_SCOPE_AGENT); }
__device__ __forceinline__ unsigned xb_xcc_id() { return (unsigned)__builtin_amdgcn_s_getreg((3 << 11) | 20) & 0xFu; }
#define XB_SPIN(cond, bar) do { unsigned _sp = 0; while (cond) { __builtin_amdgcn_s_sleep(1); \
    if ((++_sp & 255u) == 0u) { if (xb_ld(&(bar)[XB_TMO])) break; if (_sp > XB_SPIN_CAP) { atomicAdd(&(bar)[XB_TMO], 1u); break; } } } } while (0)

struct XcdBarrier {
    unsigned* bar; unsigned x;
    volatile LAS unsigned* st;
};

__device__ __forceinline__ XcdBarrier xcd_barrier_post(unsigned* bar, volatile LAS unsigned* st) {
    XcdBarrier b; b.bar = bar; b.x = xb_xcc_id(); b.st = st;
    if (threadIdx.x == 0) (void)xb_add(&bar[XB_XCNT(b.x)], 1u);
    return b;
}
__device__ __forceinline__ void xcd_barrier_complete(unsigned* bar, unsigned x, unsigned& nloc, unsigned& nx) {
    const unsigned G = gridDim.x * gridDim.y * gridDim.z;
    unsigned sum, cnt, mine, sp = 0u;
    for (;;) {
        sum = 0u; cnt = 0u; mine = 0u;
#pragma unroll
        for (unsigned j = 0; j < 16; ++j) { const unsigned c = xb_ld(&bar[XB_XCNT(j)]); sum += c; cnt += (c > 0u) ? 1u : 0u; mine = (j == x) ? c : mine; }
        if (sum == G) break;
        __builtin_amdgcn_s_sleep(1);
        if ((++sp & 255u) == 0u) { if (xb_ld(&bar[XB_TMO])) break; if (sp > XB_SPIN_CAP) { atomicAdd(&bar[XB_TMO], 1u); break; } }
    }
    nloc = mine > 0u ? mine : 1u; nx = cnt > 0u ? cnt : 1u;
}

__device__ __forceinline__ bool is_thread0(int w0) { int lane; asm volatile("v_mbcnt_lo_u32_b32 %0, -1, 0\n\tv_mbcnt_hi_u32_b32 %0, -1, %0" : "=v"(lane)); return w0 == 0 && lane == 0; }
__device__ __forceinline__ void xcd_barrier(const XcdBarrier& b, int w0) {
    asm volatile("s_waitcnt vmcnt(0)" ::: "memory");
    __syncthreads();
    if (is_thread0(w0)) {
        unsigned* bar = b.bar;
        __builtin_amdgcn_s_waitcnt(0);
        unsigned nloc = b.st[0], nx = b.st[1];
        if (nloc == 0u) { xcd_barrier_complete(bar, b.x, nloc, nx); b.st[0] = nloc; b.st[1] = nx; }
        const unsigned old = xb_add(&bar[XB_XSUB(b.x)], 1u);
        const unsigned gen = old / nloc;
        if (old + 1u == (gen + 1u) * nloc) {
            __builtin_amdgcn_fence(__ATOMIC_RELEASE, "agent");
            asm volatile("s_waitcnt vmcnt(0)" ::: "memory");
            const unsigned og = xb_add(&bar[XB_TOP], 1u);
            const unsigned tg = og / nx;
            if (og + 1u == (tg + 1u) * nx) xb_add(&bar[XB_TOPGEN], 1u);
            else XB_SPIN(xb_ld(&bar[XB_TOPGEN]) == tg, bar);
            __builtin_amdgcn_fence(__ATOMIC_ACQUIRE, "agent");
            xb_add(&bar[XB_XGEN(b.x)], 1u);
            asm volatile("s_waitcnt vmcnt(0)" ::: "memory");
        } else {
            XB_SPIN(xb_ld(&bar[XB_XGEN(b.x)]) == gen, bar);
            __builtin_amdgcn_fence(__ATOMIC_ACQUIRE, "agent");
            asm volatile("s_waitcnt vmcnt(0)" ::: "memory");
        }
    }
    __syncthreads();
}

__global__ void __launch_bounds__(NTHR, 2) hybrid_fwd(Args args) {
    extern __shared__ __attribute__((aligned(16))) unsigned char lds[];
    cg::grid_group grid = cg::this_grid();
    const int wave0 = __builtin_amdgcn_readfirstlane((int)threadIdx.x >> 6);
    Args A2;
#pragma unroll
    for (int i = 0; i < 15; ++i) A2.in[i] = (const float*)(GAS const float*)args.in[i];
    A2.out = (float*)(GAS float*)args.out; A2.ws = (unsigned char*)(GAS unsigned char*)args.ws;
#define args A2
#define ws (wsl(args.ws))
#define CTR ((unsigned*)(ws + WS_CTR))
    LAS unsigned char* ldsl = (LAS unsigned char*)lds;

#ifndef PHM
#define PHM 0xffff
#endif
    { volatile LAS unsigned* st0 = (volatile LAS unsigned*)(ldsl + LDS_MISC + 64); if (threadIdx.x < 2) st0[threadIdx.x] = 0u; }
    if (blockIdx.x == 0) { unsigned* bw = (unsigned*)(ws + WS_BAR); for (int i = threadIdx.x; i < XCD_BAR_WORDS; i += NTHR) bw[i] = 0u; }
    __syncthreads();
    p0_prologue(args, lds, wave0);
    grid.sync();
    const XcdBarrier xbar = xcd_barrier_post((unsigned*)(ws + WS_BAR), (volatile LAS unsigned*)(ldsl + LDS_MISC + 64));
#define GRID_SYNC() xcd_barrier(xbar, wave0)
#ifndef TMASK
#define TMASK 0
#endif
    unsigned long long t_acc = 0ull, t_0 = 0ull;
#define T_BEGIN(bit) do { if (TMASK & (bit)) t_0 = __builtin_amdgcn_s_memrealtime(); } while (0)
#define T_END(bit) do { if (TMASK & (bit)) t_acc += __builtin_amdgcn_s_memrealtime() - t_0; } while (0)
    for (int layer = 0; layer < 2; ++layer) {
        const float* xin = (layer == 0) ? args.in[0] : args.out;
        if (layer == 0) { norm_rows<true>(xin, args.in[1], (bf16_t*)(ws + WS_H), nullptr, wave0); GRID_SYNC(); }
        for (int g = 0; g < NGRP; ++g) {
            const int pass = layer * NGRP + g;
            T_BEGIN(1);
            if (PHM & 4) { pg8::Gemm gm{(const bf16_t*)(ws + WS_H) + (size_t)g * TG * 1024, (const bf16_t*)(ws + WS_WIN) + (size_t)layer * NP * 1024, TG, NP, 1024, 1024};
              pg8::StaticOrder S; S.init(TG, NP, (int)gridDim.x, lbx());
              pg8::EpiProj E{(bf16_t*)(ws + WS_PROJ), (float*)(ws + WS_SMALL), (const float*)(ws + WS_LAM) + 16 + layer * 32};
              pg8::gemm_phase<pg8::EpiProj, pg8::StaticOrder, true, true>(ldsl, gm, S, E, wave0); }
            if (g > 0 && lbx() >= 128) {
              pg8::Gemm gm{(const bf16_t*)(ws + WS_M16), (const bf16_t*)(ws + WS_WOUT) + (size_t)layer * 1024 * 1024, TG, 1024, 1024, 1024};
              pg8::StaticOrder S; S.init(TG, 1024, (int)gridDim.x, lbx() - 128);
              pg8::EpiRes E{xin + (size_t)(g - 1) * TG * 1024, args.out + (size_t)(g - 1) * TG * 1024};
              pg8::gemm_phase<pg8::EpiRes, pg8::StaticOrder, true, true>(ldsl, gm, S, E, wave0); }
            GRID_SYNC();
            T_END(1); T_BEGIN(2);
#ifndef EXPER
#define EXPER 0
#endif
            if (EXPER == 2) { pg8::Gemm gm{(const bf16_t*)(ws + WS_H) + (size_t)g * TG * 1024, (const bf16_t*)(ws + WS_WIN) + (size_t)layer * NP * 1024, TG, NP, 1024, 1024};
              pg8::StaticOrder S; S.init(TG, NP, (int)gridDim.x, lbx());
              pg8::EpiProj E{(bf16_t*)(ws + WS_PROJ), (float*)(ws + WS_SMALL), (const float*)(ws + WS_LAM) + 16 + layer * 32};
              pg8::gemm_phase<pg8::EpiProj, pg8::StaticOrder, true, true>(ldsl, gm, S, E, wave0); GRID_SYNC(); }
            if (EXPER == 5) { for (int q = 0; q < 10; ++q) GRID_SYNC(); }
            UNIT_LOOP(CTR + (pass * 3 + 0) * 64, 648,
                  if (u < 8) fcum_unit(args, u, wave0);
                  else if (u < 136) rope_unit(args, u - 8, wave0);
                  else ssd_states_unit(args, layer, u - 136, lds, wave0););
            GRID_SYNC();
            T_END(2); T_BEGIN(4);
            UNIT_LOOP(CTR + (pass * 3 + 1) * 64, 1024,
                  if (u < 256) diff_unit(args, layer, u & 31, 7 - (u >> 5), lds, wave0);
                  else if (u < 512) ssd_scan_unit(args, u - 256, wave0);
                  else { const int j = u - 512; fox_unit(args, j & 63, 7 - (j >> 6), lds, wave0); });
            GRID_SYNC();
            T_END(4); T_BEGIN(8);
            { const int n = (lbx() < 128) ? 0 : 2;
              const int ycol = (n == 0) ? C_FQ : C_DQ;
              pg8::Gemm gm{(const bf16_t*)(ws + WS_PROJ) + ycol, (const bf16_t*)(ws + WS_WBR) + (size_t)(layer * 3 + n) * 1024 * 1024, TG, 1024, 1024, LDP};
              pg8::StaticOrder S; S.init(TG, 1024, (int)gridDim.x, lbx() & 127);
              pg8::EpiGate E{(const bf16_t*)(ws + WS_PROJ) + C_MG + n * 1024, (float*)(ws + WS_M32), (bf16_t*)(ws + WS_M16), n};
              pg8::gemm_phase<pg8::EpiGate, pg8::StaticOrder, true, true>(ldsl, gm, S, E, wave0); }
            UNIT_LOOP(CTR + (pass * 3 + 2) * 64, 512, ssd_out_unit(args, layer, u, lds, wave0););
            GRID_SYNC();
            T_END(8); T_BEGIN(16);
            { pg8::Gemm gm{(const bf16_t*)(ws + WS_PROJ) + C_SZ, (const bf16_t*)(ws + WS_WBR) + (size_t)(layer * 3 + 1) * 1024 * 1024, TG, 1024, 1024, LDP};
              pg8::StaticOrder S; S.init(TG, 1024, (int)gridDim.x, lbx());
              pg8::EpiGate E{(const bf16_t*)(ws + WS_PROJ) + C_MG + 1024, (float*)(ws + WS_M32), (bf16_t*)(ws + WS_M16), 1};
              pg8::gemm_phase<pg8::EpiGate, pg8::StaticOrder, true, true>(ldsl, gm, S, E, wave0); }
            GRID_SYNC();
            T_END(16);
        }
        if (lbx() < 128) { pg8::Gemm gm{(const bf16_t*)(ws + WS_M16), (const bf16_t*)(ws + WS_WOUT) + (size_t)layer * 1024 * 1024, TG, 1024, 1024, 1024};
          pg8::StaticOrder S; S.init(TG, 1024, (int)gridDim.x, lbx());
          pg8::EpiRes E{xin + (size_t)(NGRP - 1) * TG * 1024, args.out + (size_t)(NGRP - 1) * TG * 1024};
          pg8::gemm_phase<pg8::EpiRes, pg8::StaticOrder, true, true>(ldsl, gm, S, E, wave0); }
        else { if (layer == 0) norm_rows<true>(args.out, args.in[1] + 1024, (bf16_t*)(ws + WS_H), nullptr, wave0, 0, 3 * TG, lbx() - 128, 128);
               else norm_rows<false>(args.out, args.in[14], nullptr, args.out, wave0, 0, 3 * TG, lbx() - 128, 128); }
        if (TMASK && layer == 1 && blockIdx.x == 0) { const unsigned long long ts = __builtin_amdgcn_s_memrealtime(); while (__builtin_amdgcn_s_memrealtime() - ts < 4ull * t_acc) __builtin_amdgcn_s_sleep(32); }
        GRID_SYNC();
        if (layer == 0) { norm_rows<true>(args.out, args.in[1] + 1024, (bf16_t*)(ws + WS_H), nullptr, wave0, 3 * TG, MT, lbx(), (int)gridDim.x); GRID_SYNC(); }
        else norm_rows<false>(args.out, args.in[14], nullptr, args.out, wave0, 3 * TG, MT, lbx(), (int)gridDim.x);
    }
#undef ws
#undef CTR
}

#undef args
extern "C" void kernel_launch(void* const* d_in, const int* in_sizes, int n_in, void* d_out, int out_size, void* d_ws, size_t ws_size, hipStream_t stream) {
    static int grid = 0;
    if (grid == 0) {
        if (n_in != 15 || out_size != MT * DM || ws_size < WS_END) { fprintf(stderr, "kernel_launch: unexpected shapes (n_in %d out %d ws %zu need %zu)\n", n_in, out_size, ws_size, (size_t)WS_END); grid = -1; return; }
        int dev = 0, cus = 0, per_cu = 0;
        hipGetDevice(&dev); hipDeviceGetAttribute(&cus, hipDeviceAttributeMultiprocessorCount, dev);
        if (hipFuncSetAttribute((const void*)hybrid_fwd, hipFuncAttributeMaxDynamicSharedMemorySize, LDS_BYTES) != hipSuccess) { fprintf(stderr, "kernel_launch: hipFuncSetAttribute failed\n"); grid = -1; return; }
        if (hipOccupancyMaxActiveBlocksPerMultiprocessor(&per_cu, (const void*)hybrid_fwd, NTHR, LDS_BYTES) != hipSuccess || per_cu < 1) { fprintf(stderr, "kernel_launch: occupancy query gave %d\n", per_cu); per_cu = 1; }
        (void)hipGetLastError();
        grid = cus * 1;
    }
    if (grid < 0) return;
    Args a{};
    for (int i = 0; i < 15; ++i) a.in[i] = (const float*)d_in[i];
    a.out = (float*)d_out; a.ws = (unsigned char*)d_ws;
    void* kargs[] = {&a};
    hipError_t e = hipLaunchCooperativeKernel((const void*)hybrid_fwd, dim3(grid), dim3(NTHR), kargs, LDS_BYTES, stream);
    if (e != hipSuccess) fprintf(stderr, "kernel_launch: cooperative launch failed: %s (grid %d)\n", hipGetErrorString(e), grid);
}
```
